# Optimizing an MI355X kernel written in HIP

```python
import jax, jax.numpy as jnp
from jax import lax
import numpy as np

D_MODEL = 2048
BATCH = 2
SEQ = 4096
DEPTH = 1

ATTN_HEADS = 8
KV_HEADS = 2
HEAD_DIM = 128
ATTN_WIDTH = ATTN_HEADS * HEAD_DIM
KV_WIDTH = KV_HEADS * HEAD_DIM
IDX_HEADS = 16
IDX_DIM = 64
TOPK_MAX = 256
Q_BLOCK = 128
RNN_WIDTH = 1024
RNN_BLOCKS = 8
RNN_BLOCK_W = RNN_WIDTH // RNN_BLOCKS
CONV_WIDTH = 4
LRU_C = 8.0
REL_BUCKETS = 32
REL_MAX_DIST = 128
N_GROUPS = 8
EXPERTS_PER_GROUP = 8
N_EXPERTS = N_GROUPS * EXPERTS_PER_GROUP
TOP_K_IN_GROUP = 2
EXPERT_FF = 512
MOE_BLOCK = 128
EPS = 1e-6
IN_SPLITS = (ATTN_WIDTH, KV_WIDTH, KV_WIDTH, IDX_HEADS * IDX_DIM, IDX_DIM, IDX_HEADS,
             RNN_WIDTH, RNN_WIDTH, D_MODEL, D_MODEL)
IN_COLS = sum(IN_SPLITS)

kernel_name = "hybrid_dsa_rglru_hmoe_block"


def rms_norm(x, g):
    xf = x.astype(jnp.float32)
    y = xf * lax.rsqrt(jnp.mean(xf * xf, axis=-1, keepdims=True) + EPS)
    return (y * g.astype(jnp.float32)).astype(x.dtype)


def rel_bucket(n):
    n = jnp.maximum(n, 0)
    max_exact = REL_BUCKETS // 2
    nf = jnp.maximum(n, 1).astype(jnp.float32)
    large = max_exact + (jnp.log(nf / max_exact) / np.float32(np.log(REL_MAX_DIST / max_exact))
                         * (REL_BUCKETS - max_exact)).astype(jnp.int32)
    large = jnp.minimum(large, REL_BUCKETS - 1)
    return jnp.where(n < max_exact, n, large)


def split_cols(proj):
    offs, acc = [], 0
    for w in IN_SPLITS[:-1]:
        acc += w
        offs.append(acc)
    return jnp.split(proj, offs, axis=-1)


def dsa_attention(q, k, v, qi, ki, wi, rel_bias):
    B, S = q.shape[0], q.shape[1]
    topk = min(TOPK_MAX, S // 4)
    rep = ATTN_HEADS // KV_HEADS
    n_blk = S // Q_BLOCK
    kpos = jnp.arange(S, dtype=jnp.int32)
    ki32 = ki.astype(jnp.float32)
    idx_scale = np.float32(IDX_DIM ** -0.5)
    w_scale = np.float32(IDX_HEADS ** -0.5)
    att_scale = np.float32(HEAD_DIM ** -0.5)

    def block(j):
        t0 = j * Q_BLOCK
        qb = lax.dynamic_slice_in_dim(q, t0, Q_BLOCK, axis=1)
        qib = lax.dynamic_slice_in_dim(qi, t0, Q_BLOCK, axis=1)
        wib = lax.dynamic_slice_in_dim(wi, t0, Q_BLOCK, axis=1)
        tpos = t0 + jnp.arange(Q_BLOCK, dtype=jnp.int32)
        dots = jnp.einsum('bqhd,bsd->bqhs', qib.astype(jnp.float32), ki32) * idx_scale
        iscore = jnp.einsum('bqhs,bqh->bqs', jax.nn.relu(dots), wib.astype(jnp.float32) * w_scale)
        causal = kpos[None, :] <= tpos[:, None]
        iscore = jnp.where(causal[None], iscore, -jnp.inf)
        _, sel = lax.top_k(iscore, topk)
        valid = sel <= tpos[None, :, None]
        k_sel = jax.vmap(lambda kk, ii: kk[ii])(k, sel)
        v_sel = jax.vmap(lambda vv, ii: vv[ii])(v, sel)
        qg = qb.reshape(B, Q_BLOCK, KV_HEADS, rep, HEAD_DIM)
        logits = jnp.einsum('bqgrd,bqkgd->bqgrk', qg, k_sel).astype(jnp.float32) * att_scale
        bias = rel_bias[rel_bucket(tpos[None, :, None] - sel)]
        bias = bias.reshape(B, Q_BLOCK, topk, KV_HEADS, rep).transpose(0, 1, 3, 4, 2)
        logits = jnp.where(valid[:, :, None, None, :], logits + bias.astype(jnp.float32), -jnp.inf)
        p = jax.nn.softmax(logits, axis=-1).astype(v.dtype)
        o = jnp.einsum('bqgrk,bqkgd->bqgrd', p, v_sel)
        return o.reshape(B, Q_BLOCK, ATTN_WIDTH)

    outs = lax.map(block, jnp.arange(n_blk, dtype=jnp.int32))
    return outs.transpose(1, 0, 2, 3).reshape(B, S, ATTN_WIDTH)


def rg_lru_branch(xr, gate, conv_w, conv_b, wa, ba, wx, bx, lam):
    B, S, W = xr.shape
    xp = jnp.pad(xr, ((0, 0), (CONV_WIDTH - 1, 0), (0, 0)))
    xc = conv_b
    for j in range(CONV_WIDTH):
        xc = xc + xp[:, j:j + S] * conv_w[j]
    xb = xc.reshape(B, S, RNN_BLOCKS, RNN_BLOCK_W).astype(jnp.float32)
    r = jax.nn.sigmoid(jnp.einsum('bsnc,ncd->bsnd', xb, wa.astype(jnp.float32)) + ba.astype(jnp.float32))
    i = jax.nn.sigmoid(jnp.einsum('bsnc,ncd->bsnd', xb, wx.astype(jnp.float32)) + bx.astype(jnp.float32))
    r = r.reshape(B, S, W)
    i = i.reshape(B, S, W)
    log_a = -LRU_C * r * jax.nn.softplus(-lam.astype(jnp.float32))
    a = jnp.exp(log_a)
    mult = jnp.sqrt(-jnp.expm1(2.0 * log_a))
    bterm = mult * (i * xb.reshape(B, S, W))

    def combine(lhs, rhs):
        a1, b1 = lhs
        a2, b2 = rhs
        return a1 * a2, a2 * b1 + b2

    _, h = lax.associative_scan(combine, (a, bterm), axis=1)
    y = h * jax.nn.gelu(gate.astype(jnp.float32))
    return y.astype(xr.dtype)


def hier_moe(u, w_group, b_group, w_er, b_er, w_gate, w_up, w_down):
    T, D = u.shape
    uf = u.astype(jnp.float32)
    glog = uf @ w_group.astype(jnp.float32) + b_group.astype(jnp.float32)
    p_group = jax.nn.softmax(glog, axis=-1)
    g_sel = jnp.argmax(glog, axis=-1).astype(jnp.int32)
    tok_ids = jnp.arange(T, dtype=jnp.int32)
    p_sel = p_group[tok_ids, g_sel]
    elog = (uf @ w_er.astype(jnp.float32) + b_er.astype(jnp.float32)).reshape(T, N_GROUPS, EXPERTS_PER_GROUP)
    elog_g = elog[tok_ids, g_sel]
    top_v, top_i = lax.top_k(elog_g, TOP_K_IN_GROUP)
    weights = p_sel[:, None] * jax.nn.softmax(top_v, axis=-1)
    expert_id = g_sel[:, None] * EXPERTS_PER_GROUP + top_i.astype(jnp.int32)

    n_slots = T * TOP_K_IN_GROUP
    e = expert_id.reshape(-1)
    tok = jnp.repeat(tok_ids, TOP_K_IN_GROUP)
    gw = weights.reshape(-1)
    order = jnp.argsort(e, stable=True)
    se, stok, sgw = e[order], tok[order], gw[order]
    counts = jnp.zeros((N_EXPERTS,), jnp.int32).at[e].add(1)
    starts = jnp.cumsum(counts) - counts
    padded = ((counts + MOE_BLOCK - 1) // MOE_BLOCK) * MOE_BLOCK
    pends = jnp.cumsum(padded)
    pstarts = pends - padded
    dest = pstarts[se] + (jnp.arange(n_slots, dtype=jnp.int32) - starts[se])
    cap = -(-(n_slots + N_EXPERTS * (MOE_BLOCK - 1)) // MOE_BLOCK) * MOE_BLOCK
    n_blk = cap // MOE_BLOCK
    buf_tok = jnp.zeros((cap,), jnp.int32).at[dest].set(stok)
    buf_w = jnp.zeros((cap,), jnp.float32).at[dest].set(sgw)
    blk_start = jnp.arange(n_blk, dtype=jnp.int32) * MOE_BLOCK
    block_expert = jnp.minimum(jnp.searchsorted(pends, blk_start, side='right'), N_EXPERTS - 1).astype(jnp.int32)
    xb = u[buf_tok].reshape(n_blk, MOE_BLOCK, D)

    def expert_block(args):
        xblk, eid = args
        h = jax.nn.silu(xblk @ w_gate[eid]) * (xblk @ w_up[eid])
        return h @ w_down[eid]

    yb = lax.map(expert_block, (xb, block_expert)).reshape(cap, D)
    yb = yb * buf_w[:, None].astype(yb.dtype)
    return jnp.zeros((T, D), u.dtype).at[buf_tok].add(yb.astype(u.dtype))


def setup_inputs(seed: int = 0) -> dict:
    key = jax.random.key(seed)
    ks = jax.random.split(key, 24)
    L, D = DEPTH, D_MODEL

    def nrm(k, shape, scale):
        return jax.random.normal(k, shape, jnp.float32) * scale

    a0 = jax.random.uniform(ks[9], (L, RNN_WIDTH), jnp.float32, minval=0.9, maxval=0.999)
    return {
        "x": nrm(ks[0], (BATCH, SEQ, D), 1.0),
        "norm1_g": 1.0 + nrm(ks[1], (L, D), 0.02),
        "w_in": nrm(ks[2], (L, D, IN_COLS), D ** -0.5),
        "conv_w": nrm(ks[3], (L, CONV_WIDTH, RNN_WIDTH), CONV_WIDTH ** -0.5),
        "conv_b": nrm(ks[4], (L, RNN_WIDTH), 0.02),
        "lru_wa": nrm(ks[5], (L, RNN_BLOCKS, RNN_BLOCK_W, RNN_BLOCK_W), RNN_BLOCK_W ** -0.5),
        "lru_ba": nrm(ks[6], (L, RNN_BLOCKS, RNN_BLOCK_W), 0.02),
        "lru_wx": nrm(ks[7], (L, RNN_BLOCKS, RNN_BLOCK_W, RNN_BLOCK_W), RNN_BLOCK_W ** -0.5),
        "lru_bx": nrm(ks[8], (L, RNN_BLOCKS, RNN_BLOCK_W), 0.02),
        "lru_lambda": jnp.log(a0) - jnp.log1p(-a0),
        "w_proj_attn": nrm(ks[10], (L, ATTN_WIDTH, D), ATTN_WIDTH ** -0.5),
        "w_proj_rnn": nrm(ks[11], (L, RNN_WIDTH, D), RNN_WIDTH ** -0.5),
        "w_out": nrm(ks[12], (L, D, D), D ** -0.5),
        "rel_bias": nrm(ks[13], (REL_BUCKETS, ATTN_HEADS), 0.5),
        "norm2_g": 1.0 + nrm(ks[14], (L, D), 0.02),
        "w_group": nrm(ks[15], (L, D, N_GROUPS), D ** -0.5),
        "b_group": nrm(ks[16], (L, N_GROUPS), 0.01),
        "w_expert_router": nrm(ks[17], (L, D, N_EXPERTS), D ** -0.5),
        "b_expert_router": nrm(ks[18], (L, N_EXPERTS), 0.01),
        "w_gate": nrm(ks[19], (L, N_EXPERTS, D, EXPERT_FF), D ** -0.5),
        "w_up": nrm(ks[20], (L, N_EXPERTS, D, EXPERT_FF), D ** -0.5),
        "w_down": nrm(ks[21], (L, N_EXPERTS, EXPERT_FF, D), EXPERT_FF ** -0.5),
        "norm_f_g": 1.0 + nrm(ks[22], (D,), 0.02),
    }


def reference(x, norm1_g, w_in, conv_w, conv_b, lru_wa, lru_ba, lru_wx, lru_bx, lru_lambda,
              w_proj_attn, w_proj_rnn, w_out, rel_bias, norm2_g, w_group, b_group,
              w_expert_router, b_expert_router, w_gate, w_up, w_down, norm_f_g):
    B, S, D = x.shape
    for l in range(DEPTH):
        u = rms_norm(x, norm1_g[l])
        proj = u @ w_in[l]
        q, k, v, qi, ki, wi, xr, rgate, ga, gr = split_cols(proj)
        q = q.reshape(B, S, ATTN_HEADS, HEAD_DIM)
        k = k.reshape(B, S, KV_HEADS, HEAD_DIM)
        v = v.reshape(B, S, KV_HEADS, HEAD_DIM)
        qi = qi.reshape(B, S, IDX_HEADS, IDX_DIM)
        attn = dsa_attention(q, k, v, qi, ki, wi, rel_bias)
        rnn = rg_lru_branch(xr, rgate, conv_w[l], conv_b[l], lru_wa[l], lru_ba[l],
                            lru_wx[l], lru_bx[l], lru_lambda[l])
        merged = (jax.nn.sigmoid(ga) * (attn @ w_proj_attn[l])
                  + jax.nn.sigmoid(gr) * (rnn @ w_proj_rnn[l]))
        x = x + merged @ w_out[l]
        u2 = rms_norm(x, norm2_g[l]).reshape(B * S, D)
        y = hier_moe(u2, w_group[l], b_group[l], w_expert_router[l], b_expert_router[l],
                     w_gate[l], w_up[l], w_down[l])
        x = x + y.reshape(B, S, D)
    return rms_norm(x, norm_f_g)
```

```cpp
#include <hip/hip_runtime.h>
#include <stdint.h>

namespace {
constexpr int kS = 4096, kT = 8192, kD = 2048;
constexpr int kNC = 8784;
constexpr int OFF_Q = 0, OFF_K = 1024, OFF_V = 1280, OFF_QI = 1536, OFF_KI = 2560, OFF_WI = 2624, OFF_XR = 2640,
              OFF_RG = 3664, OFF_GA = 4688, OFF_GR = 6736;
constexpr int kNT = 512;
constexpr int kTopK = 256;
constexpr int kNE = 64, kFF = 512, kSlots = 2 * kT;
constexpr int kChunk = 64, kNChunk = kS / kChunk;

struct Params {
    const float *x, *norm1_g, *w_in, *conv_w, *conv_b, *lru_wa, *lru_ba, *lru_wx, *lru_bx, *lru_lambda, *w_proj_attn,
        *w_proj_rnn, *w_out, *rel_bias, *norm2_g, *w_group, *b_group, *w_er, *b_er, *w_gate, *w_up, *w_down, *norm_f_g;
    float* out;
    float *u, *proj, *attn, *bufA, *bufB, *chA, *chH, *carry, *rnn, *merged, *x2, *u2, *hbuf, *ew, *lw;
    unsigned char* mask;
    int *eid, *ltok, *ecnt, *eoff;
};

__device__ __forceinline__ float wave_sum(float v) {
#pragma unroll
    for (int o = 32; o; o >>= 1) v += __shfl_xor(v, o);
    return v;
}
__device__ __forceinline__ int wave_sum_i(int v) {
#pragma unroll
    for (int o = 32; o; o >>= 1) v += __shfl_xor(v, o);
    return v;
}
__device__ __forceinline__ float block_sum(float v, float* red) {
    v = wave_sum(v);
    __syncthreads();
    if ((threadIdx.x & 63) == 0) red[threadIdx.x >> 6] = v;
    __syncthreads();
    float s = 0.f;
#pragma unroll
    for (int i = 0; i < 8; ++i) s += red[i];
    return s;
}
__device__ __forceinline__ int block_sum_i(int v, int* red) {
    v = wave_sum_i(v);
    __syncthreads();
    if ((threadIdx.x & 63) == 0) red[threadIdx.x >> 6] = v;
    __syncthreads();
    int s = 0;
#pragma unroll
    for (int i = 0; i < 8; ++i) s += red[i];
    return s;
}
__device__ __forceinline__ int block_excl_scan_i(int v, int* red, int* tot) {
    const int lane = threadIdx.x & 63, w = threadIdx.x >> 6;
    int inc = v;
#pragma unroll
    for (int o = 1; o < 64; o <<= 1) { int n = __shfl_up(inc, o); if (lane >= o) inc += n; }
    __syncthreads();
    if (lane == 63) red[w] = inc;
    __syncthreads();
    int base = 0, t = 0;
#pragma unroll
    for (int i = 0; i < 8; ++i) { int r = red[i]; if (i < w) base += r; t += r; }
    *tot = t;
    return base + inc - v;
}
__device__ __forceinline__ float sigmoidf_(float x) { return 1.0f / (1.0f + expf(-x)); }
__device__ __forceinline__ float gelu_tanh(float x) {
    const float c = 0.7978845608028654f;
    return 0.5f * x * (1.0f + tanhf(c * (x + 0.044715f * x * x * x)));
}

__device__ __forceinline__ void gemm_tile_f32(float (&acc)[8][4], const float* __restrict__ A, int lda, const int* __restrict__ rowidx,
                                              int m0, int mvalid, const float* __restrict__ Bm, int ldb, int n0, int nvalid, int K,
                                              float* lds) {
    float* As = lds;
    float* Bs = lds + 16 * 132;
    const int tid = threadIdx.x, ty = tid >> 5, tx = tid & 31;
    const int ar = tid >> 2, akq = (tid & 3) * 4;
    const int gr = m0 + ar;
    const bool aval = gr < mvalid;
    const float* arow = A + (size_t)(aval ? (rowidx ? rowidx[gr] : gr) : 0) * lda + akq;
    const int bk = tid >> 5, bc = (tid & 31) * 4;
    const bool bval = (n0 + bc) < nvalid;
    const float* bptr = Bm + (size_t)bk * ldb + n0 + bc;
    for (int k0 = 0; k0 < K; k0 += 16) {
        float4 av = aval ? *(const float4*)(arow + k0) : make_float4(0.f, 0.f, 0.f, 0.f);
        float4 bv = bval ? *(const float4*)(bptr + (size_t)k0 * ldb) : make_float4(0.f, 0.f, 0.f, 0.f);
        __syncthreads();
        As[(akq + 0) * 132 + ar] = av.x; As[(akq + 1) * 132 + ar] = av.y; As[(akq + 2) * 132 + ar] = av.z; As[(akq + 3) * 132 + ar] = av.w;
        *(float4*)(Bs + bk * 128 + bc) = bv;
        __syncthreads();
#pragma unroll
        for (int kk = 0; kk < 16; ++kk) {
            const float4 a0 = *(const float4*)(As + kk * 132 + ty * 8), a1 = *(const float4*)(As + kk * 132 + ty * 8 + 4);
            const float4 b = *(const float4*)(Bs + kk * 128 + tx * 4);
            const float a[8] = {a0.x, a0.y, a0.z, a0.w, a1.x, a1.y, a1.z, a1.w};
            const float bb[4] = {b.x, b.y, b.z, b.w};
#pragma unroll
            for (int i = 0; i < 8; ++i)
#pragma unroll
                for (int j = 0; j < 4; ++j) acc[i][j] = fmaf(a[i], bb[j], acc[i][j]);
        }
    }
    __syncthreads();
}
__device__ __forceinline__ void zero_acc(float (&acc)[8][4]) {
#pragma unroll
    for (int i = 0; i < 8; ++i)
#pragma unroll
        for (int j = 0; j < 4; ++j) acc[i][j] = 0.f;
}

enum { PH_NORM1 = 0, PH_PROJ, PH_INDEX, PH_ATTN, PH_RNNA, PH_SCAN, PH_CARRY, PH_FIX, PH_MERGE, PH_WOUT, PH_ROUTE, PH_LISTS, PH_EXP1, PH_EXP2, PH_FINAL, PH_COUNT };

__device__ __forceinline__ int phase_units(int ph) {
    switch (ph) {
        case PH_NORM1: return kT;
        case PH_PROJ: return 64 * 69;
        case PH_INDEX: return kT;
        case PH_ATTN: return kT;
        case PH_RNNA: return kT;
        case PH_SCAN: return 2 * kNChunk * 2;
        case PH_CARRY: return 4;
        case PH_FIX: return kT;
        case PH_MERGE: return 64 * 16;
        case PH_WOUT: return 64 * 16;
        case PH_ROUTE: return kT;
        case PH_LISTS: return kNE;
        case PH_EXP1: return 192 * 4;
        case PH_EXP2: return 192 * 16;
        case PH_FINAL: return kT;
    }
    return 0;
}

__device__ __forceinline__ void ph_norm(const float* __restrict__ X, const float* __restrict__ g, float* __restrict__ Y, int t, float* lds) {
    const int tid = threadIdx.x;
    const float4 v = *(const float4*)(X + (size_t)t * kD + tid * 4);
    const float ss = block_sum(v.x * v.x + v.y * v.y + v.z * v.z + v.w * v.w, lds);
    const float sc = rsqrtf(ss * (1.0f / kD) + 1e-6f);
    const float4 gg = *(const float4*)(g + tid * 4);
    float4 o; o.x = v.x * sc * gg.x; o.y = v.y * sc * gg.y; o.z = v.z * sc * gg.z; o.w = v.w * sc * gg.w;
    *(float4*)(Y + (size_t)t * kD + tid * 4) = o;
}

__device__ __forceinline__ void ph_proj(const Params& p, int vb, float* lds) {
    const int mt = vb / 69, nt = vb % 69;
    float acc[8][4]; zero_acc(acc);
    gemm_tile_f32(acc, p.u, kD, nullptr, mt * 128, kT, p.w_in, kNC, nt * 128, kNC, kD, lds);
    const int ty = threadIdx.x >> 5, tx = threadIdx.x & 31;
    const int c = nt * 128 + tx * 4;
    if (c < kNC) {
#pragma unroll
        for (int i = 0; i < 8; ++i) {
            const int r = mt * 128 + ty * 8 + i;
            *(float4*)(p.proj + (size_t)r * kNC + c) = make_float4(acc[i][0], acc[i][1], acc[i][2], acc[i][3]);
        }
    }
}

__device__ __forceinline__ unsigned fkey(float f) { unsigned b = __float_as_uint(f); return (b & 0x80000000u) ? ~b : (b | 0x80000000u); }

__device__ __forceinline__ void ph_index(const Params& p, int t, float* lds) {
    float* qs = lds;
    float* ws = lds + 1024;
    float* red = lds + 1040;
    const int tid = threadIdx.x;
    const int b = t / kS, pos = t % kS;
    __syncthreads();
    {
        const float* qrow = p.proj + (size_t)t * kNC + OFF_QI;
        qs[tid] = qrow[tid]; qs[tid + 512] = qrow[tid + 512];
        if (tid < 16) ws[tid] = p.proj[(size_t)t * kNC + OFF_WI + tid] * 0.25f;
    }
    __syncthreads();
    unsigned key[8];
    const int s0 = tid * 8;
#pragma unroll 1
    for (int j = 0; j < 8; ++j) {
        const int s = s0 + j;
        unsigned kv = 0u;
        if (s <= pos) {
            const float* krow = p.proj + (size_t)(b * kS + s) * kNC + OFF_KI;
            float kr[64];
#pragma unroll
            for (int d = 0; d < 64; d += 4) { const float4 v = *(const float4*)(krow + d); kr[d] = v.x; kr[d + 1] = v.y; kr[d + 2] = v.z; kr[d + 3] = v.w; }
            float sc = 0.f;
#pragma unroll 1
            for (int h = 0; h < 16; ++h) {
                float dot = 0.f;
#pragma unroll
                for (int d = 0; d < 64; d += 4) {
                    const float4 q = *(const float4*)(qs + h * 64 + d);
                    dot = fmaf(q.x, kr[d], dot); dot = fmaf(q.y, kr[d + 1], dot); dot = fmaf(q.z, kr[d + 2], dot); dot = fmaf(q.w, kr[d + 3], dot);
                }
                dot *= 0.125f;
                sc = fmaf(fmaxf(dot, 0.f), ws[h], sc);
            }
            kv = fkey(sc);
        }
#pragma unroll
        for (int jj = 0; jj < 8; ++jj) if (jj == j) key[jj] = kv;
    }
    const int n = pos + 1;
    unsigned mbyte = 0u;
    if (n <= kTopK) {
#pragma unroll
        for (int j = 0; j < 8; ++j) if (s0 + j <= pos) mbyte |= 1u << j;
    } else {
        int* redi = (int*)red;
        unsigned Kth = 0u;
        for (int bit = 31; bit >= 0; --bit) {
            const unsigned cand = Kth | (1u << bit);
            int c = 0;
#pragma unroll
            for (int j = 0; j < 8; ++j) c += (s0 + j <= pos && key[j] >= cand) ? 1 : 0;
            c = block_sum_i(c, redi);
            if (c >= kTopK) Kth = cand;
        }
        int cgt = 0, ceq = 0;
#pragma unroll
        for (int j = 0; j < 8; ++j) { const bool v = s0 + j <= pos; cgt += (v && key[j] > Kth) ? 1 : 0; ceq += (v && key[j] == Kth) ? 1 : 0; }
        const int tot_gt = block_sum_i(cgt, redi);
        const int need = kTopK - tot_gt;
        int tot_eq;
        int rank = block_excl_scan_i(ceq, redi, &tot_eq);
#pragma unroll
        for (int j = 0; j < 8; ++j) {
            const bool v = s0 + j <= pos;
            if (v && key[j] > Kth) mbyte |= 1u << j;
            else if (v && key[j] == Kth) { if (rank < need) mbyte |= 1u << j; ++rank; }
        }
    }
    p.mask[(size_t)t * 512 + tid] = (unsigned char)mbyte;
}

__device__ __forceinline__ int rel_bucket(int n) {
    if (n < 16) return n;
    const float v = logf((float)n / 16.0f) / 2.0794415416798357f * 16.0f;
    int l = 16 + (int)v;
    return l < 31 ? l : 31;
}

__device__ __forceinline__ void ph_attn(const Params& p, int t, float* lds) {
    float* qs = lds;
    float* lg = lds + 1024;
    int* sel = (int*)(lds + 3072);
    int* redi = (int*)(lds + 3328);
    const int tid = threadIdx.x;
    const int b = t / kS, pos = t % kS;
    __syncthreads();
    {
        const float* qrow = p.proj + (size_t)t * kNC + OFF_Q;
        qs[tid] = qrow[tid]; qs[tid + 512] = qrow[tid + 512];
    }
    const unsigned mb = p.mask[(size_t)t * 512 + tid];
    int tot;
    int off = block_excl_scan_i(__popc(mb), redi, &tot);
#pragma unroll
    for (int j = 0; j < 8; ++j) if (mb & (1u << j)) { if (off < kTopK) sel[off] = tid * 8 + j; ++off; }
    const int nsel = tot < kTopK ? tot : kTopK;
    __syncthreads();
    {
        const int j = tid & 255, g = tid >> 8;
        if (j < nsel) {
            const int s = sel[j];
            const float* krow = p.proj + (size_t)(b * kS + s) * kNC + OFF_K + g * 128;
            float d0 = 0.f, d1 = 0.f, d2 = 0.f, d3 = 0.f;
            const float* q0 = qs + (g * 4) * 128;
#pragma unroll 4
            for (int d = 0; d < 128; d += 4) {
                const float4 kv = *(const float4*)(krow + d);
                const float4 a0 = *(const float4*)(q0 + d), a1 = *(const float4*)(q0 + 128 + d), a2 = *(const float4*)(q0 + 256 + d), a3 = *(const float4*)(q0 + 384 + d);
                d0 = fmaf(a0.x, kv.x, d0); d0 = fmaf(a0.y, kv.y, d0); d0 = fmaf(a0.z, kv.z, d0); d0 = fmaf(a0.w, kv.w, d0);
                d1 = fmaf(a1.x, kv.x, d1); d1 = fmaf(a1.y, kv.y, d1); d1 = fmaf(a1.z, kv.z, d1); d1 = fmaf(a1.w, kv.w, d1);
                d2 = fmaf(a2.x, kv.x, d2); d2 = fmaf(a2.y, kv.y, d2); d2 = fmaf(a2.z, kv.z, d2); d2 = fmaf(a2.w, kv.w, d2);
                d3 = fmaf(a3.x, kv.x, d3); d3 = fmaf(a3.y, kv.y, d3); d3 = fmaf(a3.z, kv.z, d3); d3 = fmaf(a3.w, kv.w, d3);
            }
            const float sc = 0.08838834764831845f;
            const float* bias = p.rel_bias + rel_bucket(pos - s) * 8 + g * 4;
            lg[(g * 4 + 0) * 256 + j] = d0 * sc + bias[0];
            lg[(g * 4 + 1) * 256 + j] = d1 * sc + bias[1];
            lg[(g * 4 + 2) * 256 + j] = d2 * sc + bias[2];
            lg[(g * 4 + 3) * 256 + j] = d3 * sc + bias[3];
        }
    }
    __syncthreads();
    {
        const int h = tid >> 6, lane = tid & 63;
        float v[4], m = -INFINITY;
#pragma unroll
        for (int i = 0; i < 4; ++i) { const int j = lane + 64 * i; v[i] = j < nsel ? lg[h * 256 + j] : -INFINITY; m = fmaxf(m, v[i]); }
#pragma unroll
        for (int o = 32; o; o >>= 1) m = fmaxf(m, __shfl_xor(m, o));
        float s = 0.f;
#pragma unroll
        for (int i = 0; i < 4; ++i) { v[i] = (lane + 64 * i) < nsel ? expf(v[i] - m) : 0.f; s += v[i]; }
        s = wave_sum(s);
        const float inv = 1.0f / s;
#pragma unroll
        for (int i = 0; i < 4; ++i) { const int j = lane + 64 * i; if (j < nsel) lg[h * 256 + j] = v[i] * inv; }
    }
    __syncthreads();
#pragma unroll
    for (int r = 0; r < 2; ++r) {
        const int idx = tid + r * 512, h = idx >> 7, d = idx & 127, g = h >> 2;
        const float* vb = p.proj + (size_t)(b * kS) * kNC + OFF_V + g * 128 + d;
        float o = 0.f;
        for (int j = 0; j < nsel; ++j) o = fmaf(lg[h * 256 + j], vb[(size_t)sel[j] * kNC], o);
        p.attn[(size_t)t * 1024 + idx] = o;
    }
}

__device__ __forceinline__ void ph_rnna(const Params& p, int t, float* lds) {
    float* xcs = lds;
    const int tid = threadIdx.x, pos = t % kS;
    __syncthreads();
#pragma unroll
    for (int r = 0; r < 2; ++r) {
        const int c = tid + r * 512;
        float xc = p.conv_b[c];
#pragma unroll
        for (int j = 0; j < 4; ++j) {
            const int pp = pos - 3 + j;
            const float xv = pp >= 0 ? p.proj[(size_t)(t - 3 + j) * kNC + OFF_XR + c] : 0.f;
            xc = xc + xv * p.conv_w[j * 1024 + c];
        }
        xcs[c] = xc;
    }
    __syncthreads();
#pragma unroll
    for (int r = 0; r < 2; ++r) {
        const int c = tid + r * 512, n = c >> 7, d = c & 127;
        float ra = 0.f, ia = 0.f;
        const float* wa = p.lru_wa + (size_t)n * 128 * 128 + d;
        const float* wx = p.lru_wx + (size_t)n * 128 * 128 + d;
        for (int cc = 0; cc < 128; ++cc) { const float xv = xcs[n * 128 + cc]; ra = fmaf(xv, wa[cc * 128], ra); ia = fmaf(xv, wx[cc * 128], ia); }
        const float rg = sigmoidf_(ra + p.lru_ba[c]), ig = sigmoidf_(ia + p.lru_bx[c]);
        const float sp = log1pf(expf(-p.lru_lambda[c]));
        const float log_a = -8.0f * rg * sp;
        const float a = expf(log_a);
        const float mult = sqrtf(-expm1f(2.0f * log_a));
        p.bufA[(size_t)t * 1024 + c] = a;
        p.bufB[(size_t)t * 1024 + c] = mult * (ig * xcs[c]);
    }
}

__device__ __forceinline__ void ph_scan(const Params& p, int vb) {
    const int half = vb & 1, ch = (vb >> 1) % kNChunk, b = vb / (2 * kNChunk);
    const int c = half * 512 + threadIdx.x;
    const size_t t0 = (size_t)b * kS + (size_t)ch * kChunk;
    float h = 0.f, P = 1.f;
    for (int s = 0; s < kChunk; ++s) {
        const size_t i = (t0 + s) * 1024 + c;
        const float a = p.bufA[i], bt = p.bufB[i];
        h = fmaf(a, h, bt); P *= a;
        p.bufA[i] = P; p.bufB[i] = h;
    }
    p.chA[(size_t)(b * kNChunk + ch) * 1024 + c] = P;
    p.chH[(size_t)(b * kNChunk + ch) * 1024 + c] = h;
}
__device__ __forceinline__ void ph_carry(const Params& p, int vb) {
    const int half = vb & 1, b = vb >> 1;
    const int c = half * 512 + threadIdx.x;
    float H = 0.f;
    for (int ch = 0; ch < kNChunk; ++ch) {
        const size_t i = (size_t)(b * kNChunk + ch) * 1024 + c;
        p.carry[i] = H;
        H = fmaf(p.chA[i], H, p.chH[i]);
    }
}
__device__ __forceinline__ void ph_fix(const Params& p, int t) {
    const int b = t / kS, ch = (t % kS) / kChunk;
#pragma unroll
    for (int r = 0; r < 2; ++r) {
        const int c = threadIdx.x + r * 512;
        const size_t i = (size_t)t * 1024 + c;
        const float h = fmaf(p.bufA[i], p.carry[(size_t)(b * kNChunk + ch) * 1024 + c], p.bufB[i]);
        p.rnn[i] = h * gelu_tanh(p.proj[(size_t)t * kNC + OFF_RG + c]);
    }
}

__device__ __forceinline__ void ph_merge(const Params& p, int vb, float* lds) {
    const int mt = vb / 16, nt = vb % 16;
    float a1[8][4], a2[8][4]; zero_acc(a1); zero_acc(a2);
    gemm_tile_f32(a1, p.attn, 1024, nullptr, mt * 128, kT, p.w_proj_attn, kD, nt * 128, kD, 1024, lds);
    gemm_tile_f32(a2, p.rnn, 1024, nullptr, mt * 128, kT, p.w_proj_rnn, kD, nt * 128, kD, 1024, lds);
    const int ty = threadIdx.x >> 5, tx = threadIdx.x & 31;
    const int c = nt * 128 + tx * 4;
#pragma unroll
    for (int i = 0; i < 8; ++i) {
        const int r = mt * 128 + ty * 8 + i;
        const float4 ga = *(const float4*)(p.proj + (size_t)r * kNC + OFF_GA + c), gr = *(const float4*)(p.proj + (size_t)r * kNC + OFF_GR + c);
        float4 o;
        o.x = sigmoidf_(ga.x) * a1[i][0] + sigmoidf_(gr.x) * a2[i][0];
        o.y = sigmoidf_(ga.y) * a1[i][1] + sigmoidf_(gr.y) * a2[i][1];
        o.z = sigmoidf_(ga.z) * a1[i][2] + sigmoidf_(gr.z) * a2[i][2];
        o.w = sigmoidf_(ga.w) * a1[i][3] + sigmoidf_(gr.w) * a2[i][3];
        *(float4*)(p.merged + (size_t)r * kD + c) = o;
    }
}
__device__ __forceinline__ void ph_wout(const Params& p, int vb, float* lds) {
    const int mt = vb / 16, nt = vb % 16;
    float acc[8][4]; zero_acc(acc);
    gemm_tile_f32(acc, p.merged, kD, nullptr, mt * 128, kT, p.w_out, kD, nt * 128, kD, kD, lds);
    const int ty = threadIdx.x >> 5, tx = threadIdx.x & 31;
    const int c = nt * 128 + tx * 4;
#pragma unroll
    for (int i = 0; i < 8; ++i) {
        const int r = mt * 128 + ty * 8 + i;
        const float4 xv = *(const float4*)(p.x + (size_t)r * kD + c);
        *(float4*)(p.x2 + (size_t)r * kD + c) = make_float4(xv.x + acc[i][0], xv.y + acc[i][1], xv.z + acc[i][2], xv.w + acc[i][3]);
    }
}

__device__ __forceinline__ void ph_route(const Params& p, int t, float* lds) {
    float* row = lds;
    float* part = lds + 2048;
    float* lgt = lds + 2560;
    float* red = lds + 2640;
    const int tid = threadIdx.x;
    __syncthreads();
    const float4 v = *(const float4*)(p.x2 + (size_t)t * kD + tid * 4);
    const float ss = block_sum(v.x * v.x + v.y * v.y + v.z * v.z + v.w * v.w, red);
    const float sc = rsqrtf(ss * (1.0f / kD) + 1e-6f);
    const float4 gg = *(const float4*)(p.norm2_g + tid * 4);
    float4 o; o.x = v.x * sc * gg.x; o.y = v.y * sc * gg.y; o.z = v.z * sc * gg.z; o.w = v.w * sc * gg.w;
    *(float4*)(p.u2 + (size_t)t * kD + tid * 4) = o;
    *(float4*)(row + tid * 4) = o;
    __syncthreads();
    if (tid < 504) {
        const int kp = tid / 72, j = tid % 72;
        const int k0 = kp * 293, k1 = (k0 + 293) < kD ? (k0 + 293) : kD;
        float a = 0.f;
        if (j < 8) { for (int k = k0; k < k1; ++k) a = fmaf(row[k], p.w_group[(size_t)k * 8 + j], a); }
        else       { for (int k = k0; k < k1; ++k) a = fmaf(row[k], p.w_er[(size_t)k * 64 + (j - 8)], a); }
        part[kp * 72 + j] = a;
    }
    __syncthreads();
    if (tid < 72) {
        float a = 0.f;
#pragma unroll
        for (int kp = 0; kp < 7; ++kp) a += part[kp * 72 + tid];
        a += tid < 8 ? p.b_group[tid] : p.b_er[tid - 8];
        lgt[tid] = a;
    }
    __syncthreads();
    if (tid == 0) {
        int g = 0; float m = lgt[0];
        for (int i = 1; i < 8; ++i) if (lgt[i] > m) { m = lgt[i]; g = i; }
        float den = 0.f;
        for (int i = 0; i < 8; ++i) den += expf(lgt[i] - m);
        const float psel = 1.0f / den;
        const float* el = lgt + 8 + g * 8;
        int e0 = 0; float v0 = el[0];
        for (int i = 1; i < 8; ++i) if (el[i] > v0) { v0 = el[i]; e0 = i; }
        int e1 = -1; float v1 = -INFINITY;
        for (int i = 0; i < 8; ++i) if (i != e0 && el[i] > v1) { v1 = el[i]; e1 = i; }
        const float ex = expf(v1 - v0);
        const float w0 = 1.0f / (1.0f + ex), w1 = ex / (1.0f + ex);
        p.eid[t * 2 + 0] = g * 8 + e0; p.eid[t * 2 + 1] = g * 8 + e1;
        p.ew[t * 2 + 0] = psel * w0; p.ew[t * 2 + 1] = psel * w1;
    }
}

__device__ __forceinline__ void ph_lists(const Params& p, int e, float* lds) {
    int* redi = (int*)lds;
    const int tid = threadIdx.x;
    int clt = 0, ceq = 0;
    for (int s = tid; s < kSlots; s += kNT) { const int x = p.eid[s]; clt += x < e ? 1 : 0; ceq += x == e ? 1 : 0; }
    const int off = block_sum_i(clt, redi);
    const int cnt = block_sum_i(ceq, redi);
    if (tid == 0) { p.ecnt[e] = cnt; p.eoff[e] = off; }
    int base = off;
    for (int s0 = 0; s0 < kSlots; s0 += kNT) {
        const int s = s0 + tid;
        const int f = p.eid[s] == e ? 1 : 0;
        int tot;
        const int pos = block_excl_scan_i(f, redi, &tot);
        if (f) { p.ltok[base + pos] = s >> 1; p.lw[base + pos] = p.ew[s]; }
        base += tot;
    }
}

__device__ __forceinline__ bool find_expert_tile(const Params& p, int mtile, int& e, int& mt) {
    int acc = 0;
    for (int i = 0; i < kNE; ++i) {
        const int n = (p.ecnt[i] + 127) >> 7;
        if (mtile < acc + n) { e = i; mt = mtile - acc; return true; }
        acc += n;
    }
    return false;
}

__device__ __forceinline__ void ph_exp1(const Params& p, int vb, float* lds) {
    const int nt = vb & 3, mtile = vb >> 2;
    int e, mt;
    if (!find_expert_tile(p, mtile, e, mt)) return;
    const int cnt = p.ecnt[e], off = p.eoff[e];
    float ag[8][4], au[8][4]; zero_acc(ag); zero_acc(au);
    gemm_tile_f32(ag, p.u2, kD, p.ltok + off, mt * 128, cnt, p.w_gate + (size_t)e * kD * kFF, kFF, nt * 128, kFF, kD, lds);
    gemm_tile_f32(au, p.u2, kD, p.ltok + off, mt * 128, cnt, p.w_up + (size_t)e * kD * kFF, kFF, nt * 128, kFF, kD, lds);
    const int ty = threadIdx.x >> 5, tx = threadIdx.x & 31;
    const int c = nt * 128 + tx * 4;
#pragma unroll
    for (int i = 0; i < 8; ++i) {
        const int m = mt * 128 + ty * 8 + i;
        if (m < cnt) {
            float4 o;
            o.x = ag[i][0] * sigmoidf_(ag[i][0]) * au[i][0];
            o.y = ag[i][1] * sigmoidf_(ag[i][1]) * au[i][1];
            o.z = ag[i][2] * sigmoidf_(ag[i][2]) * au[i][2];
            o.w = ag[i][3] * sigmoidf_(ag[i][3]) * au[i][3];
            *(float4*)(p.hbuf + (size_t)(off + m) * kFF + c) = o;
        }
    }
}
__device__ __forceinline__ void ph_exp2(const Params& p, int vb, float* lds) {
    const int nt = vb & 15, mtile = vb >> 4;
    int e, mt;
    if (!find_expert_tile(p, mtile, e, mt)) return;
    const int cnt = p.ecnt[e], off = p.eoff[e];
    float acc[8][4]; zero_acc(acc);
    gemm_tile_f32(acc, p.hbuf + (size_t)off * kFF, kFF, nullptr, mt * 128, cnt, p.w_down + (size_t)e * kFF * kD, kD, nt * 128, kD, kFF, lds);
    const int ty = threadIdx.x >> 5, tx = threadIdx.x & 31;
    const int c = nt * 128 + tx * 4;
#pragma unroll
    for (int i = 0; i < 8; ++i) {
        const int m = mt * 128 + ty * 8 + i;
        if (m < cnt) {
            const int tok = p.ltok[off + m];
            const float w = p.lw[off + m];
            float* dst = p.x2 + (size_t)tok * kD + c;
#pragma unroll
            for (int j = 0; j < 4; ++j) atomicAdd(dst + j, acc[i][j] * w);
        }
    }
}

template <int PH>
__device__ __forceinline__ void run_phase(const Params& p, float* lds) {
    for (int vb = blockIdx.x; vb < phase_units(PH); vb += gridDim.x) {
        if constexpr (PH == PH_NORM1) ph_norm(p.x, p.norm1_g, p.u, vb, lds);
        else if constexpr (PH == PH_PROJ) ph_proj(p, vb, lds);
        else if constexpr (PH == PH_INDEX) ph_index(p, vb, lds);
        else if constexpr (PH == PH_ATTN) ph_attn(p, vb, lds);
        else if constexpr (PH == PH_RNNA) ph_rnna(p, vb, lds);
        else if constexpr (PH == PH_SCAN) ph_scan(p, vb);
        else if constexpr (PH == PH_CARRY) ph_carry(p, vb);
        else if constexpr (PH == PH_FIX) ph_fix(p, vb);
        else if constexpr (PH == PH_MERGE) ph_merge(p, vb, lds);
        else if constexpr (PH == PH_WOUT) ph_wout(p, vb, lds);
        else if constexpr (PH == PH_ROUTE) ph_route(p, vb, lds);
        else if constexpr (PH == PH_LISTS) ph_lists(p, vb, lds);
        else if constexpr (PH == PH_EXP1) ph_exp1(p, vb, lds);
        else if constexpr (PH == PH_EXP2) ph_exp2(p, vb, lds);
        else if constexpr (PH == PH_FINAL) ph_norm(p.x2, p.norm_f_g, p.out, vb, lds);
    }
}

template <int PH>
__global__ void __launch_bounds__(512, 2) k_phase(Params p) {
    __shared__ float lds[4352];
    run_phase<PH>(p, lds);
}

template <int PH>
void launch_phase(const Params& p, hipStream_t stream) {
    hipLaunchKernelGGL((k_phase<PH>), dim3(1024), dim3(kNT), 0, stream, p);
}
}

extern "C" void kernel_launch(void* const* d_in, const int* in_sizes, int n_in, void* d_out, int out_size, void* d_ws, size_t ws_size,
                              hipStream_t stream) {
    Params p{};
    const float* const* in = (const float* const*)d_in;
    p.x = in[0]; p.norm1_g = in[1]; p.w_in = in[2]; p.conv_w = in[3]; p.conv_b = in[4]; p.lru_wa = in[5]; p.lru_ba = in[6];
    p.lru_wx = in[7]; p.lru_bx = in[8]; p.lru_lambda = in[9]; p.w_proj_attn = in[10]; p.w_proj_rnn = in[11]; p.w_out = in[12];
    p.rel_bias = in[13]; p.norm2_g = in[14]; p.w_group = in[15]; p.b_group = in[16]; p.w_er = in[17]; p.b_er = in[18];
    p.w_gate = in[19]; p.w_up = in[20]; p.w_down = in[21]; p.norm_f_g = in[22];
    p.out = (float*)d_out;
    char* w = (char*)d_ws;
    size_t o = 0;
    auto take = [&](size_t bytes) { void* r = w + o; o += (bytes + 255) & ~(size_t)255; return r; };
    p.u = (float*)take((size_t)kT * kD * 4);
    p.proj = (float*)take((size_t)kT * kNC * 4);
    p.attn = (float*)take((size_t)kT * 1024 * 4);
    p.bufA = (float*)take((size_t)kT * 1024 * 4);
    p.bufB = (float*)take((size_t)kT * 1024 * 4);
    p.chA = (float*)take((size_t)2 * kNChunk * 1024 * 4);
    p.chH = (float*)take((size_t)2 * kNChunk * 1024 * 4);
    p.carry = (float*)take((size_t)2 * kNChunk * 1024 * 4);
    p.rnn = (float*)take((size_t)kT * 1024 * 4);
    p.merged = (float*)take((size_t)kT * kD * 4);
    p.x2 = (float*)take((size_t)kT * kD * 4);
    p.u2 = p.u;
    p.hbuf = (float*)take((size_t)kSlots * kFF * 4);
    p.ew = (float*)take((size_t)kSlots * 4);
    p.lw = (float*)take((size_t)kSlots * 4);
    p.mask = (unsigned char*)take((size_t)kT * 512);
    p.eid = (int*)take((size_t)kSlots * 4);
    p.ltok = (int*)take((size_t)kSlots * 4);
    p.ecnt = (int*)take(256);
    p.eoff = (int*)take(256);
    launch_phase<PH_NORM1>(p, stream);
    launch_phase<PH_PROJ>(p, stream);
    launch_phase<PH_INDEX>(p, stream);
    launch_phase<PH_ATTN>(p, stream);
    launch_phase<PH_RNNA>(p, stream);
    launch_phase<PH_SCAN>(p, stream);
    launch_phase<PH_CARRY>(p, stream);
    launch_phase<PH_FIX>(p, stream);
    launch_phase<PH_MERGE>(p, stream);
    launch_phase<PH_WOUT>(p, stream);
    launch_phase<PH_ROUTE>(p, stream);
    launch_phase<PH_LISTS>(p, stream);
    launch_phase<PH_EXP1>(p, stream);
    launch_phase<PH_EXP2>(p, stream);
    launch_phase<PH_FINAL>(p, stream);
}
```

```cpp
#include <hip/hip_runtime.h>
#include <stdint.h>
#include <cstdio>

#define XB_TMO      128
#define XB_XCNT(j)  (256  + 64 * (j))
#define XB_XSUB(j)  (1280 + 64 * (j))
#define XB_XGEN(j)  (2304 + 64 * (j))
#define XB_TOP      3328
#define XB_TOPGEN   3392
#define XCD_BAR_WORDS 3456
#define XB_SPIN_CAP (1u << 18)
#define LAS __attribute__((address_space(3)))

__device__ __forceinline__ unsigned xb_ld(unsigned* p)              { return __hip_atomic_load(p, __ATOMIC_RELAXED, __HIP_MEMORY_SCOPE_AGENT); }
__device__ __forceinline__ unsigned xb_add(unsigned* p, unsigned v) { return __hip_atomic_fetch_add(p, v, __ATOMIC_RELAXED, __HIP_MEMORY_SCOPE_AGENT); }
__device__ __forceinline__ unsigned xb_xcc_id() { return (unsigned)__builtin_amdgcn_s_getreg((3 << 11) | 20) & 0xFu; }
#define XB_SPIN(cond, bar) do { unsigned _sp = 0; while (cond) { __builtin_amdgcn_s_sleep(1); \
    if ((++_sp & 255u) == 0u) { if (xb_ld(&(bar)[XB_TMO])) break; if (_sp > XB_SPIN_CAP) { atomicAdd(&(bar)[XB_TMO], 1u); break; } } } } while (0)

struct XcdBarrier {
    unsigned* bar; unsigned x;
    volatile LAS unsigned* st;
};

__device__ __forceinline__ XcdBarrier xcd_barrier_post(unsigned* bar, volatile LAS unsigned* st) {
    XcdBarrier b; b.bar = bar; b.x = xb_xcc_id(); b.st = st;
    if (threadIdx.x == 0) (void)xb_add(&bar[XB_XCNT(b.x)], 1u);
    return b;
}
__device__ __forceinline__ void xcd_barrier_complete(unsigned* bar, unsigned x, unsigned& nloc, unsigned& nx) {
    const unsigned G = gridDim.x * gridDim.y * gridDim.z;
    unsigned sum, cnt, mine, sp = 0u;
    for (;;) {
        sum = 0u; cnt = 0u; mine = 0u;
#pragma unroll
        for (unsigned j = 0; j < 16; ++j) { const unsigned c = xb_ld(&bar[XB_XCNT(j)]); sum += c; cnt += (c > 0u) ? 1u : 0u; mine = (j == x) ? c : mine; }
        if (sum == G) break;
        __builtin_amdgcn_s_sleep(1);
        if ((++sp & 255u) == 0u) { if (xb_ld(&bar[XB_TMO])) break; if (sp > XB_SPIN_CAP) { atomicAdd(&bar[XB_TMO], 1u); break; } }
    }
    nloc = mine > 0u ? mine : 1u; nx = cnt > 0u ? cnt : 1u;
}

__device__ __forceinline__ void xcd_barrier(const XcdBarrier& b) {
    asm volatile("s_waitcnt vmcnt(0)" ::: "memory");
    __syncthreads();
    if (threadIdx.x == 0) {
        unsigned* bar = b.bar;
        __builtin_amdgcn_s_waitcnt(0);
        unsigned nloc = b.st[0], nx = b.st[1];
        if (nloc == 0u) { xcd_barrier_complete(bar, b.x, nloc, nx); b.st[0] = nloc; b.st[1] = nx; }
        const unsigned old = xb_add(&bar[XB_XSUB(b.x)], 1u);
        const unsigned gen = old / nloc;
        if (old + 1u == (gen + 1u) * nloc) {
            __builtin_amdgcn_fence(__ATOMIC_RELEASE, "agent");
            asm volatile("s_waitcnt vmcnt(0)" ::: "memory");
            const unsigned og = xb_add(&bar[XB_TOP], 1u);
            const unsigned tg = og / nx;
            if (og + 1u == (tg + 1u) * nx) xb_add(&bar[XB_TOPGEN], 1u);
            else XB_SPIN(xb_ld(&bar[XB_TOPGEN]) == tg, bar);
            __builtin_amdgcn_fence(__ATOMIC_ACQUIRE, "agent");
            xb_add(&bar[XB_XGEN(b.x)], 1u);
            asm volatile("s_waitcnt vmcnt(0)" ::: "memory");
        } else {
            XB_SPIN(xb_ld(&bar[XB_XGEN(b.x)]) == gen, bar);
            __builtin_amdgcn_fence(__ATOMIC_ACQUIRE, "agent");
            asm volatile("s_waitcnt vmcnt(0)" ::: "memory");
        }
    }
    __syncthreads();
}


namespace {
constexpr int kS = 4096, kT = 8192, kD = 2048;
constexpr int kNC = 8784;
constexpr int OFF_Q = 0, OFF_K = 1024, OFF_V = 1280, OFF_QI = 1536, OFF_KI = 2560, OFF_WI = 2624, OFF_XR = 2640,
              OFF_RG = 3664, OFF_GA = 4688, OFF_GR = 6736;
constexpr int kNT = 512;
constexpr int kTopK = 256;
constexpr int kNE = 64, kFF = 512, kSlots = 2 * kT;
constexpr int kChunk = 64, kNChunk = kS / kChunk;

struct Params {
    const float *x, *norm1_g, *w_in, *conv_w, *conv_b, *lru_wa, *lru_ba, *lru_wx, *lru_bx, *lru_lambda, *w_proj_attn,
        *w_proj_rnn, *w_out, *rel_bias, *norm2_g, *w_group, *b_group, *w_er, *b_er, *w_gate, *w_up, *w_down, *norm_f_g;
    float* out;
    float *u, *proj, *attn, *bufA, *bufB, *chA, *chH, *carry, *rnn, *merged, *x2, *u2, *hbuf, *ew, *lw;
    unsigned char* mask;
    int *eid, *ltok, *ecnt, *eoff;
    unsigned* bar;
};

__device__ __forceinline__ float wave_sum(float v) {
#pragma unroll
    for (int o = 32; o; o >>= 1) v += __shfl_xor(v, o);
    return v;
}
__device__ __forceinline__ int wave_sum_i(int v) {
#pragma unroll
    for (int o = 32; o; o >>= 1) v += __shfl_xor(v, o);
    return v;
}
__device__ __forceinline__ float block_sum(float v, float* red) {
    v = wave_sum(v);
    __syncthreads();
    if ((threadIdx.x & 63) == 0) red[threadIdx.x >> 6] = v;
    __syncthreads();
    float s = 0.f;
#pragma unroll
    for (int i = 0; i < 8; ++i) s += red[i];
    return s;
}
__device__ __forceinline__ int block_sum_i(int v, int* red) {
    v = wave_sum_i(v);
    __syncthreads();
    if ((threadIdx.x & 63) == 0) red[threadIdx.x >> 6] = v;
    __syncthreads();
    int s = 0;
#pragma unroll
    for (int i = 0; i < 8; ++i) s += red[i];
    return s;
}
__device__ __forceinline__ int block_excl_scan_i(int v, int* red, int* tot) {
    const int lane = threadIdx.x & 63, w = threadIdx.x >> 6;
    int inc = v;
#pragma unroll
    for (int o = 1; o < 64; o <<= 1) { int n = __shfl_up(inc, o); if (lane >= o) inc += n; }
    __syncthreads();
    if (lane == 63) red[w] = inc;
    __syncthreads();
    int base = 0, t = 0;
#pragma unroll
    for (int i = 0; i < 8; ++i) { int r = red[i]; if (i < w) base += r; t += r; }
    *tot = t;
    return base + inc - v;
}
__device__ __forceinline__ float sigmoidf_(float x) { return 1.0f / (1.0f + expf(-x)); }
__device__ __forceinline__ float gelu_tanh(float x) {
    const float c = 0.7978845608028654f;
    return 0.5f * x * (1.0f + tanhf(c * (x + 0.044715f * x * x * x)));
}

__device__ __forceinline__ void gemm_tile_f32(float (&acc)[8][4], const float* __restrict__ A, int lda, const int* __restrict__ rowidx,
                                              int m0, int mvalid, const float* __restrict__ Bm, int ldb, int n0, int nvalid, int K,
                                              float* lds) {
    float* As = lds;
    float* Bs = lds + 16 * 132;
    const int tid = threadIdx.x, ty = tid >> 5, tx = tid & 31;
    const int ar = tid >> 2, akq = (tid & 3) * 4;
    const int gr = m0 + ar;
    const bool aval = gr < mvalid;
    const float* arow = A + (size_t)(aval ? (rowidx ? rowidx[gr] : gr) : 0) * lda + akq;
    const int bk = tid >> 5, bc = (tid & 31) * 4;
    const bool bval = (n0 + bc) < nvalid;
    const float* bptr = Bm + (size_t)bk * ldb + n0 + bc;
    for (int k0 = 0; k0 < K; k0 += 16) {
        float4 av = aval ? *(const float4*)(arow + k0) : make_float4(0.f, 0.f, 0.f, 0.f);
        float4 bv = bval ? *(const float4*)(bptr + (size_t)k0 * ldb) : make_float4(0.f, 0.f, 0.f, 0.f);
        __syncthreads();
        As[(akq + 0) * 132 + ar] = av.x; As[(akq + 1) * 132 + ar] = av.y; As[(akq + 2) * 132 + ar] = av.z; As[(akq + 3) * 132 + ar] = av.w;
        *(float4*)(Bs + bk * 128 + bc) = bv;
        __syncthreads();
#pragma unroll
        for (int kk = 0; kk < 16; ++kk) {
            const float4 a0 = *(const float4*)(As + kk * 132 + ty * 8), a1 = *(const float4*)(As + kk * 132 + ty * 8 + 4);
            const float4 b = *(const float4*)(Bs + kk * 128 + tx * 4);
            const float a[8] = {a0.x, a0.y, a0.z, a0.w, a1.x, a1.y, a1.z, a1.w};
            const float bb[4] = {b.x, b.y, b.z, b.w};
#pragma unroll
            for (int i = 0; i < 8; ++i)
#pragma unroll
                for (int j = 0; j < 4; ++j) acc[i][j] = fmaf(a[i], bb[j], acc[i][j]);
        }
    }
    __syncthreads();
}
__device__ __forceinline__ void zero_acc(float (&acc)[8][4]) {
#pragma unroll
    for (int i = 0; i < 8; ++i)
#pragma unroll
        for (int j = 0; j < 4; ++j) acc[i][j] = 0.f;
}

enum { PH_NORM1 = 0, PH_PROJ, PH_INDEX, PH_ATTN, PH_RNNA, PH_SCAN, PH_CARRY, PH_FIX, PH_MERGE, PH_WOUT, PH_ROUTE, PH_LISTS, PH_EXP1, PH_EXP2, PH_FINAL, PH_COUNT };

__device__ __forceinline__ int phase_units(int ph) {
    switch (ph) {
        case PH_NORM1: return kT;
        case PH_PROJ: return 64 * 69;
        case PH_INDEX: return kT;
        case PH_ATTN: return kT;
        case PH_RNNA: return kT;
        case PH_SCAN: return 2 * kNChunk * 2;
        case PH_CARRY: return 4;
        case PH_FIX: return kT;
        case PH_MERGE: return 64 * 16;
        case PH_WOUT: return 64 * 16;
        case PH_ROUTE: return kT;
        case PH_LISTS: return kNE;
        case PH_EXP1: return 192 * 4;
        case PH_EXP2: return 192 * 16;
        case PH_FINAL: return kT;
    }
    return 0;
}

__device__ __forceinline__ void ph_norm(const float* __restrict__ X, const float* __restrict__ g, float* __restrict__ Y, int t, float* lds) {
    const int tid = threadIdx.x;
    const float4 v = *(const float4*)(X + (size_t)t * kD + tid * 4);
    const float ss = block_sum(v.x * v.x + v.y * v.y + v.z * v.z + v.w * v.w, lds);
    const float sc = rsqrtf(ss * (1.0f / kD) + 1e-6f);
    const float4 gg = *(const float4*)(g + tid * 4);
    float4 o; o.x = v.x * sc * gg.x; o.y = v.y * sc * gg.y; o.z = v.z * sc * gg.z; o.w = v.w * sc * gg.w;
    *(float4*)(Y + (size_t)t * kD + tid * 4) = o;
}

__device__ __forceinline__ void ph_proj(const Params& p, int vb, float* lds) {
    const int mt = vb / 69, nt = vb % 69;
    float acc[8][4]; zero_acc(acc);
    gemm_tile_f32(acc, p.u, kD, nullptr, mt * 128, kT, p.w_in, kNC, nt * 128, kNC, kD, lds);
    const int ty = threadIdx.x >> 5, tx = threadIdx.x & 31;
    const int c = nt * 128 + tx * 4;
    if (c < kNC) {
#pragma unroll
        for (int i = 0; i < 8; ++i) {
            const int r = mt * 128 + ty * 8 + i;
            *(float4*)(p.proj + (size_t)r * kNC + c) = make_float4(acc[i][0], acc[i][1], acc[i][2], acc[i][3]);
        }
    }
}

__device__ __forceinline__ unsigned fkey(float f) { unsigned b = __float_as_uint(f); return (b & 0x80000000u) ? ~b : (b | 0x80000000u); }

__device__ __forceinline__ void ph_index(const Params& p, int t, float* lds) {
    float* qs = lds;
    float* ws = lds + 1024;
    float* red = lds + 1040;
    const int tid = threadIdx.x;
    const int b = t / kS, pos = t % kS;
    __syncthreads();
    {
        const float* qrow = p.proj + (size_t)t * kNC + OFF_QI;
        qs[tid] = qrow[tid]; qs[tid + 512] = qrow[tid + 512];
        if (tid < 16) ws[tid] = p.proj[(size_t)t * kNC + OFF_WI + tid] * 0.25f;
    }
    __syncthreads();
    unsigned key[8];
    const int s0 = tid * 8;
#pragma unroll 1
    for (int j = 0; j < 8; ++j) {
        const int s = s0 + j;
        unsigned kv = 0u;
        if (s <= pos) {
            const float* krow = p.proj + (size_t)(b * kS + s) * kNC + OFF_KI;
            float kr[64];
#pragma unroll
            for (int d = 0; d < 64; d += 4) { const float4 v = *(const float4*)(krow + d); kr[d] = v.x; kr[d + 1] = v.y; kr[d + 2] = v.z; kr[d + 3] = v.w; }
            float sc = 0.f;
#pragma unroll 1
            for (int h = 0; h < 16; ++h) {
                float dot = 0.f;
#pragma unroll
                for (int d = 0; d < 64; d += 4) {
                    const float4 q = *(const float4*)(qs + h * 64 + d);
                    dot = fmaf(q.x, kr[d], dot); dot = fmaf(q.y, kr[d + 1], dot); dot = fmaf(q.z, kr[d + 2], dot); dot = fmaf(q.w, kr[d + 3], dot);
                }
                dot *= 0.125f;
                sc = fmaf(fmaxf(dot, 0.f), ws[h], sc);
            }
            kv = fkey(sc);
        }
#pragma unroll
        for (int jj = 0; jj < 8; ++jj) if (jj == j) key[jj] = kv;
    }
    const int n = pos + 1;
    unsigned mbyte = 0u;
    if (n <= kTopK) {
#pragma unroll
        for (int j = 0; j < 8; ++j) if (s0 + j <= pos) mbyte |= 1u << j;
    } else {
        int* redi = (int*)red;
        unsigned Kth = 0u;
        for (int bit = 31; bit >= 0; --bit) {
            const unsigned cand = Kth | (1u << bit);
            int c = 0;
#pragma unroll
            for (int j = 0; j < 8; ++j) c += (s0 + j <= pos && key[j] >= cand) ? 1 : 0;
            c = block_sum_i(c, redi);
            if (c >= kTopK) Kth = cand;
        }
        int cgt = 0, ceq = 0;
#pragma unroll
        for (int j = 0; j < 8; ++j) { const bool v = s0 + j <= pos; cgt += (v && key[j] > Kth) ? 1 : 0; ceq += (v && key[j] == Kth) ? 1 : 0; }
        const int tot_gt = block_sum_i(cgt, redi);
        const int need = kTopK - tot_gt;
        int tot_eq;
        int rank = block_excl_scan_i(ceq, redi, &tot_eq);
#pragma unroll
        for (int j = 0; j < 8; ++j) {
            const bool v = s0 + j <= pos;
            if (v && key[j] > Kth) mbyte |= 1u << j;
            else if (v && key[j] == Kth) { if (rank < need) mbyte |= 1u << j; ++rank; }
        }
    }
    p.mask[(size_t)t * 512 + tid] = (unsigned char)mbyte;
}

__device__ __forceinline__ int rel_bucket(int n) {
    if (n < 16) return n;
    const float v = logf((float)n / 16.0f) / 2.0794415416798357f * 16.0f;
    int l = 16 + (int)v;
    return l < 31 ? l : 31;
}

__device__ __forceinline__ void ph_attn(const Params& p, int t, float* lds) {
    float* qs = lds;
    float* lg = lds + 1024;
    int* sel = (int*)(lds + 3072);
    int* redi = (int*)(lds + 3328);
    const int tid = threadIdx.x;
    const int b = t / kS, pos = t % kS;
    __syncthreads();
    {
        const float* qrow = p.proj + (size_t)t * kNC + OFF_Q;
        qs[tid] = qrow[tid]; qs[tid + 512] = qrow[tid + 512];
    }
    const unsigned mb = p.mask[(size_t)t * 512 + tid];
    int tot;
    int off = block_excl_scan_i(__popc(mb), redi, &tot);
#pragma unroll
    for (int j = 0; j < 8; ++j) if (mb & (1u << j)) { if (off < kTopK) sel[off] = tid * 8 + j; ++off; }
    const int nsel = tot < kTopK ? tot : kTopK;
    __syncthreads();
    {
        const int j = tid & 255, g = tid >> 8;
        if (j < nsel) {
            const int s = sel[j];
            const float* krow = p.proj + (size_t)(b * kS + s) * kNC + OFF_K + g * 128;
            float d0 = 0.f, d1 = 0.f, d2 = 0.f, d3 = 0.f;
            const float* q0 = qs + (g * 4) * 128;
#pragma unroll 4
            for (int d = 0; d < 128; d += 4) {
                const float4 kv = *(const float4*)(krow + d);
                const float4 a0 = *(const float4*)(q0 + d), a1 = *(const float4*)(q0 + 128 + d), a2 = *(const float4*)(q0 + 256 + d), a3 = *(const float4*)(q0 + 384 + d);
                d0 = fmaf(a0.x, kv.x, d0); d0 = fmaf(a0.y, kv.y, d0); d0 = fmaf(a0.z, kv.z, d0); d0 = fmaf(a0.w, kv.w, d0);
                d1 = fmaf(a1.x, kv.x, d1); d1 = fmaf(a1.y, kv.y, d1); d1 = fmaf(a1.z, kv.z, d1); d1 = fmaf(a1.w, kv.w, d1);
                d2 = fmaf(a2.x, kv.x, d2); d2 = fmaf(a2.y, kv.y, d2); d2 = fmaf(a2.z, kv.z, d2); d2 = fmaf(a2.w, kv.w, d2);
                d3 = fmaf(a3.x, kv.x, d3); d3 = fmaf(a3.y, kv.y, d3); d3 = fmaf(a3.z, kv.z, d3); d3 = fmaf(a3.w, kv.w, d3);
            }
            const float sc = 0.08838834764831845f;
            const float* bias = p.rel_bias + rel_bucket(pos - s) * 8 + g * 4;
            lg[(g * 4 + 0) * 256 + j] = d0 * sc + bias[0];
            lg[(g * 4 + 1) * 256 + j] = d1 * sc + bias[1];
            lg[(g * 4 + 2) * 256 + j] = d2 * sc + bias[2];
            lg[(g * 4 + 3) * 256 + j] = d3 * sc + bias[3];
        }
    }
    __syncthreads();
    {
        const int h = tid >> 6, lane = tid & 63;
        float v[4], m = -INFINITY;
#pragma unroll
        for (int i = 0; i < 4; ++i) { const int j = lane + 64 * i; v[i] = j < nsel ? lg[h * 256 + j] : -INFINITY; m = fmaxf(m, v[i]); }
#pragma unroll
        for (int o = 32; o; o >>= 1) m = fmaxf(m, __shfl_xor(m, o));
        float s = 0.f;
#pragma unroll
        for (int i = 0; i < 4; ++i) { v[i] = (lane + 64 * i) < nsel ? expf(v[i] - m) : 0.f; s += v[i]; }
        s = wave_sum(s);
        const float inv = 1.0f / s;
#pragma unroll
        for (int i = 0; i < 4; ++i) { const int j = lane + 64 * i; if (j < nsel) lg[h * 256 + j] = v[i] * inv; }
    }
    __syncthreads();
#pragma unroll
    for (int r = 0; r < 2; ++r) {
        const int idx = tid + r * 512, h = idx >> 7, d = idx & 127, g = h >> 2;
        const float* vb = p.proj + (size_t)(b * kS) * kNC + OFF_V + g * 128 + d;
        float o = 0.f;
        for (int j = 0; j < nsel; ++j) o = fmaf(lg[h * 256 + j], vb[(size_t)sel[j] * kNC], o);
        p.attn[(size_t)t * 1024 + idx] = o;
    }
}

__device__ __forceinline__ void ph_rnna(const Params& p, int t, float* lds) {
    float* xcs = lds;
    const int tid = threadIdx.x, pos = t % kS;
    __syncthreads();
#pragma unroll
    for (int r = 0; r < 2; ++r) {
        const int c = tid + r * 512;
        float xc = p.conv_b[c];
#pragma unroll
        for (int j = 0; j < 4; ++j) {
            const int pp = pos - 3 + j;
            const float xv = pp >= 0 ? p.proj[(size_t)(t - 3 + j) * kNC + OFF_XR + c] : 0.f;
            xc = xc + xv * p.conv_w[j * 1024 + c];
        }
        xcs[c] = xc;
    }
    __syncthreads();
#pragma unroll
    for (int r = 0; r < 2; ++r) {
        const int c = tid + r * 512, n = c >> 7, d = c & 127;
        float ra = 0.f, ia = 0.f;
        const float* wa = p.lru_wa + (size_t)n * 128 * 128 + d;
        const float* wx = p.lru_wx + (size_t)n * 128 * 128 + d;
        for (int cc = 0; cc < 128; ++cc) { const float xv = xcs[n * 128 + cc]; ra = fmaf(xv, wa[cc * 128], ra); ia = fmaf(xv, wx[cc * 128], ia); }
        const float rg = sigmoidf_(ra + p.lru_ba[c]), ig = sigmoidf_(ia + p.lru_bx[c]);
        const float sp = log1pf(expf(-p.lru_lambda[c]));
        const float log_a = -8.0f * rg * sp;
        const float a = expf(log_a);
        const float mult = sqrtf(-expm1f(2.0f * log_a));
        p.bufA[(size_t)t * 1024 + c] = a;
        p.bufB[(size_t)t * 1024 + c] = mult * (ig * xcs[c]);
    }
}

__device__ __forceinline__ void ph_scan(const Params& p, int vb) {
    const int half = vb & 1, ch = (vb >> 1) % kNChunk, b = vb / (2 * kNChunk);
    const int c = half * 512 + threadIdx.x;
    const size_t t0 = (size_t)b * kS + (size_t)ch * kChunk;
    float h = 0.f, P = 1.f;
    for (int s = 0; s < kChunk; ++s) {
        const size_t i = (t0 + s) * 1024 + c;
        const float a = p.bufA[i], bt = p.bufB[i];
        h = fmaf(a, h, bt); P *= a;
        p.bufA[i] = P; p.bufB[i] = h;
    }
    p.chA[(size_t)(b * kNChunk + ch) * 1024 + c] = P;
    p.chH[(size_t)(b * kNChunk + ch) * 1024 + c] = h;
}
__device__ __forceinline__ void ph_carry(const Params& p, int vb) {
    const int half = vb & 1, b = vb >> 1;
    const int c = half * 512 + threadIdx.x;
    float H = 0.f;
    for (int ch = 0; ch < kNChunk; ++ch) {
        const size_t i = (size_t)(b * kNChunk + ch) * 1024 + c;
        p.carry[i] = H;
        H = fmaf(p.chA[i], H, p.chH[i]);
    }
}
__device__ __forceinline__ void ph_fix(const Params& p, int t) {
    const int b = t / kS, ch = (t % kS) / kChunk;
#pragma unroll
    for (int r = 0; r < 2; ++r) {
        const int c = threadIdx.x + r * 512;
        const size_t i = (size_t)t * 1024 + c;
        const float h = fmaf(p.bufA[i], p.carry[(size_t)(b * kNChunk + ch) * 1024 + c], p.bufB[i]);
        p.rnn[i] = h * gelu_tanh(p.proj[(size_t)t * kNC + OFF_RG + c]);
    }
}

__device__ __forceinline__ void ph_merge(const Params& p, int vb, float* lds) {
    const int mt = vb / 16, nt = vb % 16;
    float a1[8][4], a2[8][4]; zero_acc(a1); zero_acc(a2);
    gemm_tile_f32(a1, p.attn, 1024, nullptr, mt * 128, kT, p.w_proj_attn, kD, nt * 128, kD, 1024, lds);
    gemm_tile_f32(a2, p.rnn, 1024, nullptr, mt * 128, kT, p.w_proj_rnn, kD, nt * 128, kD, 1024, lds);
    const int ty = threadIdx.x >> 5, tx = threadIdx.x & 31;
    const int c = nt * 128 + tx * 4;
#pragma unroll
    for (int i = 0; i < 8; ++i) {
        const int r = mt * 128 + ty * 8 + i;
        const float4 ga = *(const float4*)(p.proj + (size_t)r * kNC + OFF_GA + c), gr = *(const float4*)(p.proj + (size_t)r * kNC + OFF_GR + c);
        float4 o;
        o.x = sigmoidf_(ga.x) * a1[i][0] + sigmoidf_(gr.x) * a2[i][0];
        o.y = sigmoidf_(ga.y) * a1[i][1] + sigmoidf_(gr.y) * a2[i][1];
        o.z = sigmoidf_(ga.z) * a1[i][2] + sigmoidf_(gr.z) * a2[i][2];
        o.w = sigmoidf_(ga.w) * a1[i][3] + sigmoidf_(gr.w) * a2[i][3];
        *(float4*)(p.merged + (size_t)r * kD + c) = o;
    }
}
__device__ __forceinline__ void ph_wout(const Params& p, int vb, float* lds) {
    const int mt = vb / 16, nt = vb % 16;
    float acc[8][4]; zero_acc(acc);
    gemm_tile_f32(acc, p.merged, kD, nullptr, mt * 128, kT, p.w_out, kD, nt * 128, kD, kD, lds);
    const int ty = threadIdx.x >> 5, tx = threadIdx.x & 31;
    const int c = nt * 128 + tx * 4;
#pragma unroll
    for (int i = 0; i < 8; ++i) {
        const int r = mt * 128 + ty * 8 + i;
        const float4 xv = *(const float4*)(p.x + (size_t)r * kD + c);
        *(float4*)(p.x2 + (size_t)r * kD + c) = make_float4(xv.x + acc[i][0], xv.y + acc[i][1], xv.z + acc[i][2], xv.w + acc[i][3]);
    }
}

__device__ __forceinline__ void ph_route(const Params& p, int t, float* lds) {
    float* row = lds;
    float* part = lds + 2048;
    float* lgt = lds + 2560;
    float* red = lds + 2640;
    const int tid = threadIdx.x;
    __syncthreads();
    const float4 v = *(const float4*)(p.x2 + (size_t)t * kD + tid * 4);
    const float ss = block_sum(v.x * v.x + v.y * v.y + v.z * v.z + v.w * v.w, red);
    const float sc = rsqrtf(ss * (1.0f / kD) + 1e-6f);
    const float4 gg = *(const float4*)(p.norm2_g + tid * 4);
    float4 o; o.x = v.x * sc * gg.x; o.y = v.y * sc * gg.y; o.z = v.z * sc * gg.z; o.w = v.w * sc * gg.w;
    *(float4*)(p.u2 + (size_t)t * kD + tid * 4) = o;
    *(float4*)(row + tid * 4) = o;
    __syncthreads();
    if (tid < 504) {
        const int kp = tid / 72, j = tid % 72;
        const int k0 = kp * 293, k1 = (k0 + 293) < kD ? (k0 + 293) : kD;
        float a = 0.f;
        if (j < 8) { for (int k = k0; k < k1; ++k) a = fmaf(row[k], p.w_group[(size_t)k * 8 + j], a); }
        else       { for (int k = k0; k < k1; ++k) a = fmaf(row[k], p.w_er[(size_t)k * 64 + (j - 8)], a); }
        part[kp * 72 + j] = a;
    }
    __syncthreads();
    if (tid < 72) {
        float a = 0.f;
#pragma unroll
        for (int kp = 0; kp < 7; ++kp) a += part[kp * 72 + tid];
        a += tid < 8 ? p.b_group[tid] : p.b_er[tid - 8];
        lgt[tid] = a;
    }
    __syncthreads();
    if (tid == 0) {
        int g = 0; float m = lgt[0];
        for (int i = 1; i < 8; ++i) if (lgt[i] > m) { m = lgt[i]; g = i; }
        float den = 0.f;
        for (int i = 0; i < 8; ++i) den += expf(lgt[i] - m);
        const float psel = 1.0f / den;
        const float* el = lgt + 8 + g * 8;
        int e0 = 0; float v0 = el[0];
        for (int i = 1; i < 8; ++i) if (el[i] > v0) { v0 = el[i]; e0 = i; }
        int e1 = -1; float v1 = -INFINITY;
        for (int i = 0; i < 8; ++i) if (i != e0 && el[i] > v1) { v1 = el[i]; e1 = i; }
        const float ex = expf(v1 - v0);
        const float w0 = 1.0f / (1.0f + ex), w1 = ex / (1.0f + ex);
        p.eid[t * 2 + 0] = g * 8 + e0; p.eid[t * 2 + 1] = g * 8 + e1;
        p.ew[t * 2 + 0] = psel * w0; p.ew[t * 2 + 1] = psel * w1;
    }
}

__device__ __forceinline__ void ph_lists(const Params& p, int e, float* lds) {
    int* redi = (int*)lds;
    const int tid = threadIdx.x;
    int clt = 0, ceq = 0;
    for (int s = tid; s < kSlots; s += kNT) { const int x = p.eid[s]; clt += x < e ? 1 : 0; ceq += x == e ? 1 : 0; }
    const int off = block_sum_i(clt, redi);
    const int cnt = block_sum_i(ceq, redi);
    if (tid == 0) { p.ecnt[e] = cnt; p.eoff[e] = off; }
    int base = off;
    for (int s0 = 0; s0 < kSlots; s0 += kNT) {
        const int s = s0 + tid;
        const int f = p.eid[s] == e ? 1 : 0;
        int tot;
        const int pos = block_excl_scan_i(f, redi, &tot);
        if (f) { p.ltok[base + pos] = s >> 1; p.lw[base + pos] = p.ew[s]; }
        base += tot;
    }
}

__device__ __forceinline__ bool find_expert_tile(const Params& p, int mtile, int& e, int& mt) {
    int acc = 0;
    for (int i = 0; i < kNE; ++i) {
        const int n = (p.ecnt[i] + 127) >> 7;
        if (mtile < acc + n) { e = i; mt = mtile - acc; return true; }
        acc += n;
    }
    return false;
}

__device__ __forceinline__ void ph_exp1(const Params& p, int vb, float* lds) {
    const int nt = vb & 3, mtile = vb >> 2;
    int e, mt;
    if (!find_expert_tile(p, mtile, e, mt)) return;
    const int cnt = p.ecnt[e], off = p.eoff[e];
    float ag[8][4], au[8][4]; zero_acc(ag); zero_acc(au);
    gemm_tile_f32(ag, p.u2, kD, p.ltok + off, mt * 128, cnt, p.w_gate + (size_t)e * kD * kFF, kFF, nt * 128, kFF, kD, lds);
    gemm_tile_f32(au, p.u2, kD, p.ltok + off, mt * 128, cnt, p.w_up + (size_t)e * kD * kFF, kFF, nt * 128, kFF, kD, lds);
    const int ty = threadIdx.x >> 5, tx = threadIdx.x & 31;
    const int c = nt * 128 + tx * 4;
#pragma unroll
    for (int i = 0; i < 8; ++i) {
        const int m = mt * 128 + ty * 8 + i;
        if (m < cnt) {
            float4 o;
            o.x = ag[i][0] * sigmoidf_(ag[i][0]) * au[i][0];
            o.y = ag[i][1] * sigmoidf_(ag[i][1]) * au[i][1];
            o.z = ag[i][2] * sigmoidf_(ag[i][2]) * au[i][2];
            o.w = ag[i][3] * sigmoidf_(ag[i][3]) * au[i][3];
            *(float4*)(p.hbuf + (size_t)(off + m) * kFF + c) = o;
        }
    }
}
__device__ __forceinline__ void ph_exp2(const Params& p, int vb, float* lds) {
    const int nt = vb & 15, mtile = vb >> 4;
    int e, mt;
    if (!find_expert_tile(p, mtile, e, mt)) return;
    const int cnt = p.ecnt[e], off = p.eoff[e];
    float acc[8][4]; zero_acc(acc);
    gemm_tile_f32(acc, p.hbuf + (size_t)off * kFF, kFF, nullptr, mt * 128, cnt, p.w_down + (size_t)e * kFF * kD, kD, nt * 128, kD, kFF, lds);
    const int ty = threadIdx.x >> 5, tx = threadIdx.x & 31;
    const int c = nt * 128 + tx * 4;
#pragma unroll
    for (int i = 0; i < 8; ++i) {
        const int m = mt * 128 + ty * 8 + i;
        if (m < cnt) {
            const int tok = p.ltok[off + m];
            const float w = p.lw[off + m];
            float* dst = p.x2 + (size_t)tok * kD + c;
#pragma unroll
            for (int j = 0; j < 4; ++j) atomicAdd(dst + j, acc[i][j] * w);
        }
    }
}

template <int PH>
__device__ __forceinline__ void run_phase(const Params& p, float* lds) {
    for (int vb = blockIdx.x; vb < phase_units(PH); vb += gridDim.x) {
        if constexpr (PH == PH_NORM1) ph_norm(p.x, p.norm1_g, p.u, vb, lds);
        else if constexpr (PH == PH_PROJ) ph_proj(p, vb, lds);
        else if constexpr (PH == PH_INDEX) ph_index(p, vb, lds);
        else if constexpr (PH == PH_ATTN) ph_attn(p, vb, lds);
        else if constexpr (PH == PH_RNNA) ph_rnna(p, vb, lds);
        else if constexpr (PH == PH_SCAN) ph_scan(p, vb);
        else if constexpr (PH == PH_CARRY) ph_carry(p, vb);
        else if constexpr (PH == PH_FIX) ph_fix(p, vb);
        else if constexpr (PH == PH_MERGE) ph_merge(p, vb, lds);
        else if constexpr (PH == PH_WOUT) ph_wout(p, vb, lds);
        else if constexpr (PH == PH_ROUTE) ph_route(p, vb, lds);
        else if constexpr (PH == PH_LISTS) ph_lists(p, vb, lds);
        else if constexpr (PH == PH_EXP1) ph_exp1(p, vb, lds);
        else if constexpr (PH == PH_EXP2) ph_exp2(p, vb, lds);
        else if constexpr (PH == PH_FINAL) ph_norm(p.x2, p.norm_f_g, p.out, vb, lds);
    }
}

#define GRID_BARRIER() xcd_barrier(bar)
__global__ void __launch_bounds__(512, 2) k_mega(Params p) {
    __shared__ float lds[4352];
    __shared__ uint4 xb_words;
    if (threadIdx.x == 0) xb_words = make_uint4(0u, 0u, 0u, 0u);
    __syncthreads();
    XcdBarrier bar = xcd_barrier_post(p.bar, (volatile LAS unsigned*)&xb_words);
    run_phase<PH_NORM1>(p, lds);
    GRID_BARRIER();
    run_phase<PH_PROJ>(p, lds);
    GRID_BARRIER();
    run_phase<PH_INDEX>(p, lds);
    run_phase<PH_RNNA>(p, lds);
    GRID_BARRIER();
    run_phase<PH_SCAN>(p, lds);
    run_phase<PH_ATTN>(p, lds);
    GRID_BARRIER();
    run_phase<PH_CARRY>(p, lds);
    GRID_BARRIER();
    run_phase<PH_FIX>(p, lds);
    GRID_BARRIER();
    run_phase<PH_MERGE>(p, lds);
    GRID_BARRIER();
    run_phase<PH_WOUT>(p, lds);
    GRID_BARRIER();
    run_phase<PH_ROUTE>(p, lds);
    GRID_BARRIER();
    run_phase<PH_LISTS>(p, lds);
    GRID_BARRIER();
    run_phase<PH_EXP1>(p, lds);
    GRID_BARRIER();
    run_phase<PH_EXP2>(p, lds);
    GRID_BARRIER();
    run_phase<PH_FINAL>(p, lds);
}
}

extern "C" void kernel_launch(void* const* d_in, const int* in_sizes, int n_in, void* d_out, int out_size, void* d_ws, size_t ws_size,
                              hipStream_t stream) {
    Params p{};
    const float* const* in = (const float* const*)d_in;
    p.x = in[0]; p.norm1_g = in[1]; p.w_in = in[2]; p.conv_w = in[3]; p.conv_b = in[4]; p.lru_wa = in[5]; p.lru_ba = in[6];
    p.lru_wx = in[7]; p.lru_bx = in[8]; p.lru_lambda = in[9]; p.w_proj_attn = in[10]; p.w_proj_rnn = in[11]; p.w_out = in[12];
    p.rel_bias = in[13]; p.norm2_g = in[14]; p.w_group = in[15]; p.b_group = in[16]; p.w_er = in[17]; p.b_er = in[18];
    p.w_gate = in[19]; p.w_up = in[20]; p.w_down = in[21]; p.norm_f_g = in[22];
    p.out = (float*)d_out;
    char* w = (char*)d_ws;
    size_t o = 0;
    auto take = [&](size_t bytes) { void* r = w + o; o += (bytes + 255) & ~(size_t)255; return r; };
    p.u = (float*)take((size_t)kT * kD * 4);
    p.proj = (float*)take((size_t)kT * kNC * 4);
    p.attn = (float*)take((size_t)kT * 1024 * 4);
    p.bufA = (float*)take((size_t)kT * 1024 * 4);
    p.bufB = (float*)take((size_t)kT * 1024 * 4);
    p.chA = (float*)take((size_t)2 * kNChunk * 1024 * 4);
    p.chH = (float*)take((size_t)2 * kNChunk * 1024 * 4);
    p.carry = (float*)take((size_t)2 * kNChunk * 1024 * 4);
    p.rnn = (float*)take((size_t)kT * 1024 * 4);
    p.merged = (float*)take((size_t)kT * kD * 4);
    p.x2 = (float*)take((size_t)kT * kD * 4);
    p.u2 = p.u;
    p.hbuf = (float*)take((size_t)kSlots * kFF * 4);
    p.ew = (float*)take((size_t)kSlots * 4);
    p.lw = (float*)take((size_t)kSlots * 4);
    p.mask = (unsigned char*)take((size_t)kT * 512);
    p.eid = (int*)take((size_t)kSlots * 4);
    p.ltok = (int*)take((size_t)kSlots * 4);
    p.ecnt = (int*)take(256);
    p.eoff = (int*)take(256);
    p.bar = (unsigned*)take((size_t)XCD_BAR_WORDS * 4);
    static int grid = 0;
    if (!grid) {
        int dev = 0, cus = 0, per_cu = 0;
        hipGetDevice(&dev);
        hipDeviceGetAttribute(&cus, hipDeviceAttributeMultiprocessorCount, dev);
        hipOccupancyMaxActiveBlocksPerMultiprocessor(&per_cu, (const void*)k_mega, kNT, 0);
        if (per_cu < 1) fprintf(stderr, "occupancy query says %d blocks/CU\n", per_cu);
        grid = cus * (per_cu < 1 ? per_cu : 1);
    }
    hipMemsetAsync(p.bar, 0, (size_t)XCD_BAR_WORDS * 4, stream);
    hipLaunchKernelGGL(k_mega, dim3(grid), dim3(kNT), 0, stream, p);
}
```

```cpp
#include <hip/hip_runtime.h>
#include <stdint.h>
#include <cstdio>

#define XB_TMO      128
#define XB_XCNT(j)  (256  + 64 * (j))
#define XB_XSUB(j)  (1280 + 64 * (j))
#define XB_XGEN(j)  (2304 + 64 * (j))
#define XB_TOP      3328
#define XB_TOPGEN   3392
#define XCD_BAR_WORDS 3456
#define XB_SPIN_CAP (1u << 18)
#define LAS __attribute__((address_space(3)))

__device__ __forceinline__ unsigned xb_ld(unsigned* p)              { return __hip_atomic_load(p, __ATOMIC_RELAXED, __HIP_MEMORY_SCOPE_AGENT); }
__device__ __forceinline__ unsigned xb_add(unsigned* p, unsigned v) { return __hip_atomic_fetch_add(p, v, __ATOMIC_RELAXED, __HIP_MEMORY_SCOPE_AGENT); }
__device__ __forceinline__ unsigned xb_xcc_id() { return (unsigned)__builtin_amdgcn_s_getreg((3 << 11) | 20) & 0xFu; }
#define XB_SPIN(cond, bar) do { unsigned _sp = 0; while (cond) { __builtin_amdgcn_s_sleep(1); \
    if ((++_sp & 255u) == 0u) { if (xb_ld(&(bar)[XB_TMO])) break; if (_sp > XB_SPIN_CAP) { atomicAdd(&(bar)[XB_TMO], 1u); break; } } } } while (0)

struct XcdBarrier {
    unsigned* bar; unsigned x; unsigned wave;
    volatile LAS unsigned* st;
};

__device__ __forceinline__ bool xb_is_thread0(unsigned wave) { unsigned l; asm volatile("v_mbcnt_lo_u32_b32 %0, -1, 0\n\tv_mbcnt_hi_u32_b32 %0, -1, %0" : "=v"(l)); return wave == 0u && l == 0u; }
__device__ __forceinline__ XcdBarrier xcd_barrier_post(unsigned* bar, volatile LAS unsigned* st, unsigned wave) {
    XcdBarrier b; b.bar = bar; b.x = xb_xcc_id(); b.st = st; b.wave = wave;
    if (xb_is_thread0(wave)) (void)xb_add(&bar[XB_XCNT(b.x)], 1u);
    return b;
}
__device__ __forceinline__ void xcd_barrier_complete(unsigned* bar, unsigned x, unsigned& nloc, unsigned& nx) {
    const unsigned G = gridDim.x * gridDim.y * gridDim.z;
    unsigned sum, cnt, mine, sp = 0u;
    for (;;) {
        sum = 0u; cnt = 0u; mine = 0u;
#pragma unroll
        for (unsigned j = 0; j < 16; ++j) { const unsigned c = xb_ld(&bar[XB_XCNT(j)]); sum += c; cnt += (c > 0u) ? 1u : 0u; mine = (j == x) ? c : mine; }
        if (sum == G) break;
        __builtin_amdgcn_s_sleep(1);
        if ((++sp & 255u) == 0u) { if (xb_ld(&bar[XB_TMO])) break; if (sp > XB_SPIN_CAP) { atomicAdd(&bar[XB_TMO], 1u); break; } }
    }
    nloc = mine > 0u ? mine : 1u; nx = cnt > 0u ? cnt : 1u;
}

__device__ __forceinline__ void xcd_barrier(const XcdBarrier& b) {
    asm volatile("s_waitcnt vmcnt(0)" ::: "memory");
    __syncthreads();
    if (xb_is_thread0(b.wave)) {
        unsigned* bar = b.bar;
        __builtin_amdgcn_s_waitcnt(0);
        unsigned nloc = b.st[0], nx = b.st[1];
        if (nloc == 0u) { xcd_barrier_complete(bar, b.x, nloc, nx); b.st[0] = nloc; b.st[1] = nx; }
        const unsigned old = xb_add(&bar[XB_XSUB(b.x)], 1u);
        const unsigned gen = old / nloc;
        if (old + 1u == (gen + 1u) * nloc) {
            __builtin_amdgcn_fence(__ATOMIC_RELEASE, "agent");
            asm volatile("s_waitcnt vmcnt(0)" ::: "memory");
            const unsigned og = xb_add(&bar[XB_TOP], 1u);
            const unsigned tg = og / nx;
            if (og + 1u == (tg + 1u) * nx) xb_add(&bar[XB_TOPGEN], 1u);
            else XB_SPIN(xb_ld(&bar[XB_TOPGEN]) == tg, bar);
            __builtin_amdgcn_fence(__ATOMIC_ACQUIRE, "agent");
            xb_add(&bar[XB_XGEN(b.x)], 1u);
            asm volatile("s_waitcnt vmcnt(0)" ::: "memory");
        } else {
            XB_SPIN(xb_ld(&bar[XB_XGEN(b.x)]) == gen, bar);
            __builtin_amdgcn_fence(__ATOMIC_ACQUIRE, "agent");
            asm volatile("s_waitcnt vmcnt(0)" ::: "memory");
        }
    }
    __syncthreads();
}


namespace pg8 {
#define PG8_LAS __attribute__((address_space(3)))
typedef unsigned short bf16_t;
typedef short bf16x8 __attribute__((ext_vector_type(8)));
typedef float f32x4 __attribute__((ext_vector_type(4)));
typedef unsigned u32x4 __attribute__((ext_vector_type(4)));
constexpr int BM = 256, BK = 64, HALF = 128, HTB = HALF * BK * 2  , STAGE_BYTES = 8 * HTB, NXCD = 8, WGM = 8;

__host__ __device__ __forceinline__ int lds_byte(int r, int c) { const int st = (r >> 4) * 2 + (c >> 5), rr = r & 15, cc = c & 31, ob = rr * 64 + cc * 2; return st * 1024 + (ob ^ (((ob >> 9) & 1) << 5)); }
__host__ __device__ __forceinline__ void stage_rc(int b, int& R, int& C) { const int st = b / 1024, sb = b % 1024, swz = sb ^ (((sb >> 9) & 1) << 5); R = (st >> 1) * 16 + swz / 64; C = (st & 1) * 32 + (swz % 64) / 2; }
__host__ __device__ __forceinline__ int perm32(int rho) { const int n = rho >> 4, i = rho & 15; return 8 * (i >> 2) + 4 * n + (i & 3); }

struct Unit { int pm, pn; };
struct Gemm { const bf16_t* A; const bf16_t* Bt; int M, N, K; };

struct StaticOrder {
    int nM, nN, nwg, G, c;
    __host__ __device__ void init(int M, int N, int G_, int c_) { nM = M / BM; nN = N / BM; nwg = nM * nN; G = G_; c = c_; }
    __host__ __device__ bool next(int i, Unit& u) const {
        const long L = (long)i * G + c; if (L >= nwg) return false;
        int wgid = (int)L; { const int q = nwg / NXCD, r = nwg % NXCD, xcd = wgid % NXCD, off = wgid / NXCD; wgid = (xcd < r ? xcd * (q + 1) : r * (q + 1) + (xcd - r) * q) + off; }
        const int nig = WGM * nN, gid = wgid / nig, fm = gid * WGM, gsz = (nM - fm) < WGM ? (nM - fm) : WGM;
        u.pm = fm + ((wgid % nig) % gsz); u.pn = (wgid % nig) / gsz; return true;
    }
    __device__ __forceinline__ void a_ready(const Unit&) const {}
    __device__ __forceinline__ void done(const Unit&) const {}
};
__device__ __forceinline__ unsigned cvt_pk_bf16(float lo, float hi) { unsigned r; asm volatile("s_nop 0\n\tv_cvt_pk_bf16_f32 %0, %1, %2" : "=v"(r) : "v"(lo), "v"(hi)); return r; }
typedef float f32x2 __attribute__((ext_vector_type(2)));
__device__ __forceinline__ f32x2 gelu_pk(f32x2 v) {
    const f32x2 av = __builtin_elementwise_abs(v), d = av * 0.2316418882f + 1.0f;
    f32x2 t; t.x = __builtin_amdgcn_rcpf(d.x); t.y = __builtin_amdgcn_rcpf(d.y);
    f32x2 q = t * 0.5307027145f + (-0.7265760135f); q = q * t + 0.7107068705f; q = q * t + (-0.142248368f); q = q * t + 0.127414796f; q = q * t;
    const f32x2 s = (v * v) * (-0.72134752044f);
    f32x2 e; e.x = __builtin_amdgcn_exp2f(s.x); e.y = __builtin_amdgcn_exp2f(s.y);
    const f32x2 m = v * (q * e), r = v - m;
    f32x2 o; o.x = v.x < 0.f ? m.x : r.x; o.y = v.y < 0.f ? m.y : r.y; return o;
}

template <class Epi, class Sched, bool STAMP = false>
__device__ __forceinline__ void gemm_phase(PG8_LAS unsigned char* lds, const Gemm g, const Sched& S, const Epi& E, unsigned long long* stamps, int wave0) {
    int lane_l; asm volatile("v_mbcnt_lo_u32_b32 %0, -1, 0\n\tv_mbcnt_hi_u32_b32 %0, -1, %0" : "=v"(lane_l)); const int tid = wave0 * 64 + lane_l, wid = __builtin_amdgcn_readfirstlane(tid >> 6), lane = tid & 63, wr = wid >> 2, wc = wid & 3, fr = lane & 15, fq = lane >> 4;
    const int K = g.K, nt = K / BK;
    int ts_lo = 0, ts_hi = 0, nts = 0; const unsigned long long rt_entry = STAMP ? (unsigned long long)wall_clock64() : 0ull;
#define PG8_STAMP() do { if (STAMP && wid == 0 && nts < 64) { const unsigned long long _c = (unsigned long long)clock64(); \
        ts_lo = (lane == nts) ? (int)(unsigned)_c : ts_lo; ts_hi = (lane == nts) ? (int)(unsigned)(_c >> 32) : ts_hi; ++nts; } } while (0)
    PG8_STAMP();
    unsigned voffA[2], voffB[2];
#pragma unroll
    for (int i = 0; i < 2; ++i) { int R, C; stage_rc(tid * 16 + i * 8192, R, C); const int Rb = Epi::PERM ? ((R & ~31) + perm32(R & 31)) : R;
        voffA[i] = (unsigned)(R * K + C) * 2u; voffB[i] = (unsigned)(Rb * K + C) * 2u; }
    const size_t kstep = (size_t)(BK * 2);
    const size_t hstep = (size_t)HALF * K * 2;
    const size_t tstep = 2 * hstep;
    const unsigned ldsw = (unsigned)wid * 1024u;
    const int aoff = lds_byte(wr * 64 + fr, fq * 8), boff = lds_byte(wc * 32 + fr, fq * 8);
#define PG8_SA(b, h) (((b) * 2 + (h)) * HTB)
#define PG8_SB(b, h) ((4 + (b) * 2 + (h)) * HTB)
#define PG8_STAGE(bufoff, gbase, voff) do { _Pragma("unroll") for (int _i = 0; _i < 2; ++_i) \
        __builtin_amdgcn_global_load_lds((const unsigned*)((const char*)(gbase) + (voff)[_i]), (PG8_LAS unsigned*)(lds + (bufoff) + ldsw + _i * 8192), 16, 0, 0); } while (0)
#define PG8_LDA(dst, b, h) do { _Pragma("unroll") for (int m = 0; m < 4; ++m) _Pragma("unroll") for (int k = 0; k < 2; ++k) dst[m][k] = *(const PG8_LAS bf16x8*)(lds + PG8_SA(b, h) + aoff + m * 2048 + k * 1024); } while (0)
#define PG8_LDB(dst, b, h) do { _Pragma("unroll") for (int n = 0; n < 2; ++n) _Pragma("unroll") for (int k = 0; k < 2; ++k) dst[n][k] = *(const PG8_LAS bf16x8*)(lds + PG8_SB(b, h) + boff + n * 2048 + k * 1024); } while (0)
#define PG8_MMA(ai, bj, At, Bt) do { __builtin_amdgcn_s_setprio(1); _Pragma("unroll") for (int m = 0; m < 4; ++m) _Pragma("unroll") for (int n = 0; n < 2; ++n) _Pragma("unroll") for (int k = 0; k < 2; ++k) \
        acc[ai][bj][m][n] = __builtin_amdgcn_mfma_f32_16x16x32_bf16(Bt[n][k], At[m][k], acc[ai][bj][m][n], 0, 0, 0); __builtin_amdgcn_s_setprio(0); } while (0)
#define PG8_WAIT_V(n) asm volatile("s_waitcnt vmcnt(" #n ")" ::: "memory")
#define PG8_WAIT_L(n) asm volatile("s_waitcnt lgkmcnt(" #n ")" ::: "memory")
#define PG8_BAR __builtin_amdgcn_s_barrier()
#define PG8_SCHED __builtin_amdgcn_sched_barrier(0)
    Unit cur, nxt; int ui = 0;
    if (!S.next(0, cur)) return;
    f32x4 acc[2][2][4][2];
#pragma unroll
    for (int a = 0; a < 2; ++a)
#pragma unroll
        for (int b = 0; b < 2; ++b)
#pragma unroll
            for (int m = 0; m < 4; ++m)
#pragma unroll
                for (int n = 0; n < 2; ++n) acc[a][b][m][n] = (f32x4){0.f, 0.f, 0.f, 0.f};
    bf16x8 At[4][2], B0[2][2], B1[2][2];
    const char* cA = (const char*)g.A + (size_t)cur.pm * tstep; const char* cB = (const char*)g.Bt + (size_t)cur.pn * tstep;
    S.a_ready(cur);
    PG8_STAGE(PG8_SB(0, 0), cB, voffB); PG8_STAGE(PG8_SA(0, 0), cA, voffA); PG8_STAGE(PG8_SB(0, 1), cB + hstep, voffB); PG8_STAGE(PG8_SA(0, 1), cA + hstep, voffA);
    if (wr == 1) PG8_BAR;
    PG8_WAIT_V(4); PG8_BAR;
    PG8_STAGE(PG8_SB(1, 0), cB + kstep, voffB); PG8_STAGE(PG8_SA(1, 0), cA + kstep, voffA); PG8_STAGE(PG8_SB(1, 1), cB + hstep + kstep, voffB);
    PG8_WAIT_V(6); PG8_BAR;
    PG8_STAMP();
    for (;;) {
        const bool has_next = S.next(ui + 1, nxt);
        const char* nA = has_next ? (const char*)g.A + (size_t)nxt.pm * tstep : cA; const char* nB = has_next ? (const char*)g.Bt + (size_t)nxt.pn * tstep : cB;
        for (int t = 0; t < nt; t += 2) {
            const bool last = (t == nt - 2);
            const char* a1 = cA + (size_t)(t + 1) * kstep;
            const char* a2 = last ? nA : cA + (size_t)(t + 2) * kstep; const char* b2 = last ? nB : cB + (size_t)(t + 2) * kstep;
            const char* a3 = a2 + kstep; const char* b3 = b2 + kstep;
            if (last && has_next) S.a_ready(nxt);
            PG8_LDB(B0, 0, 0); PG8_SCHED; PG8_LDA(At, 0, 0); PG8_STAGE(PG8_SA(1, 1), a1 + hstep, voffA);
            PG8_WAIT_L(8); PG8_BAR; PG8_WAIT_L(0); PG8_MMA(0, 0, At, B0); PG8_BAR; PG8_SCHED;
            PG8_LDB(B1, 0, 1); PG8_STAGE(PG8_SB(0, 0), b2, voffB);
            PG8_BAR; PG8_WAIT_L(0); PG8_MMA(0, 1, At, B1); PG8_BAR;
            PG8_LDA(At, 0, 1); PG8_STAGE(PG8_SA(0, 0), a2, voffA);
            PG8_BAR; PG8_WAIT_L(0); PG8_MMA(1, 0, At, B0); PG8_BAR; PG8_SCHED;
            PG8_STAGE(PG8_SB(0, 1), b2 + hstep, voffB);
            PG8_WAIT_V(6); PG8_BAR; PG8_MMA(1, 1, At, B1); PG8_BAR;
            PG8_LDB(B0, 1, 0); PG8_SCHED; PG8_LDA(At, 1, 0); PG8_STAGE(PG8_SA(0, 1), a2 + hstep, voffA);
            PG8_WAIT_L(8); PG8_BAR; PG8_WAIT_L(0); PG8_MMA(0, 0, At, B0); PG8_BAR; PG8_SCHED;
            PG8_LDB(B1, 1, 1); PG8_STAGE(PG8_SB(1, 0), b3, voffB);
            PG8_BAR; PG8_WAIT_L(0); PG8_MMA(0, 1, At, B1); PG8_BAR;
            PG8_LDA(At, 1, 1); PG8_STAGE(PG8_SA(1, 0), a3, voffA);
            PG8_BAR; PG8_WAIT_L(0); PG8_MMA(1, 0, At, B0); PG8_BAR; PG8_SCHED;
            PG8_STAGE(PG8_SB(1, 1), b3 + hstep, voffB);
            PG8_WAIT_V(6); PG8_BAR; PG8_MMA(1, 1, At, B1); PG8_BAR;
        }
        PG8_STAMP();
        bool keep_acc = false;
        if constexpr (!Epi::AFTER_DRAIN) { if constexpr (Epi::CHAIN) keep_acc = E.chain(acc, cur, wr, wc, fr, fq); else E(acc, cur, wr, wc, fr, fq); S.done(cur); }
        PG8_STAMP();
        if (!has_next) break;
        if (!keep_acc) {
#pragma unroll
            for (int a = 0; a < 2; ++a)
#pragma unroll
                for (int b = 0; b < 2; ++b)
#pragma unroll
                    for (int m = 0; m < 4; ++m)
#pragma unroll
                        for (int n = 0; n < 2; ++n) acc[a][b][m][n] = (f32x4){0.f, 0.f, 0.f, 0.f};
        }
        cur = nxt; cA = nA; cB = nB; ++ui;
    }
    PG8_WAIT_V(0);
    if (wr == 0) PG8_BAR;
    PG8_BAR;
    if constexpr (Epi::AFTER_DRAIN) { E.fused(acc, cur, wr, wc, fr, fq, lds, wid, lane); S.done(cur); }
    PG8_STAMP();
    if (STAMP && wid == 0) { stamps[lane] = lane < nts ? (((unsigned long long)(unsigned)ts_hi << 32) | (unsigned)ts_lo) : 0ull;
        if (lane == 62) stamps[62] = rt_entry; if (lane == 63) stamps[63] = (unsigned long long)wall_clock64(); }
#undef PG8_STAMP
#undef PG8_SA
#undef PG8_SB
#undef PG8_STAGE
#undef PG8_LDA
#undef PG8_LDB
#undef PG8_MMA
#undef PG8_WAIT_V
#undef PG8_WAIT_L
#undef PG8_BAR
#undef PG8_SCHED
}

struct UnitX { int pm, pn, ex; };
template <class Epi, class Sched>
__device__ __forceinline__ void gemm_phase2(PG8_LAS unsigned char* lds, const Gemm g, const Sched& S, const Epi& E, int wave0) {
    int lane_l; asm volatile("v_mbcnt_lo_u32_b32 %0, -1, 0\n\tv_mbcnt_hi_u32_b32 %0, -1, %0" : "=v"(lane_l)); const int tid = wave0 * 64 + lane_l, wid = __builtin_amdgcn_readfirstlane(tid >> 6), lane = tid & 63, wr = wid >> 2, wc = wid & 3, fr = lane & 15, fq = lane >> 4;
    const int K = g.K, nt = K / BK;
    int RA[2], CA[2]; unsigned voffB[2];
#pragma unroll
    for (int i = 0; i < 2; ++i) { int R, C; stage_rc(tid * 16 + i * 8192, R, C); const int Rb = Epi::PERM ? ((R & ~31) + perm32(R & 31)) : R;
        RA[i] = R; CA[i] = C; voffB[i] = (unsigned)(Rb * K + C) * 2u; }
    const size_t kstep = (size_t)(BK * 2);
    const size_t hstep = (size_t)HALF * K * 2;
    const unsigned ldsw = (unsigned)wid * 1024u;
    const int aoff = lds_byte(wr * 64 + fr, fq * 8), boff = lds_byte(wc * 32 + fr, fq * 8);
#define PG8_SA(b, h) (((b) * 2 + (h)) * HTB)
#define PG8_SB(b, h) ((4 + (b) * 2 + (h)) * HTB)
#define PG8_STAGE(bufoff, gbase, voff) do { _Pragma("unroll") for (int _i = 0; _i < 2; ++_i) \
        __builtin_amdgcn_global_load_lds((const unsigned*)((const char*)(gbase) + (voff)[_i]), (PG8_LAS unsigned*)(lds + (bufoff) + ldsw + _i * 8192), 16, 0, 0); } while (0)
#define PG8_LDA(dst, b, h) do { _Pragma("unroll") for (int m = 0; m < 4; ++m) _Pragma("unroll") for (int k = 0; k < 2; ++k) dst[m][k] = *(const PG8_LAS bf16x8*)(lds + PG8_SA(b, h) + aoff + m * 2048 + k * 1024); } while (0)
#define PG8_LDB(dst, b, h) do { _Pragma("unroll") for (int n = 0; n < 2; ++n) _Pragma("unroll") for (int k = 0; k < 2; ++k) dst[n][k] = *(const PG8_LAS bf16x8*)(lds + PG8_SB(b, h) + boff + n * 2048 + k * 1024); } while (0)
#define PG8_MMA(ai, bj, At, Bt) do { __builtin_amdgcn_s_setprio(1); _Pragma("unroll") for (int m = 0; m < 4; ++m) _Pragma("unroll") for (int n = 0; n < 2; ++n) _Pragma("unroll") for (int k = 0; k < 2; ++k) \
        acc[ai][bj][m][n] = __builtin_amdgcn_mfma_f32_16x16x32_bf16(Bt[n][k], At[m][k], acc[ai][bj][m][n], 0, 0, 0); __builtin_amdgcn_s_setprio(0); } while (0)
#define PG8_WAIT_V(n) asm volatile("s_waitcnt vmcnt(" #n ")" ::: "memory")
#define PG8_WAIT_L(n) asm volatile("s_waitcnt lgkmcnt(" #n ")" ::: "memory")
#define PG8_BAR __builtin_amdgcn_s_barrier()
#define PG8_SCHED __builtin_amdgcn_sched_barrier(0)
    UnitX cur, nxt; int ui = 0;
    if (!S.next(0, cur)) return;
    f32x4 acc[2][2][4][2];
#pragma unroll
    for (int a = 0; a < 2; ++a)
#pragma unroll
        for (int b = 0; b < 2; ++b)
#pragma unroll
            for (int m = 0; m < 4; ++m)
#pragma unroll
                for (int n = 0; n < 2; ++n) acc[a][b][m][n] = (f32x4){0.f, 0.f, 0.f, 0.f};
    bf16x8 At[4][2], B0[2][2], B1[2][2];
    unsigned vC0[2], vC1[2], vN0[2], vN1[2];
    S.a_voffs(cur, RA, CA, vC0, vC1);
    const char* const A0 = (const char*)g.A;
    const char* cB = (const char*)g.Bt + S.b_off(cur);
    PG8_STAGE(PG8_SB(0, 0), cB, voffB); PG8_STAGE(PG8_SA(0, 0), A0, vC0); PG8_STAGE(PG8_SB(0, 1), cB + hstep, voffB); PG8_STAGE(PG8_SA(0, 1), A0, vC1);
    if (wr == 1) PG8_BAR;
    PG8_WAIT_V(4); PG8_BAR;
    PG8_STAGE(PG8_SB(1, 0), cB + kstep, voffB); PG8_STAGE(PG8_SA(1, 0), A0 + kstep, vC0); PG8_STAGE(PG8_SB(1, 1), cB + hstep + kstep, voffB);
    PG8_WAIT_V(6); PG8_BAR;
    for (;;) {
        const bool has_next = S.next(ui + 1, nxt);
        const char* nB = has_next ? (const char*)g.Bt + S.b_off(nxt) : cB;
        if (has_next) S.a_voffs(nxt, RA, CA, vN0, vN1);
        else { vN0[0] = vC0[0]; vN0[1] = vC0[1]; vN1[0] = vC1[0]; vN1[1] = vC1[1]; }
        for (int t = 0; t < nt; t += 2) {
            const bool last = (t == nt - 2);
            const char* a1 = A0 + (size_t)(t + 1) * kstep;
            const char* a2 = last ? A0 : A0 + (size_t)(t + 2) * kstep; const char* b2 = last ? nB : cB + (size_t)(t + 2) * kstep;
            const char* a3 = a2 + kstep; const char* b3 = b2 + kstep;
            unsigned w0[2], w1[2];
            w0[0] = last ? vN0[0] : vC0[0]; w0[1] = last ? vN0[1] : vC0[1]; w1[0] = last ? vN1[0] : vC1[0]; w1[1] = last ? vN1[1] : vC1[1];
            PG8_LDB(B0, 0, 0); PG8_SCHED; PG8_LDA(At, 0, 0); PG8_STAGE(PG8_SA(1, 1), a1, vC1);
            PG8_WAIT_L(8); PG8_BAR; PG8_WAIT_L(0); PG8_MMA(0, 0, At, B0); PG8_BAR; PG8_SCHED;
            PG8_LDB(B1, 0, 1); PG8_STAGE(PG8_SB(0, 0), b2, voffB);
            PG8_BAR; PG8_WAIT_L(0); PG8_MMA(0, 1, At, B1); PG8_BAR;
            PG8_LDA(At, 0, 1); PG8_STAGE(PG8_SA(0, 0), a2, w0);
            PG8_BAR; PG8_WAIT_L(0); PG8_MMA(1, 0, At, B0); PG8_BAR; PG8_SCHED;
            PG8_STAGE(PG8_SB(0, 1), b2 + hstep, voffB);
            PG8_WAIT_V(6); PG8_BAR; PG8_MMA(1, 1, At, B1); PG8_BAR;
            PG8_LDB(B0, 1, 0); PG8_SCHED; PG8_LDA(At, 1, 0); PG8_STAGE(PG8_SA(0, 1), a2, w1);
            PG8_WAIT_L(8); PG8_BAR; PG8_WAIT_L(0); PG8_MMA(0, 0, At, B0); PG8_BAR; PG8_SCHED;
            PG8_LDB(B1, 1, 1); PG8_STAGE(PG8_SB(1, 0), b3, voffB);
            PG8_BAR; PG8_WAIT_L(0); PG8_MMA(0, 1, At, B1); PG8_BAR;
            PG8_LDA(At, 1, 1); PG8_STAGE(PG8_SA(1, 0), a3, w0);
            PG8_BAR; PG8_WAIT_L(0); PG8_MMA(1, 0, At, B0); PG8_BAR; PG8_SCHED;
            PG8_STAGE(PG8_SB(1, 1), b3 + hstep, voffB);
            PG8_WAIT_V(6); PG8_BAR; PG8_MMA(1, 1, At, B1); PG8_BAR;
        }
        E(acc, cur, wr, wc, fr, fq);
        if (!has_next) break;
#pragma unroll
        for (int a = 0; a < 2; ++a)
#pragma unroll
            for (int b = 0; b < 2; ++b)
#pragma unroll
                for (int m = 0; m < 4; ++m)
#pragma unroll
                    for (int n = 0; n < 2; ++n) acc[a][b][m][n] = (f32x4){0.f, 0.f, 0.f, 0.f};
        cur = nxt; cB = nB; ++ui;
        vC0[0] = vN0[0]; vC0[1] = vN0[1]; vC1[0] = vN1[0]; vC1[1] = vN1[1];
    }
    PG8_WAIT_V(0);
    if (wr == 0) PG8_BAR;
    PG8_BAR;
#undef PG8_SA
#undef PG8_SB
#undef PG8_STAGE
#undef PG8_LDA
#undef PG8_LDB
#undef PG8_MMA
#undef PG8_WAIT_V
#undef PG8_WAIT_L
#undef PG8_BAR
#undef PG8_SCHED
}
}


namespace moe {
using pg8::bf16x8; using pg8::f32x4; using pg8::lds_byte; using pg8::stage_rc; using pg8::HTB; using pg8::BK; using pg8::HALF;
struct Unit { int pm, pn, ex; };
typedef unsigned u32x4_t __attribute__((ext_vector_type(4)));
constexpr int MT = 320, RG = MT / 16, ASLOT = RG * 2048;
#define MOE_SA(s) ((s) * ASLOT)
#define MOE_SB(b) (3 * ASLOT + (b) * HTB)
#define MOE_SYNC() do { asm volatile("s_waitcnt lgkmcnt(0)" ::: "memory"); __builtin_amdgcn_s_barrier(); asm volatile("" ::: "memory"); } while (0)
#define MOE_BLOAD(R, src) do { const float* _s = (src); \
        asm volatile("global_load_dwordx4 %0, %8, off nt\n\tglobal_load_dwordx4 %1, %9, off nt\n\tglobal_load_dwordx4 %2, %10, off nt\n\tglobal_load_dwordx4 %3, %11, off nt\n\t" \
                     "global_load_dwordx4 %4, %12, off nt\n\tglobal_load_dwordx4 %5, %13, off nt\n\tglobal_load_dwordx4 %6, %14, off nt\n\tglobal_load_dwordx4 %7, %15, off nt" \
                     : "=&v"(R[0]), "=&v"(R[1]), "=&v"(R[2]), "=&v"(R[3]), "=&v"(R[4]), "=&v"(R[5]), "=&v"(R[6]), "=&v"(R[7]) \
                     : "v"(_s), "v"(_s + (size_t)1 * Cfg::LDB), "v"(_s + (size_t)2 * Cfg::LDB), "v"(_s + (size_t)3 * Cfg::LDB), \
                       "v"(_s + (size_t)4 * Cfg::LDB), "v"(_s + (size_t)5 * Cfg::LDB), "v"(_s + (size_t)6 * Cfg::LDB), "v"(_s + (size_t)7 * Cfg::LDB) : "memory"); } while (0)
#define MOE_BWAIT(R, n) asm volatile("s_waitcnt vmcnt(" #n ")" : "+v"(R[0]), "+v"(R[1]), "+v"(R[2]), "+v"(R[3]), "+v"(R[4]), "+v"(R[5]), "+v"(R[6]), "+v"(R[7]) :: "memory")
#define MOE_BWRITE(slot, R) do { _Pragma("unroll") for (int _i = 0; _i < 4; ++_i) { u32x4_t _w; \
        _w.x = pg8::cvt_pk_bf16(R[0][_i], R[1][_i]); _w.y = pg8::cvt_pk_bf16(R[2][_i], R[3][_i]); _w.z = pg8::cvt_pk_bf16(R[4][_i], R[5][_i]); _w.w = pg8::cvt_pk_bf16(R[6][_i], R[7][_i]); \
        *(PG8_LAS u32x4_t*)(lds + (slot) + bw[_i]) = _w; } } while (0)

template <class Cfg>
__device__ __forceinline__ void gemm(PG8_LAS unsigned char* lds, const Cfg& C, int wave0) {
    int tid_l; { int lane_; asm volatile("v_mbcnt_lo_u32_b32 %0, -1, 0\n\tv_mbcnt_hi_u32_b32 %0, -1, %0 ; moe K=%1" : "=v"(lane_) : "i"(Cfg::K)); tid_l = wave0 * 64 + lane_; }
    const int tid = tid_l, wid = __builtin_amdgcn_readfirstlane(tid >> 6), lane = tid & 63;
    constexpr int K = Cfg::K, nt = K / BK;
    static_assert(nt % 4 == 0 && nt >= 8, "K-tile count");
    const size_t kstep = (size_t)(BK * 2);
    Unit u, un;
    if (!C.next(0, u)) return;
    if (wid >= 4) {
        int t256_l; asm volatile("v_mbcnt_lo_u32_b32 %0, -1, 0\n\tv_mbcnt_hi_u32_b32 %0, -1, %0 ; moe loader K=%1" : "=v"(t256_l) : "i"(Cfg::K)); t256_l += (wid - 4) * 64;
        const int t256 = t256_l, nq = t256 & 31, kq = t256 >> 5;
        unsigned bw[4];
#pragma unroll
        for (int i = 0; i < 4; ++i) bw[i] = (unsigned)lds_byte(4 * nq + i, 8 * kq);
        const float* bsrc = C.bsrc(u, nq) + (size_t)(8 * kq) * Cfg::LDB;
        f32x4 R0[8], R1[8], R2[8], R3[8];
        __builtin_amdgcn_s_waitcnt(0);
        MOE_BLOAD(R0, bsrc);
        MOE_BWAIT(R0, 0);
        MOE_BWRITE(MOE_SB(0), R0);
        MOE_BLOAD(R1, bsrc + (size_t)1 * BK * Cfg::LDB);
        MOE_BLOAD(R2, bsrc + (size_t)2 * BK * Cfg::LDB);
        MOE_BLOAD(R3, bsrc + (size_t)3 * BK * Cfg::LDB);
        MOE_SYNC();
        for (int ui = 0;; ++ui) {
            const bool has_next = C.next(ui + 1, un);
            const float* bnext = has_next ? C.bsrc(un, nq) + (size_t)(8 * kq) * Cfg::LDB : bsrc;
#pragma unroll 1
            for (int t = 0; t < nt; t += 4) {
                const bool tail = (t + 4 >= nt);
                const float* q0 = tail ? bnext : bsrc + (size_t)(t + 4) * BK * Cfg::LDB;
                MOE_BWAIT(R1, 16); MOE_BWRITE(MOE_SB(1), R1); MOE_BLOAD(R0, q0);                                     MOE_SYNC();
                MOE_BWAIT(R2, 16); MOE_BWRITE(MOE_SB(0), R2); MOE_BLOAD(R1, q0 + (size_t)1 * BK * Cfg::LDB);          MOE_SYNC();
                MOE_BWAIT(R3, 16); MOE_BWRITE(MOE_SB(1), R3); MOE_BLOAD(R2, q0 + (size_t)2 * BK * Cfg::LDB);          MOE_SYNC();
                MOE_BWAIT(R0, 16); MOE_BWRITE(MOE_SB(0), R0); MOE_BLOAD(R3, q0 + (size_t)3 * BK * Cfg::LDB);          MOE_SYNC();
            }
            if (!has_next) break;
            bsrc = bnext;
        }
        MOE_BWAIT(R1, 0);
        MOE_SYNC();
        return;
    }
    int lane_c = lane; asm volatile("" : "+v"(lane_c));
    const int wr = wid >> 1, wc = wid & 1, fr = lane_c & 15, fq = lane_c >> 4;
    constexpr int NP = RG / 2;
    const int aoff = lds_byte(fr, fq * 8), boff = lds_byte(wc * 64 + fr, fq * 8);
#define MOE_STAGE(slot, gbase, v) do { _Pragma("unroll") for (int _i = 0; _i < NP; ++_i) \
        __builtin_amdgcn_global_load_lds((const unsigned*)((const char*)(gbase) + (v)[_i]), (PG8_LAS unsigned*)(lds + MOE_SA(slot) + (wid + 4 * _i) * 1024), 16, 0, 0); } while (0)
    unsigned vA[NP];
    C.a_voffs(u, wid, lane, vA);
    const char* const A0 = (const char*)C.abase();
    f32x4 acc[10][4];
#pragma unroll
    for (int m = 0; m < 10; ++m)
#pragma unroll
        for (int n = 0; n < 4; ++n) acc[m][n] = (f32x4){0.f, 0.f, 0.f, 0.f};
    int sl = 0;
    MOE_STAGE(0, A0, vA);
    MOE_STAGE(1, A0 + kstep, vA);
    asm volatile("s_waitcnt vmcnt(10)" ::: "memory");
    MOE_SYNC();
    for (int ui = 0;; ++ui) {
        const bool has_next = C.next(ui + 1, un);
#pragma unroll 1
        for (int t = 0; t < nt; ++t) {
            const bool tail = (t + 2 >= nt);
            const int s2 = sl == 0 ? 2 : sl - 1;
            if (t == nt - 2 && has_next) C.a_voffs(un, wid, lane, vA);
            MOE_STAGE(s2, A0 + (size_t)(tail ? t + 2 - nt : t + 2) * kstep, vA);
            const PG8_LAS unsigned char* ab = lds + MOE_SA(sl) + wr * (10 * 2048) + aoff;
            const PG8_LAS unsigned char* bb = lds + MOE_SB(t & 1) + boff;
            bf16x8 Bf[4][2], Af[2][2];
#define MOE_LDA(buf, m_) do { _Pragma("unroll") for (int k = 0; k < 2; ++k) Af[buf][k] = *(const PG8_LAS bf16x8*)(ab + (m_) * 2048 + k * 1024); } while (0)
#pragma unroll
            for (int n = 0; n < 4; ++n)
#pragma unroll
                for (int k = 0; k < 2; ++k) Bf[n][k] = *(const PG8_LAS bf16x8*)(bb + n * 2048 + k * 1024);
            MOE_LDA(0, 0);
#pragma unroll
            for (int m = 0; m < 10; ++m) {
                __builtin_amdgcn_sched_barrier(0);
                __builtin_amdgcn_s_setprio(1);
                acc[m][0] = __builtin_amdgcn_mfma_f32_16x16x32_bf16(Bf[0][0], Af[m & 1][0], acc[m][0], 0, 0, 0);
                __builtin_amdgcn_sched_barrier(0);
                if (m < 9) MOE_LDA((m + 1) & 1, m + 1);
                __builtin_amdgcn_sched_barrier(0);
                acc[m][0] = __builtin_amdgcn_mfma_f32_16x16x32_bf16(Bf[0][1], Af[m & 1][1], acc[m][0], 0, 0, 0);
#pragma unroll
                for (int n = 1; n < 4; ++n)
#pragma unroll
                    for (int k = 0; k < 2; ++k) acc[m][n] = __builtin_amdgcn_mfma_f32_16x16x32_bf16(Bf[n][k], Af[m & 1][k], acc[m][n], 0, 0, 0);
                __builtin_amdgcn_s_setprio(0);
                __builtin_amdgcn_sched_barrier(0);
            }
#undef MOE_LDA
            asm volatile("s_waitcnt vmcnt(10)" ::: "memory");
            MOE_SYNC();
            sl = sl == 2 ? 0 : sl + 1;
        }
        C.epilogue(acc, u, wr, wc, fr, fq);
        if (!has_next) break;
#pragma unroll
        for (int m = 0; m < 10; ++m)
#pragma unroll
            for (int n = 0; n < 4; ++n) acc[m][n] = (f32x4){0.f, 0.f, 0.f, 0.f};
        u = un;
    }
    asm volatile("s_waitcnt vmcnt(0)" ::: "memory");
    MOE_SYNC();
#undef MOE_STAGE
}
#undef MOE_SA
#undef MOE_SB
#undef MOE_SYNC
#undef MOE_BLOAD
#undef MOE_BWAIT
#undef MOE_BWRITE
}

namespace {
typedef unsigned short bf16_t;
typedef float f32x4 __attribute__((ext_vector_type(4)));
typedef unsigned u32x4 __attribute__((ext_vector_type(4)));
typedef unsigned u32x2 __attribute__((ext_vector_type(2)));

constexpr int kS = 4096, kT = 8192, kD = 2048;
constexpr int kNC = 8784;
constexpr int kNP = 8960;
constexpr int kNT = 512;
constexpr int kTopK = 256;
constexpr int kNE = 64, kFF = 512, kSlots = 2 * kT;
constexpr int kChunk = 32, kNChunk = kS / kChunk;
constexpr int kStageBytes = 155648;
constexpr int kLdsBytes = kStageBytes + 64 + 1024 + 1024;

constexpr size_t al256(size_t x) { return (x + 255) & ~(size_t)255; }
constexpr size_t O_bar = 0;
constexpr size_t O_ecnt = O_bar + al256((size_t)XCD_BAR_WORDS * 4);
constexpr size_t O_WguT = O_ecnt + 512 + 64 * 128;
constexpr size_t O_WdT = O_WguT + 256;
constexpr size_t O_WinT = O_WdT + 256;
constexpr size_t O_WpT = O_WinT + al256((size_t)kNP * kD * 2);
constexpr size_t O_WoutT = O_WpT + al256((size_t)2 * kD * 1024 * 2);
constexpr size_t O_u_bf = O_WoutT + al256((size_t)kD * kD * 2);
constexpr size_t O_q_bf = O_u_bf + al256((size_t)kT * kD * 2);
constexpr size_t O_k_bf = O_q_bf + al256((size_t)kT * 1024 * 2);
constexpr size_t O_vT = O_k_bf + al256((size_t)kT * 256 * 2);
constexpr size_t O_qi_bf = O_vT + al256((size_t)kT * 256 * 2);
constexpr size_t O_ki_bf = O_qi_bf + al256((size_t)kT * 1024 * 2);
constexpr size_t O_gg_bf = O_ki_bf + al256((size_t)kT * 64 * 2);
constexpr size_t O_sga_bf = O_gg_bf + al256((size_t)kT * 1024 * 2);
constexpr size_t O_sgr_bf = O_sga_bf + al256((size_t)kT * kD * 2);
constexpr size_t O_ab_bf = O_sgr_bf + al256((size_t)kT * kD * 2);
constexpr size_t O_merged_bf = O_ab_bf + al256((size_t)2 * kT * 1024 * 2);
constexpr size_t O_wi = O_merged_bf + al256((size_t)kT * kD * 2);
constexpr size_t O_xr = O_wi + al256((size_t)kT * 16 * 4);
constexpr size_t O_bufA = O_xr + al256((size_t)kT * 1024 * 4);
constexpr size_t O_bufB = O_bufA + al256((size_t)kT * 1024 * 4);
constexpr size_t O_chA = O_bufB + al256((size_t)kT * 1024 * 4);
constexpr size_t O_chH = O_chA + al256((size_t)2 * kNChunk * 1024 * 4);
constexpr size_t O_carry = O_chH + al256((size_t)2 * kNChunk * 1024 * 4);
constexpr size_t O_x2 = O_carry + al256((size_t)2 * kNChunk * 1024 * 4);
constexpr size_t O_ew = O_x2 + al256((size_t)kT * kD * 4);
constexpr size_t O_lw = O_ew + al256((size_t)kSlots * 4);
constexpr size_t O_mask = O_lw + al256((size_t)32768 * 4);
constexpr size_t O_eid = O_mask + al256((size_t)kT * 512);
constexpr size_t O_ltok = O_eid + al256((size_t)kSlots * 4);
constexpr size_t O_slotpos = O_ltok + al256((size_t)32768 * 4);
constexpr size_t O_mtp = O_slotpos + al256((size_t)kSlots * 4);
constexpr size_t O_sc = O_mtp + al256((size_t)512);
constexpr size_t O_WrT = O_sc + al256((size_t)kT * kS * 4);
constexpr size_t O_rstd = O_WrT + al256((size_t)2 * 96 * kD * 2);
constexpr size_t O_lrs = O_rstd + al256((size_t)kT * 4);
constexpr size_t O_WgT = O_lrs + al256((size_t)32768 * 4);
constexpr size_t O_spl = O_WgT + al256((size_t)2 * 8 * 128 * 128 * 2);
constexpr size_t O_tokr = O_spl + al256((size_t)1024 * 4);
constexpr size_t O_wrk = O_tokr + al256((size_t)kNE * 16384 * 4);
constexpr size_t O_srank = O_wrk + al256((size_t)kNE * 16384 * 4);
constexpr size_t kWsBytes = O_srank + al256((size_t)kSlots * 4);
struct Params {
    const float *x, *norm1_g, *w_in, *conv_w, *conv_b, *lru_wa, *lru_ba, *lru_wx, *lru_bx, *lru_lambda, *w_proj_attn,
        *w_proj_rnn, *w_out, *rel_bias, *norm2_g, *w_group, *b_group, *w_er, *b_er, *w_gate, *w_up, *w_down, *norm_f_g;
    float* out;
    unsigned char* ws;
    int wave, pad_;
    __device__ __forceinline__ unsigned* bar() const { return (unsigned*)(ws + O_bar); }
    __device__ __forceinline__ bf16_t* WguT() const { return (bf16_t*)(ws + O_WguT); }
    __device__ __forceinline__ bf16_t* WdT() const { return (bf16_t*)(ws + O_WdT); }
    __device__ __forceinline__ bf16_t* WinT() const { return (bf16_t*)(ws + O_WinT); }
    __device__ __forceinline__ bf16_t* WpT() const { return (bf16_t*)(ws + O_WpT); }
    __device__ __forceinline__ bf16_t* WoutT() const { return (bf16_t*)(ws + O_WoutT); }
    __device__ __forceinline__ bf16_t* u_bf() const { return (bf16_t*)(ws + O_u_bf); }
    __device__ __forceinline__ bf16_t* q_bf() const { return (bf16_t*)(ws + O_q_bf); }
    __device__ __forceinline__ bf16_t* k_bf() const { return (bf16_t*)(ws + O_k_bf); }
    __device__ __forceinline__ bf16_t* vT() const { return (bf16_t*)(ws + O_vT); }
    __device__ __forceinline__ bf16_t* qi_bf() const { return (bf16_t*)(ws + O_qi_bf); }
    __device__ __forceinline__ bf16_t* ki_bf() const { return (bf16_t*)(ws + O_ki_bf); }
    __device__ __forceinline__ bf16_t* gg_bf() const { return (bf16_t*)(ws + O_gg_bf); }
    __device__ __forceinline__ bf16_t* sga_bf() const { return (bf16_t*)(ws + O_sga_bf); }
    __device__ __forceinline__ bf16_t* sgr_bf() const { return (bf16_t*)(ws + O_sgr_bf); }
    __device__ __forceinline__ bf16_t* ab_bf() const { return (bf16_t*)(ws + O_ab_bf); }
    __device__ __forceinline__ bf16_t* merged_bf() const { return (bf16_t*)(ws + O_merged_bf); }
    __device__ __forceinline__ float* wi() const { return (float*)(ws + O_wi); }
    __device__ __forceinline__ float* xr() const { return (float*)(ws + O_xr); }
    __device__ __forceinline__ float* bufA() const { return (float*)(ws + O_bufA); }
    __device__ __forceinline__ float* bufB() const { return (float*)(ws + O_bufB); }
    __device__ __forceinline__ float* chA() const { return (float*)(ws + O_chA); }
    __device__ __forceinline__ float* chH() const { return (float*)(ws + O_chH); }
    __device__ __forceinline__ float* carry() const { return (float*)(ws + O_carry); }
    __device__ __forceinline__ float* x2() const { return (float*)(ws + O_x2); }
    __device__ __forceinline__ float* ew() const { return (float*)(ws + O_ew); }
    __device__ __forceinline__ float* lw() const { return (float*)(ws + O_lw); }
    __device__ __forceinline__ unsigned char* mask() const { return (unsigned char*)(ws + O_mask); }
    __device__ __forceinline__ int* eid() const { return (int*)(ws + O_eid); }
    __device__ __forceinline__ int* ltok() const { return (int*)(ws + O_ltok); }
    __device__ __forceinline__ int* slotpos() const { return (int*)(ws + O_slotpos); }
    __device__ __forceinline__ int* mtp() const { return (int*)(ws + O_mtp); }
    __device__ __forceinline__ float* sc() const { return (float*)(ws + O_sc); }
    __device__ __forceinline__ bf16_t* WrT() const { return (bf16_t*)(ws + O_WrT); }
    __device__ __forceinline__ float* rstd() const { return (float*)(ws + O_rstd); }
    __device__ __forceinline__ float* lrs() const { return (float*)(ws + O_lrs); }
    __device__ __forceinline__ bf16_t* WgT() const { return (bf16_t*)(ws + O_WgT); }
    __device__ __forceinline__ float* spl() const { return (float*)(ws + O_spl); }
    __device__ __forceinline__ int* ecnt() const { return (int*)(ws + O_ecnt); }
    __device__ __forceinline__ int* tokr() const { return (int*)(ws + O_tokr); }
    __device__ __forceinline__ float* wrk() const { return (float*)(ws + O_wrk); }
    __device__ __forceinline__ int* srank() const { return (int*)(ws + O_srank); }
    __device__ __forceinline__ bf16_t* u2_bf() const { return (bf16_t*)(ws + O_u_bf); }
    __device__ __forceinline__ bf16_t* h_bf() const { return (bf16_t*)(ws + O_q_bf); }
    __device__ __forceinline__ bf16_t* y_bf() const { return (bf16_t*)(ws + O_sga_bf); }
    __device__ __forceinline__ float* tmp() const { return (float*)(ws + O_bufA); }
};

__device__ __forceinline__ int tidx_w(int wave) {
    int lane; asm volatile("v_mbcnt_lo_u32_b32 %0, -1, 0\n\tv_mbcnt_hi_u32_b32 %0, -1, %0" : "=v"(lane));
    return wave * 64 + lane;
}
#define tidx() tidx_w(p.wave)
__device__ __forceinline__ float bf2f(bf16_t b) { return __uint_as_float(((unsigned)b) << 16); }
__device__ __forceinline__ bf16_t f2bf(float f) { unsigned u = __float_as_uint(f); u += 0x7FFFu + ((u >> 16) & 1u); return (bf16_t)(u >> 16); }
__device__ __forceinline__ unsigned pk2(float lo, float hi) { return pg8::cvt_pk_bf16(lo, hi); }

__device__ __forceinline__ float wave_sum(float v) {
#pragma unroll
    for (int o = 32; o; o >>= 1) v += __shfl_xor(v, o);
    return v;
}
__device__ __forceinline__ float wave_sum_dpp(float v) {
#define WS_DPP(ctrl) v += __uint_as_float((unsigned)__builtin_amdgcn_update_dpp(0, (int)__float_as_uint(v), ctrl, 0xF, 0xF, true))
    WS_DPP(0xB1); WS_DPP(0x4E); WS_DPP(0x141); WS_DPP(0x140);
#undef WS_DPP
    const int iv = (int)__float_as_uint(v);
    return (__uint_as_float((unsigned)__builtin_amdgcn_readlane(iv, 0)) + __uint_as_float((unsigned)__builtin_amdgcn_readlane(iv, 16)))
         + (__uint_as_float((unsigned)__builtin_amdgcn_readlane(iv, 32)) + __uint_as_float((unsigned)__builtin_amdgcn_readlane(iv, 48)));
}
__device__ __forceinline__ int wave_sum_i(int v) {
#pragma unroll
    for (int o = 32; o; o >>= 1) v += __shfl_xor(v, o);
    return v;
}
__device__ __forceinline__ float block_sum(float v, float* red, int wave) {
    v = wave_sum(v);
    __syncthreads();
    if ((tidx_w(wave) & 63) == 0) red[wave] = v;
    __syncthreads();
    float s = 0.f;
#pragma unroll
    for (int i = 0; i < 8; ++i) s += red[i];
    return s;
}
__device__ __forceinline__ float sigmoidf_(float x) { return __builtin_amdgcn_rcpf(1.0f + __expf(-x)); }
__device__ __forceinline__ float gelu_tanh(float x) {
    const float y2 = 1.5957691216057308f * (x + 0.044715f * x * x * x);
    return x * __builtin_amdgcn_rcpf(1.0f + __expf(-y2));
}
__device__ __forceinline__ int swap23(int v) { return (v & ~12) | ((v & 4) << 1) | ((v & 8) >> 1); }
__device__ __forceinline__ size_t vt_index(int b, int g, int d, int s) { return ((size_t)((b * 2 + g) * 128 + d)) * kS + (size_t)((s & ~15) | swap23(s & 15)); }

__device__ __forceinline__ void xpose_item(const float* __restrict__ W, int ldw, bf16_t* __restrict__ WT, int Kt, int k0, int ncol, bool valid, size_t orow) {
    f32x4 v[32];
    const float* src = W + (size_t)k0 * ldw + (valid ? ncol : 0);
#pragma unroll
    for (int kk = 0; kk < 32; ++kk) v[kk] = *(const f32x4*)(src + (size_t)kk * ldw);
    if (valid) {
#pragma unroll
        for (int j = 0; j < 4; ++j) {
            bf16_t* dst = WT + (orow + j) * (size_t)Kt + k0;
#pragma unroll
            for (int q = 0; q < 4; ++q) {
                u32x4 o;
                o.x = pk2(v[8 * q + 0][j], v[8 * q + 1][j]); o.y = pk2(v[8 * q + 2][j], v[8 * q + 3][j]);
                o.z = pk2(v[8 * q + 4][j], v[8 * q + 5][j]); o.w = pk2(v[8 * q + 6][j], v[8 * q + 7][j]);
                *(u32x4*)(dst + 8 * q) = o;
            }
        }
    }
}
constexpr int XI_IN = (kD / 32) * 35;
constexpr int XI_P = (1024 / 32) * (kD / 256);
constexpr int XI_O = (kD / 32) * (kD / 256);
constexpr int XI_E = 3 * 128;
constexpr int XI_LATE = 2 * XI_P + XI_O;
__device__ __forceinline__ void xpose_in_item(const Params& p, int r, int lane) {
    const int nb = r % 35, kb = r / 35, n = nb * 256 + 4 * lane;
    xpose_item(p.w_in, kNC, p.WinT(), kD, kb * 32, n, n < kNC, (size_t)(n < 2640 ? n : n + 176));
}
__device__ __forceinline__ void xpose_late_item(const Params& p, int r, int lane) {
    if (r < 2 * XI_P) {
        const int which = r / XI_P; r -= which * XI_P;
        const int nb = r & 7, kb = r >> 3, n = nb * 256 + 4 * lane;
        xpose_item(which ? p.w_proj_rnn : p.w_proj_attn, kD, p.WpT(), 1024, kb * 32, n, true, (size_t)(which * kD + n));
        return;
    }
    r -= 2 * XI_P;
    if (r < XI_O) {
        const int nb = r & 7, kb = r >> 3, n = nb * 256 + 4 * lane;
        xpose_item(p.w_out, kD, p.WoutT(), kD, kb * 32, n, true, (size_t)n);
        return;
    }
}
__device__ __forceinline__ void ph_convert_late(const Params& p, int qi = 0) {
    const int lane = tidx() & 63;
    constexpr int BATCH = 8;
    for (;;) {
        int it = 0;
        if (lane == 0) it = atomicAdd(p.ecnt() + 64 + qi, BATCH);
        it = __builtin_amdgcn_readfirstlane(it);
        if (it >= XI_LATE) break;
#pragma unroll 1
        for (int k = 0; k < BATCH; ++k) if (it + k < XI_LATE) xpose_late_item(p, it + k, lane);
    }
}
__device__ __forceinline__ void norm1_rows2(const Params& p, int m0, int m1, int lane) {
    const f32x4* xa = (const f32x4*)(p.x + (size_t)m0 * kD) + lane;
    const f32x4* xb = (const f32x4*)(p.x + (size_t)m1 * kD) + lane;
    const f32x4* gr = (const f32x4*)p.norm1_g + lane;
    f32x4 va[8], vb[8]; float sa = 0.f, sb = 0.f;
#pragma unroll
    for (int j = 0; j < 8; ++j) { va[j] = xa[64 * j]; vb[j] = xb[64 * j]; }
#pragma unroll
    for (int j = 0; j < 8; ++j) {
        sa += (va[j].x * va[j].x + va[j].y * va[j].y) + (va[j].z * va[j].z + va[j].w * va[j].w);
        sb += (vb[j].x * vb[j].x + vb[j].y * vb[j].y) + (vb[j].z * vb[j].z + vb[j].w * vb[j].w);
    }
    const float ca = rsqrtf(wave_sum(sa) * (1.0f / kD) + 1e-6f), cb = rsqrtf(wave_sum(sb) * (1.0f / kD) + 1e-6f);
    u32x2* oa = (u32x2*)(p.u_bf() + (size_t)m0 * kD) + lane;
    u32x2* ob = (u32x2*)(p.u_bf() + (size_t)m1 * kD) + lane;
#pragma unroll
    for (int j = 0; j < 8; ++j) {
        const f32x4 g = gr[64 * j];
        u32x2 o; o.x = pk2(va[j].x * ca * g.x, va[j].y * ca * g.y); o.y = pk2(va[j].z * ca * g.z, va[j].w * ca * g.w); oa[64 * j] = o;
        u32x2 q; q.x = pk2(vb[j].x * cb * g.x, vb[j].y * cb * g.y); q.y = pk2(vb[j].z * cb * g.z, vb[j].w * cb * g.w); ob[64 * j] = q;
    }
}
__device__ __forceinline__ void ph_prologue(const Params& p, float* lds) {
    const int tid = tidx(), lane = tid & 63, wave = tid >> 6;
    const int gw = blockIdx.x * 8 + wave, NGW = gridDim.x * 8;
    for (int it = gw; it < XI_IN; it += NGW) xpose_in_item(p, it, lane);
    for (int m = gw; m < kT / 2; m += NGW) norm1_rows2(p, m, m + kT / 2, lane);
}
__device__ __forceinline__ void ph_tables(const Params& p) {
    const int tid = tidx();
    const int nb = gridDim.x == 256 ? 160 : gridDim.x, b0 = gridDim.x == 256 ? (int)blockIdx.x - 96 : (int)blockIdx.x;
    if (b0 < 0) return;
    for (int idx = b0 * kNT + tid; idx < 96 * kD; idx += nb * kNT) {
        const int n = idx >> 11, k = idx & (kD - 1);
        const float v = n < 8 ? p.w_group[(size_t)k * 8 + n] : (n < 72 ? p.w_er[(size_t)k * 64 + (n - 8)] : 0.f);
        const bf16_t hi = f2bf(v);
        const int piece = (((k >> 8) * 16 + ((k >> 4) & 15)) * 6 + 2 * (n >> 5)) * 64 + ((k >> 3) & 1) * 32 + (n & 31);
        p.WrT()[(size_t)piece * 8 + (k & 7)] = hi; p.WrT()[(size_t)(piece + 64) * 8 + (k & 7)] = f2bf(v - bf2f(hi));
    }
    for (int idx = b0 * kNT + tid; idx < 2 * 8 * 128 * 128; idx += nb * kNT) {
        const int which = idx >> 17, n = (idx >> 14) & 7, d = (idx >> 7) & 127, cp = idx & 127, c = (cp & ~15) | swap23(cp & 15);
        p.WgT()[idx] = f2bf((which ? p.lru_wx : p.lru_wa)[(size_t)n * 16384 + c * 128 + d]);
    }
    for (int idx = b0 * kNT + tid; idx < 1024; idx += nb * kNT) p.spl()[idx] = log1pf(expf(-p.lru_lambda[idx]));
}

struct EpiProj {
    static constexpr bool PERM = true, AFTER_DRAIN = false, CHAIN = false;
    Params p;
    template <int ACT>
    __device__ __forceinline__ void store_bf16(const pg8::f32x4 (&acc)[2][2][4][2], bf16_t* base, int ldc, int row0, int col0) const {
#pragma unroll
        for (int ai = 0; ai < 2; ++ai)
#pragma unroll
            for (int m = 0; m < 4; ++m) {
                bf16_t* rowp = base + (size_t)(row0 + ai * 128 + m * 16) * ldc + col0;
#pragma unroll
                for (int bj = 0; bj < 2; ++bj) {
                    pg8::f32x4 v0 = acc[ai][bj][m][0], v1 = acc[ai][bj][m][1];
                    if (ACT == 1) {
#pragma unroll
                        for (int j = 0; j < 4; ++j) { v0[j] = gelu_tanh(v0[j]); v1[j] = gelu_tanh(v1[j]); }
                    }
                    if (ACT == 2) {
#pragma unroll
                        for (int j = 0; j < 4; ++j) { v0[j] = sigmoidf_(v0[j]); v1[j] = sigmoidf_(v1[j]); }
                    }
                    u32x4 w; w.x = pk2(v0[0], v0[1]); w.y = pk2(v0[2], v0[3]); w.z = pk2(v1[0], v1[1]); w.w = pk2(v1[2], v1[3]);
                    *(u32x4*)(rowp + bj * 128) = w;
                }
            }
    }
    __device__ __forceinline__ void operator()(const pg8::f32x4 (&acc)[2][2][4][2], const pg8::Unit& u, int wr, int wc, int fr, int fq) const {
        const int row0 = u.pm * 256 + wr * 64 + fr, cc0 = wc * 32 + 8 * fq;
        const int pn = u.pn;
        if (pn < 4) store_bf16<0>(acc, p.q_bf(), 1024, row0, pn * 256 + cc0);
        else if (pn == 4) store_bf16<0>(acc, p.k_bf(), 256, row0, cc0);
        else if (pn == 5) {
#pragma unroll
            for (int ai = 0; ai < 2; ++ai)
#pragma unroll
                for (int m = 0; m < 4; ++m) {
                    const int row = row0 + ai * 128 + m * 16, b = row >> 12, s = row & (kS - 1);
#pragma unroll
                    for (int bj = 0; bj < 2; ++bj)
#pragma unroll
                        for (int n = 0; n < 2; ++n)
#pragma unroll
                            for (int j = 0; j < 4; ++j) {
                                const int c = cc0 + bj * 128 + n * 4 + j;
                                p.vT()[vt_index(b, c >> 7, c & 127, s)] = f2bf(acc[ai][bj][m][n][j]);
                            }
                }
        }
        else if (pn < 10) store_bf16<0>(acc, p.qi_bf(), 1024, row0, (pn - 6) * 256 + cc0);
        else if (pn == 10) {
#pragma unroll
            for (int ai = 0; ai < 2; ++ai)
#pragma unroll
                for (int m = 0; m < 4; ++m) {
                    const int row = row0 + ai * 128 + m * 16;
                    const pg8::f32x4 v0 = acc[ai][0][m][0], v1 = acc[ai][0][m][1];
                    if (cc0 < 64) {
                        u32x4 w; w.x = pk2(v0[0], v0[1]); w.y = pk2(v0[2], v0[3]); w.z = pk2(v1[0], v1[1]); w.w = pk2(v1[2], v1[3]);
                        *(u32x4*)(p.ki_bf() + (size_t)row * 64 + cc0) = w;
                    } else if (cc0 < 80) {
                        float* d = p.wi() + (size_t)row * 16 + (cc0 - 64);
                        *(pg8::f32x4*)d = v0; *(pg8::f32x4*)(d + 4) = v1;
                    }
                }
        }
        else if (pn < 15) {
#pragma unroll
            for (int ai = 0; ai < 2; ++ai)
#pragma unroll
                for (int m = 0; m < 4; ++m) {
                    float* rowp = p.xr() + (size_t)(row0 + ai * 128 + m * 16) * 1024 + (pn - 11) * 256 + cc0;
#pragma unroll
                    for (int bj = 0; bj < 2; ++bj) { *(pg8::f32x4*)(rowp + bj * 128) = acc[ai][bj][m][0]; *(pg8::f32x4*)(rowp + bj * 128 + 4) = acc[ai][bj][m][1]; }
                }
        }
        else if (pn < 19) store_bf16<1>(acc, p.gg_bf(), 1024, row0, (pn - 15) * 256 + cc0);
        else store_bf16<2>(acc, pn < 27 ? p.sga_bf() : p.sgr_bf(), kD, row0, ((pn - 19) & 7) * 256 + cc0);
    }
};

__device__ __forceinline__ void unpack8(const u32x4 w, float (&f)[8]) {
    f[0] = __uint_as_float(w.x << 16); f[1] = __uint_as_float(w.x & 0xFFFF0000u);
    f[2] = __uint_as_float(w.y << 16); f[3] = __uint_as_float(w.y & 0xFFFF0000u);
    f[4] = __uint_as_float(w.z << 16); f[5] = __uint_as_float(w.z & 0xFFFF0000u);
    f[6] = __uint_as_float(w.w << 16); f[7] = __uint_as_float(w.w & 0xFFFF0000u);
}

struct EpiMerge {
    static constexpr bool PERM = true, AFTER_DRAIN = false, CHAIN = true;
    Params p;
    __device__ __forceinline__ bool chain(pg8::f32x4 (&acc)[2][2][4][2], const pg8::Unit& u, int wr, int wc, int fr, int fq) const {
        const bool second = u.pn >= 8;
        const int row0 = (u.pm & 31) * 256 + wr * 64 + fr, col0 = (u.pn & 7) * 256 + wc * 32 + 8 * fq;
#pragma unroll
        for (int ai = 0; ai < 2; ++ai)
#pragma unroll
            for (int m = 0; m < 4; ++m) {
                const size_t ro = (size_t)(row0 + ai * 128 + m * 16) * kD + col0;
#pragma unroll
                for (int bj = 0; bj < 2; ++bj) {
                    float gr[8]; unpack8(*(const u32x4*)(p.sgr_bf() + ro + bj * 128), gr);
                    if (!second) {
                        float ga[8]; unpack8(*(const u32x4*)(p.sga_bf() + ro + bj * 128), ga);
#pragma unroll
                        for (int j = 0; j < 4; ++j) { acc[ai][bj][m][0][j] *= ga[j] * __builtin_amdgcn_rcpf(gr[j]); acc[ai][bj][m][1][j] *= ga[4 + j] * __builtin_amdgcn_rcpf(gr[4 + j]); }
                    } else {
                        pg8::f32x4 v0 = acc[ai][bj][m][0], v1 = acc[ai][bj][m][1];
#pragma unroll
                        for (int j = 0; j < 4; ++j) { v0[j] *= gr[j]; v1[j] *= gr[4 + j]; }
                        u32x4 w; w.x = pk2(v0[0], v0[1]); w.y = pk2(v0[2], v0[3]); w.z = pk2(v1[0], v1[1]); w.w = pk2(v1[2], v1[3]);
                        *(u32x4*)(p.merged_bf() + ro + bj * 128) = w;
                    }
                }
            }
        return !second;
    }
};
struct MergeOrder {
    pg8::StaticOrder base;
    __device__ bool next(int i, pg8::Unit& u) const {
        if (!base.next(i >> 1, u)) return false;
        if (i & 1) { u.pm += 32; u.pn += 8; }
        return true;
    }
    __device__ __forceinline__ void a_ready(const pg8::Unit&) const {}
    __device__ __forceinline__ void done(const pg8::Unit&) const {}
};
struct EpiWout {
    static constexpr bool PERM = true, AFTER_DRAIN = false, CHAIN = false;
    Params p;
    __device__ __forceinline__ void operator()(const pg8::f32x4 (&acc)[2][2][4][2], const pg8::Unit& u, int wr, int wc, int fr, int fq) const {
        const int row0 = u.pm * 256 + wr * 64 + fr, col0 = u.pn * 256 + wc * 32 + 8 * fq;
#pragma unroll
        for (int ai = 0; ai < 2; ++ai)
#pragma unroll
            for (int m = 0; m < 4; ++m) {
                const size_t ro = (size_t)(row0 + ai * 128 + m * 16) * kD + col0;
#pragma unroll
                for (int bj = 0; bj < 2; ++bj) {
                    const float* xs = p.x + ro + bj * 128; float* xd = p.x2() + ro + bj * 128;
                    *(pg8::f32x4*)xd = *(const pg8::f32x4*)xs + acc[ai][bj][m][0];
                    *(pg8::f32x4*)(xd + 4) = *(const pg8::f32x4*)(xs + 4) + acc[ai][bj][m][1];
                }
            }
    }
};

enum { PH_INDEX = 0, PH_ATTN, PH_RNNA, PH_SCAN, PH_CARRY, PH_FIX, PH_ROUTE, PH_LISTS, PH_FINAL, PH_COUNT };

__device__ __forceinline__ int phase_units(int ph) {
    switch (ph) {
        case PH_INDEX: return kT;
        case PH_ATTN: return kT;
        case PH_RNNA: return kT;
        case PH_SCAN: return 2 * kNChunk * 2;
        case PH_CARRY: return 4;
        case PH_FIX: return kT;
        case PH_ROUTE: return kT;
        case PH_LISTS: return kNE;
        case PH_FINAL: return kT;
    }
    return 0;
}

__device__ __forceinline__ unsigned fkey(float f) { unsigned b = __float_as_uint(f); return (b & 0x80000000u) ? ~b : (b | 0x80000000u); }


typedef short bf16x8_t __attribute__((ext_vector_type(8)));
typedef float f32x16_t __attribute__((ext_vector_type(16)));

constexpr int kIdxChunk = 256;

__device__ __forceinline__ void idx_stage_chunk(const Params& p, int b, int ci, unsigned char* buf, int wave, int lane) {
#pragma unroll
    for (int i = 0; i < 4; ++i) {
        const int q = wave * 4 + i;
        const int key = 8 * q + (lane >> 3), cpos = lane & 7;
        const bf16_t* src = p.ki_bf() + (size_t)(b * kS + ci * kIdxChunk + key) * 64 + ((cpos ^ ((key >> 1) & 7)) * 8);
        __builtin_amdgcn_global_load_lds((const unsigned*)src, (LAS unsigned*)(buf + q * 1024), 16, 0, 0);
    }
}

__device__ __forceinline__ void index_item(const Params& p, int b, int tb, unsigned char* smem, int mode = 3) {
    const int tid_l = tidx();
    const int tid = tid_l, lane = tid & 63, wave = __builtin_amdgcn_readfirstlane(tid >> 6);
    const int tg = wave & 3, kp = wave >> 2, hi = lane >> 5, l31 = lane & 31;
    const int pos0 = tb * 16;
    const int wpos0 = pos0 + 4 * tg;
    const size_t trow0 = (size_t)b * kS + wpos0;
    bf16x8_t af[2][4]; float wv[2][16];
    {
        const int rho = l31, atok = (rho >> 2) & 1, ahead = (rho & 3) + 4 * (rho >> 3);
#pragma unroll
        for (int mt = 0; mt < 2; ++mt) {
            const bf16_t* qrow = p.qi_bf() + (trow0 + 2 * mt + atok) * 1024 + ahead * 64 + 8 * hi;
#pragma unroll
            for (int kk = 0; kk < 4; ++kk) af[mt][kk] = *(const bf16x8_t*)(qrow + 16 * kk);
            const float* wrow = p.wi() + (trow0 + 2 * mt + hi) * 16;
#pragma unroll
            for (int r = 0; r < 16; r += 4) { const f32x4 w4 = *(const f32x4*)(wrow + r); wv[mt][r] = w4.x * 0.03125f; wv[mt][r + 1] = w4.y * 0.03125f; wv[mt][r + 2] = w4.z * 0.03125f; wv[mt][r + 3] = w4.w * 0.03125f; }
        }
    }
    const int nchunk = (mode & 1) ? (pos0 + 15) / kIdxChunk + 1 : 0;
    __syncthreads();
    if (mode & 1) idx_stage_chunk(p, b, 0, smem, wave, lane);
    asm volatile("s_waitcnt vmcnt(0)" ::: "memory");
    __syncthreads();
    const int rdoff = l31 * 128, rdswz = (l31 >> 1) & 7;
    for (int ci = 0; ci < nchunk; ++ci) {
        if (ci + 1 < nchunk) idx_stage_chunk(p, b, ci + 1, smem + ((ci + 1) & 1) * 32768, wave, lane);
        const unsigned char* buf = smem + (ci & 1) * 32768;
#pragma unroll 1
        for (int kt = kp; kt < 8; kt += 2) {
            const int key0 = ci * kIdxChunk + kt * 32;
            if (key0 > wpos0 + 3) break;
            bf16x8_t bfr[4];
#pragma unroll
            for (int kk = 0; kk < 4; ++kk) bfr[kk] = *(const bf16x8_t*)(buf + kt * 4096 + rdoff + (((2 * kk + hi) ^ rdswz) * 16));
#pragma unroll
            for (int mt = 0; mt < 2; ++mt) {
                f32x16_t acc;
#pragma unroll
                for (int r = 0; r < 16; ++r) acc[r] = 0.f;
#pragma unroll
                for (int kk = 0; kk < 4; ++kk) acc = __builtin_amdgcn_mfma_f32_32x32x16_bf16(af[mt][kk], bfr[kk], acc, 0, 0, 0);
                float sc = 0.f;
#pragma unroll
                for (int r = 0; r < 16; ++r) sc = fmaf(fmaxf(acc[r], 0.f), wv[mt][r], sc);
                p.sc()[(trow0 + 2 * mt + hi) * kS + key0 + l31] = sc;
            }
        }
        asm volatile("s_waitcnt vmcnt(0)" ::: "memory");
        __syncthreads();
    }
#pragma unroll 1
    for (int tt = 0; tt < ((mode & 2) ? 2 : 0); ++tt) {
        const int pos = pos0 + 2 * wave + tt;
        const size_t trow = (size_t)b * kS + pos;
        const float* srow = p.sc() + trow * kS;
        unsigned key[64];
#pragma unroll
        for (int g = 0; g < 4; ++g) {
            if (g == 0 || 1024 * g <= pos) {
                float v[16];
#pragma unroll
                for (int jj = 0; jj < 16; ++jj) { const int s = 64 * (16 * g + jj) + lane; v[jj] = srow[s <= pos ? s : pos]; }
#pragma unroll
                for (int jj = 0; jj < 16; ++jj) {
                    const int s = 64 * (16 * g + jj) + lane;
                    const unsigned bb = __float_as_uint(v[jj]);
                    key[16 * g + jj] = (s <= pos) ? ((bb & 0x80000000u) ? ~bb : (bb | 0x80000000u)) : 0u;
                }
            } else {
#pragma unroll
                for (int jj = 0; jj < 16; ++jj) key[16 * g + jj] = 0u;
            }
        }
        unsigned long long mine = 0ull;
        if (pos + 1 <= kTopK) {
#pragma unroll
            for (int j = 0; j < 4; ++j) { const unsigned long long wj = __ballot(64 * j + lane <= pos); if (lane == j) mine = wj; }
        } else {
            unsigned Kth = 0u; bool exact = false;
#pragma unroll 1
            for (int bit = 31; bit >= 0; --bit) {
                const unsigned cand = Kth | (1u << bit);
                int cl = 0;
#pragma unroll
                for (int g = 0; g < 4; ++g) {
                    if (g == 0 || 1024 * g <= pos) {
#pragma unroll
                        for (int j = 16 * g; j < 16 * g + 16; ++j) cl += __popcll(__ballot(key[j] >= cand));
                    }
                }
                const int cnt = cl;
                if (cnt >= kTopK) { Kth = cand; if (cnt == kTopK) { exact = true; break; } }
            }
            if (exact) {
#pragma unroll
                for (int j = 0; j < 64; ++j) { const unsigned long long wj = __ballot(key[j] >= Kth); if (lane == j) mine = wj; }
            } else {
                int cgt = 0;
#pragma unroll
                for (int j = 0; j < 64; ++j) cgt += __popcll(__ballot(key[j] > Kth));
                const int need = kTopK - cgt;
                int running = 0;
                const unsigned long long lt = (1ull << lane) - 1ull;
#pragma unroll
                for (int j = 0; j < 64; ++j) {
                    const unsigned long long eq = __ballot(key[j] == Kth);
                    const int rank = running + __popcll(eq & lt);
                    const bool sel = key[j] > Kth || (key[j] == Kth && rank < need);
                    const unsigned long long wj = __ballot(sel);
                    if (lane == j) mine = wj;
                    running += __popcll(eq);
                }
            }
        }
        *(unsigned long long*)(p.mask() + trow * 512 + lane * 8) = mine;
    }
}

__device__ __forceinline__ void ph_index_mfma(const Params& p, unsigned char* smem, int mode = 3) {
    for (int i = blockIdx.x; i < 256; i += gridDim.x) {
        const int b = i & 1;
#pragma unroll 1
        for (int k = 0; k < 2; ++k) index_item(p, b, k ? (i >> 1) : 255 - (i >> 1), smem, mode);
    }
    __syncthreads();
}

__device__ __forceinline__ int rel_bucket(int n) {
    if (n < 16) return n;
    const float v = logf((float)n / 16.0f) / 2.0794415416798357f * 16.0f;
    int l = 16 + (int)v;
    return l < 31 ? l : 31;
}

__device__ __forceinline__ void att_stage_pair(const Params& p, int b, int g, int i, unsigned char* buf, int wave, int lane) {
    const int kind = wave >> 2, par = (wave >> 1) & 1, j = 2 * i + par;
#pragma unroll
    for (int ii = 0; ii < 8; ++ii) {
        const int pc = (wave & 1) * 8 + ii;
        const bf16_t* src;
        if (kind == 0) { const int key = 4 * pc + (lane >> 4), cpos = lane & 15; src = p.k_bf() + (size_t)(b * kS + 64 * j + key) * 256 + g * 128 + ((cpos ^ (key & 15)) * 8); }
        else           { const int d = 8 * pc + (lane >> 3), cpos = lane & 7; src = p.vT() + (size_t)((b * 2 + g) * 128 + d) * kS + 64 * j + ((cpos ^ ((d >> 1) & 7)) * 8); }
        __builtin_amdgcn_global_load_lds((const unsigned*)src, (LAS unsigned*)(buf + kind * 32768 + par * 16384 + pc * 1024), 16, 0, 0);
    }
}
__device__ __forceinline__ float half_max(float x) { auto rr = __builtin_amdgcn_permlane32_swap(__float_as_uint(x), __float_as_uint(x), false, false); return fmaxf(__uint_as_float(rr[0]), __uint_as_float(rr[1])); }
__device__ __forceinline__ float half_sum(float x) { auto rr = __builtin_amdgcn_permlane32_swap(__float_as_uint(x), __float_as_uint(x), false, false); return __uint_as_float(rr[0]) + __uint_as_float(rr[1]); }

__device__ __forceinline__ void attn_item(const Params& p, int b, int h, int qb, unsigned char* smem) {
    const int tid_l = tidx();
    const int tid = tid_l, lane = tid & 63, wave = __builtin_amdgcn_readfirstlane(tid >> 6);
    const int rw = wave & 3, kp = wave >> 2, hi = lane >> 5, l31 = lane & 31;
    const int g = h >> 2, r0 = 128 * qb + 32 * rw, row = r0 + l31;
    const size_t trow = (size_t)b * kS + row;
    float* tbl = (float*)(smem + kStageBytes + 64);
    constexpr float LOG2E = 1.4426950408889634f, C2 = 1.4426950408889634f * 0.08838834764831845f;
    __syncthreads();
    const float tb0 = p.rel_bias[rel_bucket(tid & 127) * 8 + h], tb1 = p.rel_bias[31 * 8 + h];
    bf16x8_t qf[8];
    {
        const bf16_t* qrow = p.q_bf() + trow * 1024 + h * 128 + 8 * hi;
#pragma unroll
        for (int kk = 0; kk < 8; ++kk) qf[kk] = *(const bf16x8_t*)(qrow + 16 * kk);
    }
    f32x16_t o[4];
#pragma unroll
    for (int a = 0; a < 4; ++a)
#pragma unroll
        for (int r = 0; r < 16; ++r) o[a][r] = 0.f;
    float m = -1e30f, l = 0.f;
    att_stage_pair(p, b, g, 0, smem, wave, lane);
    const unsigned long long* mrow = (const unsigned long long*)(p.mask() + trow * 512);
    unsigned long long mw_next;
    asm volatile("global_load_dwordx2 %0, %1, off" : "=v"(mw_next) : "v"(mrow + kp) : "memory");
    if (tid < 256) tbl[tid] = tid < 128 ? (tb0 - tb1) * LOG2E : 0.f;
    asm volatile("s_waitcnt vmcnt(0)" : "+v"(mw_next) :: "memory");
    __syncthreads();
    const int kswz = l31 & 15;
    for (int i = 0; i <= qb; ++i) {
        if (i < qb) att_stage_pair(p, b, g, i + 1, smem + ((i + 1) & 1) * 65536, wave, lane);
        const int j = 2 * i + kp;
        const unsigned long long mw = mw_next;
        asm volatile("global_load_dwordx2 %0, %1, off" : "=v"(mw_next) : "v"(mrow + ((j + 2) < 64 ? (j + 2) : 63)) : "memory");
        if (64 * j <= r0 + 31) {
            const unsigned char* kb = smem + (i & 1) * 65536 + kp * 16384;
            const unsigned char* vb = kb + 32768;
            int kofs = l31 * 256, ksw = kswz * 16 ^ hi * 16; asm volatile("" : "+v"(kofs), "+v"(ksw));
            f32x16_t s0, s1;
#pragma unroll
            for (int r = 0; r < 16; ++r) { s0[r] = 0.f; s1[r] = 0.f; }
            {
                bf16x8_t ka[2][2];
                { const int co = kofs + ksw; ka[0][0] = *(const bf16x8_t*)(kb + co); ka[0][1] = *(const bf16x8_t*)(kb + 8192 + co); }
#pragma unroll
                for (int kk = 0; kk < 8; ++kk) {
                    if (kk < 7) { const int co = kofs + ((32 * (kk + 1)) ^ ksw); ka[(kk + 1) & 1][0] = *(const bf16x8_t*)(kb + co); ka[(kk + 1) & 1][1] = *(const bf16x8_t*)(kb + 8192 + co); }
                    s0 = __builtin_amdgcn_mfma_f32_32x32x16_bf16(ka[kk & 1][0], qf[kk], s0, 0, 0, 0);
                    s1 = __builtin_amdgcn_mfma_f32_32x32x16_bf16(ka[kk & 1][1], qf[kk], s1, 0, 0, 0);
                }
            }
            const bool needb = (64 * j + 191 > r0);
            const unsigned mlo = (unsigned)(mw) >> (4 * hi), mhi = (unsigned)(mw >> 32) >> (4 * hi);
            const unsigned NEGB = 0xFF800000u;
#define ATT_MASK(x, w, c) __uint_as_float((__float_as_uint(x) & (unsigned)__builtin_amdgcn_sbfe((int)(w), (c), 1)) | (NEGB & ~(unsigned)__builtin_amdgcn_sbfe((int)(w), (c), 1)))
            float mn, ps = 0.f, alpha;
            if (needb) {
                const int dq = row - 64 * j - 4 * hi;
#pragma unroll
                for (int r = 0; r < 16; ++r) {
                    const int c = (r & 3) + 8 * (r >> 2);
                    int d0 = dq - c, d1 = dq - c - 32;
                    d0 = d0 < 0 ? 0 : (d0 > 255 ? 255 : d0); d1 = d1 < 0 ? 0 : (d1 > 255 ? 255 : d1);
                    const float x0 = fmaf(s0[r], C2, tbl[d0]), x1 = fmaf(s1[r], C2, tbl[d1]);
                    s0[r] = ATT_MASK(x0, mlo, c); s1[r] = ATT_MASK(x1, mhi, c);
                }
                float mx = s0[0];
#pragma unroll
                for (int r = 1; r < 16; ++r) mx = fmaxf(mx, s0[r]);
#pragma unroll
                for (int r = 0; r < 16; ++r) mx = fmaxf(mx, s1[r]);
                mx = half_max(mx);
                mn = fmaxf(m, mx);
                alpha = __builtin_amdgcn_exp2f(m - mn);
#pragma unroll
                for (int r = 0; r < 16; ++r) { s0[r] = __builtin_amdgcn_exp2f(s0[r] - mn); s1[r] = __builtin_amdgcn_exp2f(s1[r] - mn); ps += s0[r] + s1[r]; }
            } else {
#pragma unroll
                for (int r = 0; r < 16; ++r) {
                    const int c = (r & 3) + 8 * (r >> 2);
                    s0[r] = ATT_MASK(s0[r], mlo, c); s1[r] = ATT_MASK(s1[r], mhi, c);
                }
                float mx = s0[0];
#pragma unroll
                for (int r = 1; r < 16; ++r) mx = fmaxf(mx, s0[r]);
#pragma unroll
                for (int r = 0; r < 16; ++r) mx = fmaxf(mx, s1[r]);
                mx = half_max(mx);
                mn = fmaxf(m, mx * C2);
                alpha = __builtin_amdgcn_exp2f(m - mn);
                const float nmn = -mn;
#pragma unroll
                for (int r = 0; r < 16; ++r) { s0[r] = __builtin_amdgcn_exp2f(fmaf(s0[r], C2, nmn)); s1[r] = __builtin_amdgcn_exp2f(fmaf(s1[r], C2, nmn)); ps += s0[r] + s1[r]; }
            }
#undef ATT_MASK
            m = mn;
            ps = half_sum(ps);
            l = l * alpha + ps;
            if (__any(alpha != 1.f)) {
#pragma unroll
                for (int a = 0; a < 4; ++a)
#pragma unroll
                    for (int r = 0; r < 16; ++r) o[a][r] *= alpha;
            }
            bf16x8_t pf[4];
#pragma unroll
            for (int s = 0; s < 2; ++s) {
                u32x4 w0, w1;
                w0.x = pk2(s0[8 * s + 0], s0[8 * s + 1]); w0.y = pk2(s0[8 * s + 2], s0[8 * s + 3]); w0.z = pk2(s0[8 * s + 4], s0[8 * s + 5]); w0.w = pk2(s0[8 * s + 6], s0[8 * s + 7]);
                w1.x = pk2(s1[8 * s + 0], s1[8 * s + 1]); w1.y = pk2(s1[8 * s + 2], s1[8 * s + 3]); w1.z = pk2(s1[8 * s + 4], s1[8 * s + 5]); w1.w = pk2(s1[8 * s + 6], s1[8 * s + 7]);
                pf[s] = *reinterpret_cast<bf16x8_t*>(&w0); pf[2 + s] = *reinterpret_cast<bf16x8_t*>(&w1);
            }
            int vofs = l31 * 128, vsw = (((l31 >> 1) & 7) * 16) ^ (hi * 16); asm volatile("" : "+v"(vofs), "+v"(vsw));
            {
                bf16x8_t va[2][4];
#pragma unroll
                for (int ks = 0; ks < 4; ++ks) va[0][ks] = *(const bf16x8_t*)(vb + vofs + ((32 * ks) ^ vsw));
#pragma unroll
                for (int a = 0; a < 4; ++a) {
                    if (a < 3) {
#pragma unroll
                        for (int ks = 0; ks < 4; ++ks) va[(a + 1) & 1][ks] = *(const bf16x8_t*)(vb + (a + 1) * 4096 + vofs + ((32 * ks) ^ vsw));
                    }
#pragma unroll
                    for (int ks = 0; ks < 4; ++ks) o[a] = __builtin_amdgcn_mfma_f32_32x32x16_bf16(va[a & 1][ks], pf[ks], o[a], 0, 0, 0);
                    __builtin_amdgcn_sched_barrier(0);
                }
            }
        }
        asm volatile("s_waitcnt vmcnt(0)" : "+v"(mw_next) :: "memory");
        __syncthreads();
    }
    float* xch = (float*)smem + rw * (66 * 64);
    if (kp == 1) {
#pragma unroll
        for (int a = 0; a < 4; ++a)
#pragma unroll
            for (int r = 0; r < 16; ++r) xch[(a * 16 + r) * 64 + lane] = o[a][r];
        xch[64 * 64 + lane] = m; xch[65 * 64 + lane] = l;
    }
    __syncthreads();
    if (kp == 0) {
        const float m1 = xch[64 * 64 + lane], l1 = xch[65 * 64 + lane];
        const float mn = fmaxf(m, m1), a0 = __builtin_amdgcn_exp2f(m - mn), a1 = __builtin_amdgcn_exp2f(m1 - mn);
        const float inv = 1.0f / (l * a0 + l1 * a1);
        int rowb = r0 + (lane & 31); asm volatile("" : "+v"(rowb));
        bf16_t* orow = p.ab_bf() + ((size_t)b * kS + rowb) * 1024 + h * 128 + 4 * hi;
#pragma unroll
        for (int a = 0; a < 4; ++a)
#pragma unroll
            for (int k4 = 0; k4 < 4; ++k4) {
                float v[4];
#pragma unroll
                for (int e = 0; e < 4; ++e) { const int r = 4 * k4 + e; v[e] = (o[a][r] * a0 + xch[(a * 16 + r) * 64 + lane] * a1) * inv; }
                u32x2 w; w.x = pk2(v[0], v[1]); w.y = pk2(v[2], v[3]);
                *(u32x2*)(orow + 32 * a + 8 * k4) = w;
            }
    }
}
__device__ __forceinline__ void ph_attn_mfma(const Params& p, unsigned char* smem) {
    for (int i = blockIdx.x; i < 256; i += gridDim.x) {
        const int bh = i & 15;
#pragma unroll 1
        for (int k = 0; k < 2; ++k) attn_item(p, bh >> 3, bh & 7, k ? (i >> 4) : 31 - (i >> 4), smem);
    }
    __syncthreads();
}

__device__ __forceinline__ float neg_expm1(float x) {
    if (x > -0.1f) return -x * (1.0f + x * (0.5f + x * (0.16666667f + x * (0.041666668f + x * 0.0083333338f))));
    return 1.0f - __expf(x);
}
template <int mt>
__device__ __forceinline__ void rnn1_mt(const Params& p, const float (&xc)[8][8], const bf16x8_t (&bfr)[8], int n, int token, int b, int chunk, int hi, int l31) {
        f32x16_t accr, acci;
#pragma unroll
        for (int r = 0; r < 16; ++r) { accr[r] = 0.f; acci[r] = 0.f; }
        const bf16_t* wa = p.WgT() + (size_t)((n * 128 + 32 * mt + l31) * 128) + 8 * hi;
        const bf16_t* wx = wa + 8 * 128 * 128;
#pragma unroll
        for (int ks = 0; ks < 8; ++ks) {
            const bf16x8_t fa = *(const bf16x8_t*)(wa + 16 * ks), fx = *(const bf16x8_t*)(wx + 16 * ks);
            accr = __builtin_amdgcn_mfma_f32_32x32x16_bf16(fa, bfr[ks], accr, 0, 0, 0);
            acci = __builtin_amdgcn_mfma_f32_32x32x16_bf16(fx, bfr[ks], acci, 0, 0, 0);
            if ((ks & 3) == 3) __builtin_amdgcn_sched_barrier(0);
        }
        float av[16], bv[16];
#pragma unroll
        for (int k4 = 0; k4 < 4; ++k4) {
            const int c0 = n * 128 + 32 * mt + 8 * k4 + 4 * hi;
            const f32x4 ba = *(const f32x4*)(p.lru_ba + c0), bx = *(const f32x4*)(p.lru_bx + c0), sp = *(const f32x4*)(p.spl() + c0);
#pragma unroll
            for (int e = 0; e < 4; ++e) {
                const int r = 4 * k4 + e;
                const float x = xc[2 * mt + (r >> 3)][(r & 3) + 4 * ((r >> 2) & 1)];
                const float rg = 1.0f / (1.0f + __expf(-(accr[r] + ba[e]))), ig = 1.0f / (1.0f + __expf(-(acci[r] + bx[e])));
                const float la = -8.0f * rg * sp[e];
                av[r] = __expf(la);
                bv[r] = sqrtf(neg_expm1(2.0f * la)) * (ig * x);
            }
        }
#define RNN_DPP_STEP(CTRL, RMASK) do { _Pragma("unroll") for (int r = 0; r < 16; ++r) { \
            const float ap = __uint_as_float((unsigned)__builtin_amdgcn_update_dpp((int)0x3F800000, (int)__float_as_uint(av[r]), CTRL, RMASK, 0xF, false)); \
            const float bp = __uint_as_float((unsigned)__builtin_amdgcn_update_dpp(0, (int)__float_as_uint(bv[r]), CTRL, RMASK, 0xF, false)); \
            bv[r] = fmaf(av[r], bp, bv[r]); av[r] *= ap; } } while (0)
        RNN_DPP_STEP(0x111, 0xF); RNN_DPP_STEP(0x112, 0xF); RNN_DPP_STEP(0x114, 0xF); RNN_DPP_STEP(0x118, 0xF); RNN_DPP_STEP(0x142, 0xA);
#undef RNN_DPP_STEP
#pragma unroll
        for (int k4 = 0; k4 < 4; ++k4) {
            const int c0 = n * 128 + 32 * mt + 8 * k4 + 4 * hi;
            const f32x4 va = (f32x4){av[4 * k4], av[4 * k4 + 1], av[4 * k4 + 2], av[4 * k4 + 3]}, vb = (f32x4){bv[4 * k4], bv[4 * k4 + 1], bv[4 * k4 + 2], bv[4 * k4 + 3]};
            *(f32x4*)(p.bufA() + (size_t)token * 1024 + c0) = va;
            *(f32x4*)(p.bufB() + (size_t)token * 1024 + c0) = vb;
            if (l31 == 31) {
                *(f32x4*)(p.chA() + (size_t)(b * kNChunk + chunk) * 1024 + c0) = va;
                *(f32x4*)(p.chH() + (size_t)(b * kNChunk + chunk) * 1024 + c0) = vb;
            }
        }

}
__device__ __forceinline__ void rnn1_item(const Params& p, int tg, int n) {
    asm volatile("" : "+s"(n));
    const int tid = tidx(), lane = tid & 63, hi = lane >> 5, l31 = lane & 31;
    const int token = tg * 32 + l31, pos = token & (kS - 1);
    float xc[8][8];
#pragma unroll
    for (int ks = 0; ks < 8; ++ks)
#pragma unroll
        for (int hf = 0; hf < 2; ++hf) {
            const int c0 = n * 128 + 16 * ks + 4 * hi + 8 * hf;
            f32x4 a = *(const f32x4*)(p.conv_b + c0);
#pragma unroll
            for (int j = 0; j < 4; ++j) {
                const f32x4 w = *(const f32x4*)(p.conv_w + j * 1024 + c0);
                const bool inside = pos - 3 + j >= 0;
                f32x4 x = *(const f32x4*)(p.xr() + (size_t)(inside ? token - 3 + j : token) * 1024 + c0);
                const float keep = inside ? 1.0f : 0.0f;
                a = a + (x * keep) * w;
            }
            xc[ks][4 * hf + 0] = a.x; xc[ks][4 * hf + 1] = a.y; xc[ks][4 * hf + 2] = a.z; xc[ks][4 * hf + 3] = a.w;
            if (hf == 1 && (ks & 1)) __builtin_amdgcn_sched_barrier(0);
        }
    bf16x8_t bfr[8];
#pragma unroll
    for (int ks = 0; ks < 8; ++ks) {
        u32x4 w; w.x = pk2(xc[ks][0], xc[ks][1]); w.y = pk2(xc[ks][2], xc[ks][3]); w.z = pk2(xc[ks][4], xc[ks][5]); w.w = pk2(xc[ks][6], xc[ks][7]);
        bfr[ks] = *reinterpret_cast<bf16x8_t*>(&w);
    }
    const int b = token >> 12, chunk = pos >> 5;
    __builtin_amdgcn_sched_barrier(0);
    rnn1_mt<0>(p, xc, bfr, n, token, b, chunk, hi, l31);
    __builtin_amdgcn_sched_barrier(0);
    rnn1_mt<1>(p, xc, bfr, n, token, b, chunk, hi, l31);
    __builtin_amdgcn_sched_barrier(0);
    rnn1_mt<2>(p, xc, bfr, n, token, b, chunk, hi, l31);
    __builtin_amdgcn_sched_barrier(0);
    rnn1_mt<3>(p, xc, bfr, n, token, b, chunk, hi, l31);
}
__device__ __forceinline__ void ph_rnn1(const Params& p) {
    const int wave = __builtin_amdgcn_readfirstlane(tidx() >> 6);
    for (int tg = blockIdx.x; tg < kT / 32; tg += gridDim.x) rnn1_item(p, tg, wave);
}
__device__ __forceinline__ void ph_rnn2(const Params& p, float* lds) {
    const int tid = tidx();
    float* A = lds; float* H = lds + kNChunk * 64;
    for (int u = blockIdx.x; u < 32; u += gridDim.x) {
        const int b = u >> 4, c0 = (u & 15) * 64;
        __syncthreads();
        for (int idx = tid; idx < kNChunk * 64; idx += kNT) {
            const size_t gi = (size_t)(b * kNChunk + (idx >> 6)) * 1024 + c0 + (idx & 63);
            A[idx] = p.chA()[gi]; H[idx] = p.chH()[gi];
        }
        __syncthreads();
        if (tid < 64) {
            float Hc = 0.f;
            for (int ch = 0; ch < kNChunk; ++ch) {
                p.carry()[(size_t)(b * kNChunk + ch) * 1024 + c0 + tid] = Hc;
                Hc = fmaf(A[ch * 64 + tid], Hc, H[ch * 64 + tid]);
            }
        }
    }
    __syncthreads();
}
__device__ __forceinline__ void ph_rnn3(const Params& p) {
    const int tid = tidx(), c4 = (tid & 255) * 4, tsub = tid >> 8;
    for (int cu = blockIdx.x; cu < kT / 32; cu += gridDim.x) {
        const f32x4 cin = *(const f32x4*)(p.carry() + (size_t)cu * 1024 + c4);
#pragma unroll 4
        for (int s = 0; s < 16; ++s) {
            const size_t i = (size_t)(cu * 32 + 2 * s + tsub) * 1024 + c4;
            const f32x4 ca = *(const f32x4*)(p.bufA() + i), hl = *(const f32x4*)(p.bufB() + i);
            const u32x2 gg = *(const u32x2*)(p.gg_bf() + i);
            const f32x4 h = hl + ca * cin;
            u32x2 o;
            o.x = pk2(h.x * __uint_as_float(gg.x << 16), h.y * __uint_as_float(gg.x & 0xFFFF0000u));
            o.y = pk2(h.z * __uint_as_float(gg.y << 16), h.w * __uint_as_float(gg.y & 0xFFFF0000u));
            *(u32x2*)(p.ab_bf() + (size_t)kT * 1024 + i) = o;
        }
    }
}

__device__ __forceinline__ void route_item(const Params& p, int item, unsigned char* smem, bool commit = true) {
    const int tid = tidx(), lane = tid & 63, wave = __builtin_amdgcn_readfirstlane(tid >> 6), hi = lane >> 5, l31 = lane & 31;
    const int t0 = item * 32;
    float* part = (float*)smem;
    float* ssp = (float*)(smem + 131072);
    float* lg = ssp + 32;
    float* rs = lg + 32 * 96;
    float* gl = rs + 32;
    float* bias = gl + 2048;
    const f32x4 gpre = *(const f32x4*)(p.norm2_g + 4 * tid);
    const float bpre = tid < 8 ? p.b_group[tid] : (tid < 72 ? p.b_er[tid - 8] : 0.f);
    f32x16_t acc[3];
#pragma unroll
    for (int a = 0; a < 3; ++a)
#pragma unroll
        for (int r = 0; r < 16; ++r) acc[a][r] = 0.f;
    float ss[4] = {0.f, 0.f, 0.f, 0.f};
    const float* xbase = p.x2() + (size_t)(t0 + 4 * wave) * kD + 4 * lane;
    bf16_t* obase = p.u2_bf() + (size_t)(t0 + 4 * wave) * kD + 4 * lane;
    const bf16_t* wfr = p.WrT() + (size_t)lane * 8;
    const int wks = lane >> 2, whi = (lane >> 1) & 1;
    f32x4 xv[4][4];
#pragma unroll
    for (int j = 0; j < 4; ++j)
#pragma unroll
        for (int i = 0; i < 4; ++i) xv[j][i] = *(const f32x4*)(xbase + (size_t)j * kD + 256 * i);
    __syncthreads();
    *(f32x4*)(gl + 4 * tid) = gpre;
    if (tid < 72) bias[tid] = bpre;
    __syncthreads();
#pragma unroll
    for (int kc = 0; kc < 2; ++kc) {
        f32x4 g4[4];
#pragma unroll
        for (int i = 0; i < 4; ++i) g4[i] = *(const f32x4*)(gl + 1024 * kc + 256 * i + 4 * lane);
        int wbase = wks * 2048 + whi * 512 + (lane & 1) * 8, wrot = 4 * wave + 2 * wks + whi;
        asm volatile("" : "+v"(wbase), "+v"(wrot));
#pragma unroll
        for (int j = 0; j < 4; ++j) {
#pragma unroll
            for (int i = 0; i < 4; ++i) {
                const f32x4 x = xv[j][i];
                ss[j] += (x.x * x.x + x.y * x.y) + (x.z * x.z + x.w * x.w);
                const f32x4 a = x * g4[i];
                u32x2 h; h.x = pk2(a.x, a.y); h.y = pk2(a.z, a.w);
                *(u32x2*)(obase + (size_t)j * kD + 1024 * kc + 256 * i) = h;
                u32x2 lo;
                lo.x = pk2(a.x - __uint_as_float(h.x << 16), a.y - __uint_as_float(h.x & 0xFFFF0000u));
                lo.y = pk2(a.z - __uint_as_float(h.y << 16), a.w - __uint_as_float(h.y & 0xFFFF0000u));
                unsigned char* d = smem + i * 32768 + wbase + ((wrot + j) & 31) * 16;
                *(u32x2*)d = h; *(u32x2*)(d + 1024) = lo;
            }
        }
        if (kc == 0) {
#pragma unroll
            for (int j = 0; j < 4; ++j)
#pragma unroll
                for (int i = 0; i < 4; ++i) xv[j][i] = *(const f32x4*)(xbase + (size_t)j * kD + 1024 + 256 * i);
        }
        if (kc == 1) {
#pragma unroll
            for (int j = 0; j < 4; ++j) { const float s = wave_sum_dpp(ss[j]); if (lane == 0) ssp[4 * wave + j] = s; }
        }
        __syncthreads();
        bf16x8_t wq[2][6];
#pragma unroll
        for (int f = 0; f < 6; ++f) wq[0][f] = *(const bf16x8_t*)(wfr + (size_t)(((64 * kc + 8 * wave) * 6 + f) * 64) * 8);
#pragma unroll
        for (int i = 0; i < 8; ++i) {
            const int ks = 8 * wave + i;
            if (i + 1 < 8) {
#pragma unroll
                for (int f = 0; f < 6; ++f) wq[(i + 1) & 1][f] = *(const bf16x8_t*)(wfr + (size_t)(((64 * kc + ks + 1) * 6 + f) * 64) * 8);
            }
            const unsigned char* s = smem + ((ks * 2) * 2 + hi) * 512 + ((l31 + 2 * ks + hi) & 31) * 16;
            const bf16x8_t ah = *(const bf16x8_t*)s, alo = *(const bf16x8_t*)(s + 1024);
            __builtin_amdgcn_sched_barrier(0);
#pragma unroll
            for (int nt = 0; nt < 3; ++nt) {
                const bf16x8_t bh = wq[i & 1][2 * nt], bl = wq[i & 1][2 * nt + 1];
                acc[nt] = __builtin_amdgcn_mfma_f32_32x32x16_bf16(ah, bh, acc[nt], 0, 0, 0);
                acc[nt] = __builtin_amdgcn_mfma_f32_32x32x16_bf16(ah, bl, acc[nt], 0, 0, 0);
                acc[nt] = __builtin_amdgcn_mfma_f32_32x32x16_bf16(alo, bh, acc[nt], 0, 0, 0);
            }
            __builtin_amdgcn_sched_barrier(0);
        }
        __syncthreads();
    }
#pragma unroll
    for (int nt = 0; nt < 3; ++nt)
#pragma unroll
        for (int r = 0; r < 16; ++r) part[wave * 3072 + (nt * 16 + r) * 64 + lane] = acc[nt][r];
    __syncthreads();
    for (int o = tid; o < 3072; o += kNT) {
        float s = 0.f;
#pragma unroll
        for (int w = 0; w < 8; ++w) s += part[w * 3072 + o];
        const int nt = o >> 10, r = (o >> 6) & 15, ln = o & 63;
        const int trow = (r & 3) + 8 * (r >> 2) + 4 * (ln >> 5), col = 32 * nt + (ln & 31);
        lg[trow * 96 + col] = s;
    }
    if (tid < 32) {
        const float s = ssp[tid];
        const float r = rsqrtf(s * (1.0f / kD) + 1e-6f);
        rs[tid] = r; p.rstd()[t0 + tid] = r;
    }
    __syncthreads();
    if (tid < 32 && commit) {
        const int t = t0 + tid;
        const float r = rs[tid];
        const float* lgt = lg + tid * 96;
        float glg[8];
#pragma unroll
        for (int i = 0; i < 8; ++i) glg[i] = lgt[i] * r + bias[i];
        int g = 0; float m = glg[0];
#pragma unroll
        for (int i = 1; i < 8; ++i) if (glg[i] > m) { m = glg[i]; g = i; }
        float den = 0.f;
#pragma unroll
        for (int i = 0; i < 8; ++i) den += expf(glg[i] - m);
        const float psel = 1.0f / den;
        float el[8];
#pragma unroll
        for (int i = 0; i < 8; ++i) el[i] = lgt[8 + g * 8 + i] * r + bias[8 + g * 8 + i];
        int e0 = 0; float v0 = el[0];
#pragma unroll
        for (int i = 1; i < 8; ++i) if (el[i] > v0) { v0 = el[i]; e0 = i; }
        int e1 = -1; float v1 = -INFINITY;
#pragma unroll
        for (int i = 0; i < 8; ++i) if (i != e0 && el[i] > v1) { v1 = el[i]; e1 = i; }
        const float ex = expf(v1 - v0);
        const float w0 = 1.0f / (1.0f + ex), w1 = ex / (1.0f + ex);
        const int ea = g * 8 + e0, eb = g * 8 + e1;
        const int ra = atomicAdd(p.ecnt() + 128 + 32 * ea, 1), rb = atomicAdd(p.ecnt() + 128 + 32 * eb, 1);
        p.eid()[t * 2 + 0] = ea; p.eid()[t * 2 + 1] = eb;
        p.srank()[t * 2 + 0] = ra; p.srank()[t * 2 + 1] = rb;
        p.tokr()[ea * 16384 + ra] = t; p.tokr()[eb * 16384 + rb] = t;
        p.wrk()[ea * 16384 + ra] = psel * w0; p.wrk()[eb * 16384 + rb] = psel * w1;
    }
}
__device__ __forceinline__ void ph_route_mfma(const Params& p, unsigned char* smem, bool commit = true) {
    for (int i = blockIdx.x; i < kT / 32; i += gridDim.x) route_item(p, i, smem, commit);
    __syncthreads();
}

__device__ __forceinline__ void build_expert_tab(const Params& p, int* tab) {
    const int tid = tidx();
    __syncthreads();
    if (tid < 64) {
        const int c = p.ecnt()[128 + 32 * tid], tiles = (c + moe::MT - 1) / moe::MT;
        int inc = tiles, cin = c;
#pragma unroll
        for (int o = 1; o < 64; o <<= 1) { const int n = __shfl_up(inc, o), n2 = __shfl_up(cin, o); if (tid >= o) { inc += n; cin += n2; } }
        tab[tid] = inc - tiles; tab[65 + tid] = c; tab[129 + tid] = cin - c;
        if (tid == 63) { tab[64] = inc; tab[193] = cin; }
    }
    __syncthreads();
}

__device__ __forceinline__ int find_expert(const int* __restrict__ mtp, int mg) {
    int e = 0;
#pragma unroll 1
    for (int i = 1; i < kNE; ++i) e = (mtp[i] <= mg) ? i : e;
    return e;
}
struct MoeCfg1 {
    static constexpr int K = kD, LDB = kFF;
    Params p; const int* tab; int G, c;
    __device__ __forceinline__ bool next(int i, moe::Unit& u) const {
        const int cc = (G == 256) ? (((c & 7) * 4 + (c >> 6)) * 8 + ((c >> 3) & 7)) : c;
        const int L = i * G + cc, total = tab[kNE] * 8;
        if (L >= total) return false;
        u.pm = L >> 3; u.pn = L & 7; u.ex = find_expert(tab, u.pm);
        return true;
    }
    __device__ __forceinline__ void a_voffs(const moe::Unit& u, int wid, int lane, unsigned (&v)[10]) const {
        const int rb = (u.pm - tab[u.ex]) * moe::MT, cnt = tab[65 + u.ex];
        const int* lst = p.tokr() + u.ex * 16384;
#pragma unroll
        for (int i = 0; i < 10; ++i) {
            int R, Cc; pg8::stage_rc((wid + 4 * i) * 1024 + lane * 16, R, Cc);
            const int r = rb + R;
            const int t = lst[r < cnt ? r : cnt - 1];
            v[i] = (unsigned)(t * kD + Cc) * 2u;
        }
    }
    __device__ __forceinline__ const void* abase() const { return p.u2_bf(); }
    __device__ __forceinline__ const float* bsrc(const moe::Unit& u, int nq) const {
        const int col = 64 * u.pn + 32 * (nq >> 4) + 16 * ((nq >> 3) & 1) + 4 * (nq & 3);
        return (((nq >> 2) & 1) ? p.w_up : p.w_gate) + (size_t)u.ex * kD * kFF + col;
    }
    __device__ __forceinline__ void epilogue(const pg8::f32x4 (&acc)[10][4], const moe::Unit& u, int wr, int wc, int fr, int fq) const {
        const int cnt = tab[65 + u.ex], rk0 = (u.pm - tab[u.ex]) * moe::MT + wr * 160 + fr, row0 = tab[129 + u.ex];
        const int col = 64 * u.pn + 32 * wc + 4 * fq;
#pragma unroll
        for (int m = 0; m < 10; ++m) {
            const int rank = rk0 + 16 * m, rc = rank < cnt ? rank : cnt - 1;
            const float w = p.wrk()[u.ex * 16384 + rc], rs = p.rstd()[p.tokr()[u.ex * 16384 + rc]];
            bf16_t* rowp = p.h_bf() + (size_t)(row0 + rank) * kFF + col;
#pragma unroll
            for (int q = 0; q < 2; ++q) {
                float h[4];
#pragma unroll
                for (int j = 0; j < 4; ++j) { const float g = acc[m][2 * q][j] * rs, uu = acc[m][2 * q + 1][j] * rs; h[j] = g / (1.0f + __expf(-g)) * uu * w; }
                u32x2 o; o.x = pk2(h[0], h[1]); o.y = pk2(h[2], h[3]);
                if (rank < cnt) *(u32x2*)(rowp + 16 * q) = o;
            }
        }
    }
};
struct MoeCfg2 {
    static constexpr int K = kFF, LDB = kD;
    Params p; const int* tab; int G, c;
    __device__ __forceinline__ bool next(int i, moe::Unit& u) const {
        const int cc = (G == 256) ? (((c & 7) * 2 + (c >> 7)) * 16 + ((c >> 3) & 15)) : c;
        const int L = i * G + cc, total = tab[kNE] * 16;
        if (L >= total) return false;
        u.pm = L >> 4; u.pn = L & 15; u.ex = find_expert(tab, u.pm);
        return true;
    }
    __device__ __forceinline__ void a_voffs(const moe::Unit& u, int wid, int lane, unsigned (&v)[10]) const {
        const int row0 = tab[129 + u.ex] + (u.pm - tab[u.ex]) * moe::MT;
#pragma unroll
        for (int i = 0; i < 10; ++i) { int R, Cc; pg8::stage_rc((wid + 4 * i) * 1024 + lane * 16, R, Cc); v[i] = (unsigned)((row0 + R) * kFF + Cc) * 2u; }
    }
    __device__ __forceinline__ const void* abase() const { return p.h_bf(); }
    __device__ __forceinline__ const float* bsrc(const moe::Unit& u, int nq) const { return p.w_down + (size_t)u.ex * kFF * kD + 128 * u.pn + 4 * nq; }
    __device__ __forceinline__ void epilogue(const pg8::f32x4 (&acc)[10][4], const moe::Unit& u, int wr, int wc, int fr, int fq) const {
        const int cnt = tab[65 + u.ex], rk0 = (u.pm - tab[u.ex]) * moe::MT + wr * 160 + fr, row0 = tab[129 + u.ex];
        const int col = 128 * u.pn + 64 * wc + 4 * fq;
#pragma unroll
        for (int m = 0; m < 10; ++m) {
            const int rank = rk0 + 16 * m;
            bf16_t* rowp = p.y_bf() + (size_t)(row0 + rank) * kD + col;
#pragma unroll
            for (int n = 0; n < 4; ++n) {
                const pg8::f32x4 v = acc[m][n];
                u32x2 o; o.x = pk2(v[0], v[1]); o.y = pk2(v[2], v[3]);
                if (rank < cnt) *(u32x2*)(rowp + 16 * n) = o;
            }
        }
    }
};

__device__ __forceinline__ void final_row(const Params& p, int t, const int* tab, int lane) {
    const int pa = tab[129 + p.eid()[2 * t]] + p.srank()[2 * t], pb = tab[129 + p.eid()[2 * t + 1]] + p.srank()[2 * t + 1];
    const f32x4* xr = (const f32x4*)(p.x2() + (size_t)t * kD) + lane;
    const u32x2* ya = (const u32x2*)(p.y_bf() + (size_t)pa * kD) + lane;
    const u32x2* yb = (const u32x2*)(p.y_bf() + (size_t)pb * kD) + lane;
    f32x4 v[8]; u32x2 a[8], c[8];
#pragma unroll
    for (int j = 0; j < 8; ++j) { v[j] = xr[64 * j]; a[j] = ya[64 * j]; c[j] = yb[64 * j]; }
    float ss = 0.f;
#pragma unroll
    for (int j = 0; j < 8; ++j) {
        v[j].x += __uint_as_float(a[j].x << 16) + __uint_as_float(c[j].x << 16);
        v[j].y += __uint_as_float(a[j].x & 0xFFFF0000u) + __uint_as_float(c[j].x & 0xFFFF0000u);
        v[j].z += __uint_as_float(a[j].y << 16) + __uint_as_float(c[j].y << 16);
        v[j].w += __uint_as_float(a[j].y & 0xFFFF0000u) + __uint_as_float(c[j].y & 0xFFFF0000u);
        ss += (v[j].x * v[j].x + v[j].y * v[j].y) + (v[j].z * v[j].z + v[j].w * v[j].w);
    }
    const float sc = rsqrtf(wave_sum(ss) * (1.0f / kD) + 1e-6f);
    const f32x4* gr = (const f32x4*)p.norm_f_g + lane;
    f32x4* orow = (f32x4*)(p.out + (size_t)t * kD) + lane;
#pragma unroll
    for (int j = 0; j < 8; ++j) { const f32x4 g = gr[64 * j]; orow[64 * j] = (f32x4){v[j].x * sc * g.x, v[j].y * sc * g.y, v[j].z * sc * g.z, v[j].w * sc * g.w}; }
}
__device__ __forceinline__ void ph_final2(const Params& p, const int* tab) {
    const int tid = tidx(), lane = tid & 63;
    for (int t = blockIdx.x * 8 + p.wave; t < kT; t += gridDim.x * 8) final_row(p, t, tab, lane);
}

#define GRID_BARRIER() xcd_barrier(bar)
__global__ void __launch_bounds__(512, 2) k_mega(Params p_in) {
    Params p = p_in;
    p.wave = __builtin_amdgcn_readfirstlane(threadIdx.x >> 6);
    extern __shared__ __attribute__((aligned(16))) unsigned char smem[];
    float* lds = (float*)smem;
    PG8_LAS unsigned char* ldsl = (PG8_LAS unsigned char*)smem;
    volatile LAS unsigned* xbw = (volatile LAS unsigned*)(smem + kStageBytes);
    if (tidx() < 4) xbw[tidx()] = 0u;
    __syncthreads();
    XcdBarrier bar = xcd_barrier_post(p.bar(), xbw, (unsigned)p.wave);
    const int G = gridDim.x, c = blockIdx.x;

    ph_prologue(p, lds);
    GRID_BARRIER();
    {
        pg8::Gemm g{p.u_bf(), p.WinT(), kT, kNP, kD};
        pg8::StaticOrder S; S.init(kT, kNP, G, c);
        EpiProj E{p};
        pg8::gemm_phase<EpiProj, pg8::StaticOrder, false>(ldsl, g, S, E, nullptr, p.wave);
    }
    ph_convert_late(p);
    ph_tables(p);
    GRID_BARRIER();
    ph_rnn1(p);
    ph_index_mfma(p, smem);
    GRID_BARRIER();
    ph_rnn2(p, lds);
    ph_attn_mfma(p, smem);
    GRID_BARRIER();
    ph_rnn3(p);
    GRID_BARRIER();
    {
        pg8::Gemm g{p.ab_bf(), p.WpT(), 2 * kT, 2 * kD, 1024};
        MergeOrder S; S.base.init(kT, kD, G, c);
        EpiMerge E{p};
        pg8::gemm_phase<EpiMerge, MergeOrder, false>(ldsl, g, S, E, nullptr, p.wave);
    }
    GRID_BARRIER();
    {
        pg8::Gemm g{p.merged_bf(), p.WoutT(), kT, kD, kD};
        pg8::StaticOrder S; S.init(kT, kD, G, c);
        EpiWout E{p};
        pg8::gemm_phase<EpiWout, pg8::StaticOrder, false>(ldsl, g, S, E, nullptr, p.wave);
    }
    GRID_BARRIER();
    ph_route_mfma(p, smem);
    GRID_BARRIER();
    int* etab = (int*)(smem + kStageBytes + 64 + 1024);
    build_expert_tab(p, etab);
    {
        MoeCfg1 C1{p, etab, G, c};
        moe::gemm<MoeCfg1>(ldsl, C1, p.wave);
    }
    GRID_BARRIER();
    {
        MoeCfg2 C2{p, etab, G, c};
        moe::gemm<MoeCfg2>(ldsl, C2, p.wave);
    }
    GRID_BARRIER();
    ph_final2(p, etab);
}
}

extern "C" void kernel_launch(void* const* d_in, const int* in_sizes, int n_in, void* d_out, int out_size, void* d_ws, size_t ws_size,
                              hipStream_t stream) {
    Params p{};
    const float* const* in = (const float* const*)d_in;
    p.x = in[0]; p.norm1_g = in[1]; p.w_in = in[2]; p.conv_w = in[3]; p.conv_b = in[4]; p.lru_wa = in[5]; p.lru_ba = in[6];
    p.lru_wx = in[7]; p.lru_bx = in[8]; p.lru_lambda = in[9]; p.w_proj_attn = in[10]; p.w_proj_rnn = in[11]; p.w_out = in[12];
    p.rel_bias = in[13]; p.norm2_g = in[14]; p.w_group = in[15]; p.b_group = in[16]; p.w_er = in[17]; p.b_er = in[18];
    p.w_gate = in[19]; p.w_up = in[20]; p.w_down = in[21]; p.norm_f_g = in[22];
    p.out = (float*)d_out;
    p.ws = (unsigned char*)d_ws;
    if (kWsBytes > ws_size) fprintf(stderr, "workspace too small: need %zu, have %zu\n", (size_t)kWsBytes, ws_size);
    static int grid = 0;
    if (!grid) {
        int dev = 0, cus = 0, per_cu = 0;
        (void)hipGetDevice(&dev);
        (void)hipDeviceGetAttribute(&cus, hipDeviceAttributeMultiprocessorCount, dev);
        if (hipFuncSetAttribute((const void*)k_mega, hipFuncAttributeMaxDynamicSharedMemorySize, kLdsBytes) != hipSuccess) fprintf(stderr, "hipFuncSetAttribute failed\n");
        (void)hipOccupancyMaxActiveBlocksPerMultiprocessor(&per_cu, (const void*)k_mega, kNT, kLdsBytes);
        if (per_cu < 1) fprintf(stderr, "occupancy query says %d blocks/CU\n", per_cu);
        (void)hipGetLastError();
        grid = cus;
    }
    (void)hipMemsetAsync(p.ws + O_bar, 0, O_WguT - O_bar, stream);
    hipLaunchKernelGGL(k_mega, dim3(grid), dim3(kNT), kLdsBytes, stream, p);
}
```

```cpp
#include <hip/hip_runtime.h>
#include <stdint.h>
#include <cstdio>

#define XB_TMO      128
#define XB_XCNT(j)  (256  + 64 * (j))
#define XB_XSUB(j)  (1280 + 64 * (j))
#define XB_XGEN(j)  (2304 + 64 * (j))
#define XB_TOP      3328
#define XB_TOPGEN   3392
#define XCD_BAR_WORDS 3456
#define XB_SPIN_CAP (1u << 18)
#define LAS __attribute__((address_space(3)))

__device__ __forceinline__ unsigned xb_ld(unsigned* p)              { return __hip_atomic_load(p, __ATOMIC_RELAXED, __HIP_MEMORY_SCOPE_AGENT); }
__device__ __forceinline__ unsigned xb_add(unsigned* p, unsigned v) { return __hip_atomic_fetch_add(p, v, __ATOMIC_RELAXED, __HIP_MEMORY_SCOPE_AGENT); }
__device__ __forceinline__ unsigned xb_xcc_id() { return (unsigned)__builtin_amdgcn_s_getreg((3 << 11) | 20) & 0xFu; }
#define XB_SPIN(cond, bar) do { unsigned _sp = 0; while (cond) { __builtin_amdgcn_s_sleep(1); \
    if ((++_sp & 255u) == 0u) { if (xb_ld(&(bar)[XB_TMO])) break; if (_sp > XB_SPIN_CAP) { atomicAdd(&(bar)[XB_TMO], 1u); break; } } } } while (0)

struct XcdBarrier {
    unsigned* bar; unsigned x; unsigned wave;
    volatile LAS unsigned* st;
};

__device__ __forceinline__ bool xb_is_thread0(unsigned wave) { unsigned l; asm volatile("v_mbcnt_lo_u32_b32 %0, -1, 0\n\tv_mbcnt_hi_u32_b32 %0, -1, %0" : "=v"(l)); return wave == 0u && l == 0u; }
__device__ __forceinline__ XcdBarrier xcd_barrier_post(unsigned* bar, volatile LAS unsigned* st, unsigned wave) {
    XcdBarrier b; b.bar = bar; b.x = xb_xcc_id(); b.st = st; b.wave = wave;
    if (xb_is_thread0(wave)) (void)xb_add(&bar[XB_XCNT(b.x)], 1u);
    return b;
}
__device__ __forceinline__ void xcd_barrier_complete(unsigned* bar, unsigned x, unsigned& nloc, unsigned& nx) {
    const unsigned G = gridDim.x * gridDim.y * gridDim.z;
    unsigned sum, cnt, mine, sp = 0u;
    for (;;) {
        sum = 0u; cnt = 0u; mine = 0u;
#pragma unroll
        for (unsigned j = 0; j < 16; ++j) { const unsigned c = xb_ld(&bar[XB_XCNT(j)]); sum += c; cnt += (c > 0u) ? 1u : 0u; mine = (j == x) ? c : mine; }
        if (sum == G) break;
        __builtin_amdgcn_s_sleep(1);
        if ((++sp & 255u) == 0u) { if (xb_ld(&bar[XB_TMO])) break; if (sp > XB_SPIN_CAP) { atomicAdd(&bar[XB_TMO], 1u); break; } }
    }
    nloc = mine > 0u ? mine : 1u; nx = cnt > 0u ? cnt : 1u;
}

__device__ __forceinline__ void xcd_barrier(const XcdBarrier& b) {
    asm volatile("s_waitcnt vmcnt(0)" ::: "memory");
    __syncthreads();
    if (xb_is_thread0(b.wave)) {
        unsigned* bar = b.bar;
        __builtin_amdgcn_s_waitcnt(0);
        unsigned nloc = b.st[0], nx = b.st[1];
        if (nloc == 0u) { xcd_barrier_complete(bar, b.x, nloc, nx); b.st[0] = nloc; b.st[1] = nx; }
        const unsigned old = xb_add(&bar[XB_XSUB(b.x)], 1u);
        const unsigned gen = old / nloc;
        if (old + 1u == (gen + 1u) * nloc) {
            __builtin_amdgcn_fence(__ATOMIC_RELEASE, "agent");
            asm volatile("s_waitcnt vmcnt(0)" ::: "memory");
            const unsigned og = xb_add(&bar[XB_TOP], 1u);
            const unsigned tg = og / nx;
            if (og + 1u == (tg + 1u) * nx) xb_add(&bar[XB_TOPGEN], 1u);
            else XB_SPIN(xb_ld(&bar[XB_TOPGEN]) == tg, bar);
            __builtin_amdgcn_fence(__ATOMIC_ACQUIRE, "agent");
            xb_add(&bar[XB_XGEN(b.x)], 1u);
            asm volatile("s_waitcnt vmcnt(0)" ::: "memory");
        } else {
            XB_SPIN(xb_ld(&bar[XB_XGEN(b.x)]) == gen, bar);
            __builtin_amdgcn_fence(__ATOMIC_ACQUIRE, "agent");
            asm volatile("s_waitcnt vmcnt(0)" ::: "memory");
        }
    }
    __syncthreads();
}


namespace pg8 {
#define PG8_LAS __attribute__((address_space(3)))
typedef unsigned short bf16_t;
typedef short bf16x8 __attribute__((ext_vector_type(8)));
typedef float f32x4 __attribute__((ext_vector_type(4)));
typedef unsigned u32x4 __attribute__((ext_vector_type(4)));
constexpr int BM = 256, BK = 64, HALF = 128, HTB = HALF * BK * 2  , STAGE_BYTES = 8 * HTB, NXCD = 8, WGM = 8;

__host__ __device__ __forceinline__ int lds_byte(int r, int c) { const int st = (r >> 4) * 2 + (c >> 5), rr = r & 15, cc = c & 31, ob = rr * 64 + cc * 2; return st * 1024 + (ob ^ (((ob >> 9) & 1) << 5)); }
__host__ __device__ __forceinline__ void stage_rc(int b, int& R, int& C) { const int st = b / 1024, sb = b % 1024, swz = sb ^ (((sb >> 9) & 1) << 5); R = (st >> 1) * 16 + swz / 64; C = (st & 1) * 32 + (swz % 64) / 2; }
__host__ __device__ __forceinline__ int perm32(int rho) { const int n = rho >> 4, i = rho & 15; return 8 * (i >> 2) + 4 * n + (i & 3); }

struct Unit { int pm, pn; };
struct Gemm { const bf16_t* A; const bf16_t* Bt; int M, N, K; };

struct StaticOrder {
    int nM, nN, nwg, G, c;
    __host__ __device__ void init(int M, int N, int G_, int c_) { nM = M / BM; nN = N / BM; nwg = nM * nN; G = G_; c = c_; }
    __host__ __device__ bool next(int i, Unit& u) const {
        const long L = (long)i * G + c; if (L >= nwg) return false;
        int wgid = (int)L; { const int q = nwg / NXCD, r = nwg % NXCD, xcd = wgid % NXCD, off = wgid / NXCD; wgid = (xcd < r ? xcd * (q + 1) : r * (q + 1) + (xcd - r) * q) + off; }
        const int nig = WGM * nN, gid = wgid / nig, fm = gid * WGM, gsz = (nM - fm) < WGM ? (nM - fm) : WGM;
        u.pm = fm + ((wgid % nig) % gsz); u.pn = (wgid % nig) / gsz; return true;
    }
    __device__ __forceinline__ void a_ready(const Unit&) const {}
    __device__ __forceinline__ void done(const Unit&) const {}
};
__device__ __forceinline__ unsigned cvt_pk_bf16(float lo, float hi) { unsigned r; asm volatile("s_nop 0\n\tv_cvt_pk_bf16_f32 %0, %1, %2" : "=v"(r) : "v"(lo), "v"(hi)); return r; }
typedef float f32x2 __attribute__((ext_vector_type(2)));
__device__ __forceinline__ f32x2 gelu_pk(f32x2 v) {
    const f32x2 av = __builtin_elementwise_abs(v), d = av * 0.2316418882f + 1.0f;
    f32x2 t; t.x = __builtin_amdgcn_rcpf(d.x); t.y = __builtin_amdgcn_rcpf(d.y);
    f32x2 q = t * 0.5307027145f + (-0.7265760135f); q = q * t + 0.7107068705f; q = q * t + (-0.142248368f); q = q * t + 0.127414796f; q = q * t;
    const f32x2 s = (v * v) * (-0.72134752044f);
    f32x2 e; e.x = __builtin_amdgcn_exp2f(s.x); e.y = __builtin_amdgcn_exp2f(s.y);
    const f32x2 m = v * (q * e), r = v - m;
    f32x2 o; o.x = v.x < 0.f ? m.x : r.x; o.y = v.y < 0.f ? m.y : r.y; return o;
}

template <class Epi, class Sched, bool STAMP = false>
__device__ __forceinline__ void gemm_phase(PG8_LAS unsigned char* lds, const Gemm g, const Sched& S, const Epi& E, unsigned long long* stamps, int wave0) {
    int lane_l; asm volatile("v_mbcnt_lo_u32_b32 %0, -1, 0\n\tv_mbcnt_hi_u32_b32 %0, -1, %0" : "=v"(lane_l)); const int tid = wave0 * 64 + lane_l, wid = __builtin_amdgcn_readfirstlane(tid >> 6), lane = tid & 63, wr = wid >> 2, wc = wid & 3, fr = lane & 15, fq = lane >> 4;
    const int K = g.K, nt = K / BK;
    int ts_lo = 0, ts_hi = 0, nts = 0; const unsigned long long rt_entry = STAMP ? (unsigned long long)wall_clock64() : 0ull;
#define PG8_STAMP() do { if (STAMP && wid == 0 && nts < 64) { const unsigned long long _c = (unsigned long long)clock64(); \
        ts_lo = (lane == nts) ? (int)(unsigned)_c : ts_lo; ts_hi = (lane == nts) ? (int)(unsigned)(_c >> 32) : ts_hi; ++nts; } } while (0)
    PG8_STAMP();
    unsigned voffA[2], voffB[2];
#pragma unroll
    for (int i = 0; i < 2; ++i) { int R, C; stage_rc(tid * 16 + i * 8192, R, C); const int Rb = Epi::PERM ? ((R & ~31) + perm32(R & 31)) : R;
        voffA[i] = (unsigned)(R * K + C) * 2u; voffB[i] = (unsigned)(Rb * K + C) * 2u; }
    const size_t kstep = (size_t)(BK * 2);
    const size_t hstep = (size_t)HALF * K * 2;
    const size_t tstep = 2 * hstep;
    const unsigned ldsw = (unsigned)wid * 1024u;
    const int aoff = lds_byte(wr * 64 + fr, fq * 8), boff = lds_byte(wc * 32 + fr, fq * 8);
#define PG8_SA(b, h) (((b) * 2 + (h)) * HTB)
#define PG8_SB(b, h) ((4 + (b) * 2 + (h)) * HTB)
#define PG8_STAGE(bufoff, gbase, voff) do { _Pragma("unroll") for (int _i = 0; _i < 2; ++_i) \
        __builtin_amdgcn_global_load_lds((const unsigned*)((const char*)(gbase) + (voff)[_i]), (PG8_LAS unsigned*)(lds + (bufoff) + ldsw + _i * 8192), 16, 0, 0); } while (0)
#define PG8_LDA(dst, b, h) do { _Pragma("unroll") for (int m = 0; m < 4; ++m) _Pragma("unroll") for (int k = 0; k < 2; ++k) dst[m][k] = *(const PG8_LAS bf16x8*)(lds + PG8_SA(b, h) + aoff + m * 2048 + k * 1024); } while (0)
#define PG8_LDB(dst, b, h) do { _Pragma("unroll") for (int n = 0; n < 2; ++n) _Pragma("unroll") for (int k = 0; k < 2; ++k) dst[n][k] = *(const PG8_LAS bf16x8*)(lds + PG8_SB(b, h) + boff + n * 2048 + k * 1024); } while (0)
#define PG8_MMA(ai, bj, At, Bt) do { __builtin_amdgcn_s_setprio(1); _Pragma("unroll") for (int m = 0; m < 4; ++m) _Pragma("unroll") for (int n = 0; n < 2; ++n) _Pragma("unroll") for (int k = 0; k < 2; ++k) \
        acc[ai][bj][m][n] = __builtin_amdgcn_mfma_f32_16x16x32_bf16(Bt[n][k], At[m][k], acc[ai][bj][m][n], 0, 0, 0); __builtin_amdgcn_s_setprio(0); } while (0)
#define PG8_WAIT_V(n) asm volatile("s_waitcnt vmcnt(" #n ")" ::: "memory")
#define PG8_WAIT_L(n) asm volatile("s_waitcnt lgkmcnt(" #n ")" ::: "memory")
#define PG8_BAR __builtin_amdgcn_s_barrier()
#define PG8_SCHED __builtin_amdgcn_sched_barrier(0)
    Unit cur, nxt; int ui = 0;
    if (!S.next(0, cur)) return;
    f32x4 acc[2][2][4][2];
#pragma unroll
    for (int a = 0; a < 2; ++a)
#pragma unroll
        for (int b = 0; b < 2; ++b)
#pragma unroll
            for (int m = 0; m < 4; ++m)
#pragma unroll
                for (int n = 0; n < 2; ++n) acc[a][b][m][n] = (f32x4){0.f, 0.f, 0.f, 0.f};
    bf16x8 At[4][2], B0[2][2], B1[2][2];
    const char* cA = (const char*)g.A + (size_t)cur.pm * tstep; const char* cB = (const char*)g.Bt + (size_t)cur.pn * tstep;
    S.a_ready(cur);
    PG8_STAGE(PG8_SB(0, 0), cB, voffB); PG8_STAGE(PG8_SA(0, 0), cA, voffA); PG8_STAGE(PG8_SB(0, 1), cB + hstep, voffB); PG8_STAGE(PG8_SA(0, 1), cA + hstep, voffA);
    if (wr == 1) PG8_BAR;
    PG8_WAIT_V(4); PG8_BAR;
    PG8_STAGE(PG8_SB(1, 0), cB + kstep, voffB); PG8_STAGE(PG8_SA(1, 0), cA + kstep, voffA); PG8_STAGE(PG8_SB(1, 1), cB + hstep + kstep, voffB);
    PG8_WAIT_V(6); PG8_BAR;
    PG8_STAMP();
    for (;;) {
        const bool has_next = S.next(ui + 1, nxt);
        const char* nA = has_next ? (const char*)g.A + (size_t)nxt.pm * tstep : cA; const char* nB = has_next ? (const char*)g.Bt + (size_t)nxt.pn * tstep : cB;
        for (int t = 0; t < nt; t += 2) {
            const bool last = (t == nt - 2);
            const char* a1 = cA + (size_t)(t + 1) * kstep;
            const char* a2 = last ? nA : cA + (size_t)(t + 2) * kstep; const char* b2 = last ? nB : cB + (size_t)(t + 2) * kstep;
            const char* a3 = a2 + kstep; const char* b3 = b2 + kstep;
            if (last && has_next) S.a_ready(nxt);
            PG8_LDB(B0, 0, 0); PG8_SCHED; PG8_LDA(At, 0, 0); PG8_STAGE(PG8_SA(1, 1), a1 + hstep, voffA);
            PG8_WAIT_L(8); PG8_BAR; PG8_WAIT_L(0); PG8_MMA(0, 0, At, B0); PG8_BAR; PG8_SCHED;
            PG8_LDB(B1, 0, 1); PG8_STAGE(PG8_SB(0, 0), b2, voffB);
            PG8_BAR; PG8_WAIT_L(0); PG8_MMA(0, 1, At, B1); PG8_BAR;
            PG8_LDA(At, 0, 1); PG8_STAGE(PG8_SA(0, 0), a2, voffA);
            PG8_BAR; PG8_WAIT_L(0); PG8_MMA(1, 0, At, B0); PG8_BAR; PG8_SCHED;
            PG8_STAGE(PG8_SB(0, 1), b2 + hstep, voffB);
            PG8_WAIT_V(6); PG8_BAR; PG8_MMA(1, 1, At, B1); PG8_BAR;
            PG8_LDB(B0, 1, 0); PG8_SCHED; PG8_LDA(At, 1, 0); PG8_STAGE(PG8_SA(0, 1), a2 + hstep, voffA);
            PG8_WAIT_L(8); PG8_BAR; PG8_WAIT_L(0); PG8_MMA(0, 0, At, B0); PG8_BAR; PG8_SCHED;
            PG8_LDB(B1, 1, 1); PG8_STAGE(PG8_SB(1, 0), b3, voffB);
            PG8_BAR; PG8_WAIT_L(0); PG8_MMA(0, 1, At, B1); PG8_BAR;
            PG8_LDA(At, 1, 1); PG8_STAGE(PG8_SA(1, 0), a3, voffA);
            PG8_BAR; PG8_WAIT_L(0); PG8_MMA(1, 0, At, B0); PG8_BAR; PG8_SCHED;
            PG8_STAGE(PG8_SB(1, 1), b3 + hstep, voffB);
            PG8_WAIT_V(6); PG8_BAR; PG8_MMA(1, 1, At, B1); PG8_BAR;
        }
        PG8_STAMP();
        bool keep_acc = false;
        if constexpr (!Epi::AFTER_DRAIN) { if constexpr (Epi::CHAIN) keep_acc = E.chain(acc, cur, wr, wc, fr, fq); else E(acc, cur, wr, wc, fr, fq); S.done(cur); }
        PG8_STAMP();
        if (!has_next) break;
        if (!keep_acc) {
#pragma unroll
            for (int a = 0; a < 2; ++a)
#pragma unroll
                for (int b = 0; b < 2; ++b)
#pragma unroll
                    for (int m = 0; m < 4; ++m)
#pragma unroll
                        for (int n = 0; n < 2; ++n) acc[a][b][m][n] = (f32x4){0.f, 0.f, 0.f, 0.f};
        }
        cur = nxt; cA = nA; cB = nB; ++ui;
    }
    PG8_WAIT_V(0);
    if (wr == 0) PG8_BAR;
    PG8_BAR;
    if constexpr (Epi::AFTER_DRAIN) { E.fused(acc, cur, wr, wc, fr, fq, lds, wid, lane); S.done(cur); }
    PG8_STAMP();
    if (STAMP && wid == 0) { stamps[lane] = lane < nts ? (((unsigned long long)(unsigned)ts_hi << 32) | (unsigned)ts_lo) : 0ull;
        if (lane == 62) stamps[62] = rt_entry; if (lane == 63) stamps[63] = (unsigned long long)wall_clock64(); }
#undef PG8_STAMP
#undef PG8_SA
#undef PG8_SB
#undef PG8_STAGE
#undef PG8_LDA
#undef PG8_LDB
#undef PG8_MMA
#undef PG8_WAIT_V
#undef PG8_WAIT_L
#undef PG8_BAR
#undef PG8_SCHED
}

struct UnitX { int pm, pn, ex; };
template <class Epi, class Sched>
__device__ __forceinline__ void gemm_phase2(PG8_LAS unsigned char* lds, const Gemm g, const Sched& S, const Epi& E, int wave0) {
    int lane_l; asm volatile("v_mbcnt_lo_u32_b32 %0, -1, 0\n\tv_mbcnt_hi_u32_b32 %0, -1, %0" : "=v"(lane_l)); const int tid = wave0 * 64 + lane_l, wid = __builtin_amdgcn_readfirstlane(tid >> 6), lane = tid & 63, wr = wid >> 2, wc = wid & 3, fr = lane & 15, fq = lane >> 4;
    const int K = g.K, nt = K / BK;
    int RA[2], CA[2]; unsigned voffB[2];
#pragma unroll
    for (int i = 0; i < 2; ++i) { int R, C; stage_rc(tid * 16 + i * 8192, R, C); const int Rb = Epi::PERM ? ((R & ~31) + perm32(R & 31)) : R;
        RA[i] = R; CA[i] = C; voffB[i] = (unsigned)(Rb * K + C) * 2u; }
    const size_t kstep = (size_t)(BK * 2);
    const size_t hstep = (size_t)HALF * K * 2;
    const unsigned ldsw = (unsigned)wid * 1024u;
    const int aoff = lds_byte(wr * 64 + fr, fq * 8), boff = lds_byte(wc * 32 + fr, fq * 8);
#define PG8_SA(b, h) (((b) * 2 + (h)) * HTB)
#define PG8_SB(b, h) ((4 + (b) * 2 + (h)) * HTB)
#define PG8_STAGE(bufoff, gbase, voff) do { _Pragma("unroll") for (int _i = 0; _i < 2; ++_i) \
        __builtin_amdgcn_global_load_lds((const unsigned*)((const char*)(gbase) + (voff)[_i]), (PG8_LAS unsigned*)(lds + (bufoff) + ldsw + _i * 8192), 16, 0, 0); } while (0)
#define PG8_LDA(dst, b, h) do { _Pragma("unroll") for (int m = 0; m < 4; ++m) _Pragma("unroll") for (int k = 0; k < 2; ++k) dst[m][k] = *(const PG8_LAS bf16x8*)(lds + PG8_SA(b, h) + aoff + m * 2048 + k * 1024); } while (0)
#define PG8_LDB(dst, b, h) do { _Pragma("unroll") for (int n = 0; n < 2; ++n) _Pragma("unroll") for (int k = 0; k < 2; ++k) dst[n][k] = *(const PG8_LAS bf16x8*)(lds + PG8_SB(b, h) + boff + n * 2048 + k * 1024); } while (0)
#define PG8_MMA(ai, bj, At, Bt) do { __builtin_amdgcn_s_setprio(1); _Pragma("unroll") for (int m = 0; m < 4; ++m) _Pragma("unroll") for (int n = 0; n < 2; ++n) _Pragma("unroll") for (int k = 0; k < 2; ++k) \
        acc[ai][bj][m][n] = __builtin_amdgcn_mfma_f32_16x16x32_bf16(Bt[n][k], At[m][k], acc[ai][bj][m][n], 0, 0, 0); __builtin_amdgcn_s_setprio(0); } while (0)
#define PG8_WAIT_V(n) asm volatile("s_waitcnt vmcnt(" #n ")" ::: "memory")
#define PG8_WAIT_L(n) asm volatile("s_waitcnt lgkmcnt(" #n ")" ::: "memory")
#define PG8_BAR __builtin_amdgcn_s_barrier()
#define PG8_SCHED __builtin_amdgcn_sched_barrier(0)
    UnitX cur, nxt; int ui = 0;
    if (!S.next(0, cur)) return;
    f32x4 acc[2][2][4][2];
#pragma unroll
    for (int a = 0; a < 2; ++a)
#pragma unroll
        for (int b = 0; b < 2; ++b)
#pragma unroll
            for (int m = 0; m < 4; ++m)
#pragma unroll
                for (int n = 0; n < 2; ++n) acc[a][b][m][n] = (f32x4){0.f, 0.f, 0.f, 0.f};
    bf16x8 At[4][2], B0[2][2], B1[2][2];
    unsigned vC0[2], vC1[2], vN0[2], vN1[2];
    S.a_voffs(cur, RA, CA, vC0, vC1);
    const char* const A0 = (const char*)g.A;
    const char* cB = (const char*)g.Bt + S.b_off(cur);
    PG8_STAGE(PG8_SB(0, 0), cB, voffB); PG8_STAGE(PG8_SA(0, 0), A0, vC0); PG8_STAGE(PG8_SB(0, 1), cB + hstep, voffB); PG8_STAGE(PG8_SA(0, 1), A0, vC1);
    if (wr == 1) PG8_BAR;
    PG8_WAIT_V(4); PG8_BAR;
    PG8_STAGE(PG8_SB(1, 0), cB + kstep, voffB); PG8_STAGE(PG8_SA(1, 0), A0 + kstep, vC0); PG8_STAGE(PG8_SB(1, 1), cB + hstep + kstep, voffB);
    PG8_WAIT_V(6); PG8_BAR;
    for (;;) {
        const bool has_next = S.next(ui + 1, nxt);
        const char* nB = has_next ? (const char*)g.Bt + S.b_off(nxt) : cB;
        if (has_next) S.a_voffs(nxt, RA, CA, vN0, vN1);
        else { vN0[0] = vC0[0]; vN0[1] = vC0[1]; vN1[0] = vC1[0]; vN1[1] = vC1[1]; }
        for (int t = 0; t < nt; t += 2) {
            const bool last = (t == nt - 2);
            const char* a1 = A0 + (size_t)(t + 1) * kstep;
            const char* a2 = last ? A0 : A0 + (size_t)(t + 2) * kstep; const char* b2 = last ? nB : cB + (size_t)(t + 2) * kstep;
            const char* a3 = a2 + kstep; const char* b3 = b2 + kstep;
            unsigned w0[2], w1[2];
            w0[0] = last ? vN0[0] : vC0[0]; w0[1] = last ? vN0[1] : vC0[1]; w1[0] = last ? vN1[0] : vC1[0]; w1[1] = last ? vN1[1] : vC1[1];
            PG8_LDB(B0, 0, 0); PG8_SCHED; PG8_LDA(At, 0, 0); PG8_STAGE(PG8_SA(1, 1), a1, vC1);
            PG8_WAIT_L(8); PG8_BAR; PG8_WAIT_L(0); PG8_MMA(0, 0, At, B0); PG8_BAR; PG8_SCHED;
            PG8_LDB(B1, 0, 1); PG8_STAGE(PG8_SB(0, 0), b2, voffB);
            PG8_BAR; PG8_WAIT_L(0); PG8_MMA(0, 1, At, B1); PG8_BAR;
            PG8_LDA(At, 0, 1); PG8_STAGE(PG8_SA(0, 0), a2, w0);
            PG8_BAR; PG8_WAIT_L(0); PG8_MMA(1, 0, At, B0); PG8_BAR; PG8_SCHED;
            PG8_STAGE(PG8_SB(0, 1), b2 + hstep, voffB);
            PG8_WAIT_V(6); PG8_BAR; PG8_MMA(1, 1, At, B1); PG8_BAR;
            PG8_LDB(B0, 1, 0); PG8_SCHED; PG8_LDA(At, 1, 0); PG8_STAGE(PG8_SA(0, 1), a2, w1);
            PG8_WAIT_L(8); PG8_BAR; PG8_WAIT_L(0); PG8_MMA(0, 0, At, B0); PG8_BAR; PG8_SCHED;
            PG8_LDB(B1, 1, 1); PG8_STAGE(PG8_SB(1, 0), b3, voffB);
            PG8_BAR; PG8_WAIT_L(0); PG8_MMA(0, 1, At, B1); PG8_BAR;
            PG8_LDA(At, 1, 1); PG8_STAGE(PG8_SA(1, 0), a3, w0);
            PG8_BAR; PG8_WAIT_L(0); PG8_MMA(1, 0, At, B0); PG8_BAR; PG8_SCHED;
            PG8_STAGE(PG8_SB(1, 1), b3 + hstep, voffB);
            PG8_WAIT_V(6); PG8_BAR; PG8_MMA(1, 1, At, B1); PG8_BAR;
        }
        E(acc, cur, wr, wc, fr, fq);
        if (!has_next) break;
#pragma unroll
        for (int a = 0; a < 2; ++a)
#pragma unroll
            for (int b = 0; b < 2; ++b)
#pragma unroll
                for (int m = 0; m < 4; ++m)
#pragma unroll
                    for (int n = 0; n < 2; ++n) acc[a][b][m][n] = (f32x4){0.f, 0.f, 0.f, 0.f};
        cur = nxt; cB = nB; ++ui;
        vC0[0] = vN0[0]; vC0[1] = vN0[1]; vC1[0] = vN1[0]; vC1[1] = vN1[1];
    }
    PG8_WAIT_V(0);
    if (wr == 0) PG8_BAR;
    PG8_BAR;
#undef PG8_SA
#undef PG8_SB
#undef PG8_STAGE
#undef PG8_LDA
#undef PG8_LDB
#undef PG8_MMA
#undef PG8_WAIT_V
#undef PG8_WAIT_L
#undef PG8_BAR
#undef PG8_SCHED
}
}


namespace moe {
using pg8::bf16x8; using pg8::f32x4; using pg8::lds_byte; using pg8::stage_rc; using pg8::HTB; using pg8::BK; using pg8::HALF;
struct Unit { int pm, pn, ex; };
typedef unsigned u32x4_t __attribute__((ext_vector_type(4)));
constexpr int MT = 320, RG = MT / 16, ASLOT = RG * 2048;
#define MOE_SA(s) ((s) * ASLOT)
#define MOE_SB(b) (3 * ASLOT + (b) * HTB)
#define MOE_SYNC() do { asm volatile("s_waitcnt lgkmcnt(0)" ::: "memory"); __builtin_amdgcn_s_barrier(); asm volatile("" ::: "memory"); } while (0)
#define MOE_BLOAD(R, src) do { const float* _s = (src); \
        asm volatile("global_load_dwordx4 %0, %8, off nt\n\tglobal_load_dwordx4 %1, %9, off nt\n\tglobal_load_dwordx4 %2, %10, off nt\n\tglobal_load_dwordx4 %3, %11, off nt\n\t" \
                     "global_load_dwordx4 %4, %12, off nt\n\tglobal_load_dwordx4 %5, %13, off nt\n\tglobal_load_dwordx4 %6, %14, off nt\n\tglobal_load_dwordx4 %7, %15, off nt" \
                     : "=&v"(R[0]), "=&v"(R[1]), "=&v"(R[2]), "=&v"(R[3]), "=&v"(R[4]), "=&v"(R[5]), "=&v"(R[6]), "=&v"(R[7]) \
                     : "v"(_s), "v"(_s + (size_t)1 * Cfg::LDB), "v"(_s + (size_t)2 * Cfg::LDB), "v"(_s + (size_t)3 * Cfg::LDB), \
                       "v"(_s + (size_t)4 * Cfg::LDB), "v"(_s + (size_t)5 * Cfg::LDB), "v"(_s + (size_t)6 * Cfg::LDB), "v"(_s + (size_t)7 * Cfg::LDB) : "memory"); } while (0)
#define MOE_BWAIT(R, n) asm volatile("s_waitcnt vmcnt(" #n ")" : "+v"(R[0]), "+v"(R[1]), "+v"(R[2]), "+v"(R[3]), "+v"(R[4]), "+v"(R[5]), "+v"(R[6]), "+v"(R[7]) :: "memory")
#define MOE_BWRITE(slot, R) do { _Pragma("unroll") for (int _i = 0; _i < 4; ++_i) { u32x4_t _w; \
        _w.x = pg8::cvt_pk_bf16(R[0][_i], R[1][_i]); _w.y = pg8::cvt_pk_bf16(R[2][_i], R[3][_i]); _w.z = pg8::cvt_pk_bf16(R[4][_i], R[5][_i]); _w.w = pg8::cvt_pk_bf16(R[6][_i], R[7][_i]); \
        *(PG8_LAS u32x4_t*)(lds + (slot) + bw[_i]) = _w; } } while (0)

template <class Cfg>
__device__ __forceinline__ void gemm(PG8_LAS unsigned char* lds, const Cfg& C, int wave0) {
    int tid_l; { int lane_; asm volatile("v_mbcnt_lo_u32_b32 %0, -1, 0\n\tv_mbcnt_hi_u32_b32 %0, -1, %0 ; moe K=%1" : "=v"(lane_) : "i"(Cfg::K)); tid_l = wave0 * 64 + lane_; }
    const int tid = tid_l, wid = __builtin_amdgcn_readfirstlane(tid >> 6), lane = tid & 63;
    constexpr int K = Cfg::K, nt = K / BK;
    static_assert(nt % 4 == 0 && nt >= 8, "K-tile count");
    const size_t kstep = (size_t)(BK * 2);
    Unit u, un;
    if (!C.next(0, u)) return;
    if (wid >= 4) {
        int t256_l; asm volatile("v_mbcnt_lo_u32_b32 %0, -1, 0\n\tv_mbcnt_hi_u32_b32 %0, -1, %0 ; moe loader K=%1" : "=v"(t256_l) : "i"(Cfg::K)); t256_l += (wid - 4) * 64;
        const int t256 = t256_l, nq = t256 & 31, kq = t256 >> 5;
        unsigned bw[4];
#pragma unroll
        for (int i = 0; i < 4; ++i) bw[i] = (unsigned)lds_byte(4 * nq + i, 8 * kq);
        const float* bsrc = C.bsrc(u, nq) + (size_t)(8 * kq) * Cfg::LDB;
        f32x4 R0[8], R1[8], R2[8], R3[8];
        __builtin_amdgcn_s_waitcnt(0);
        MOE_BLOAD(R0, bsrc);
        MOE_BWAIT(R0, 0);
        MOE_BWRITE(MOE_SB(0), R0);
        MOE_BLOAD(R1, bsrc + (size_t)1 * BK * Cfg::LDB);
        MOE_BLOAD(R2, bsrc + (size_t)2 * BK * Cfg::LDB);
        MOE_BLOAD(R3, bsrc + (size_t)3 * BK * Cfg::LDB);
        MOE_SYNC();
        for (int ui = 0;; ++ui) {
            const bool has_next = C.next(ui + 1, un);
            const float* bnext = has_next ? C.bsrc(un, nq) + (size_t)(8 * kq) * Cfg::LDB : bsrc;
#pragma unroll 1
            for (int t = 0; t < nt; t += 4) {
                const bool tail = (t + 4 >= nt);
                const float* q0 = tail ? bnext : bsrc + (size_t)(t + 4) * BK * Cfg::LDB;
                MOE_BWAIT(R1, 16); MOE_BWRITE(MOE_SB(1), R1); MOE_BLOAD(R0, q0);                                     MOE_SYNC();
                MOE_BWAIT(R2, 16); MOE_BWRITE(MOE_SB(0), R2); MOE_BLOAD(R1, q0 + (size_t)1 * BK * Cfg::LDB);          MOE_SYNC();
                MOE_BWAIT(R3, 16); MOE_BWRITE(MOE_SB(1), R3); MOE_BLOAD(R2, q0 + (size_t)2 * BK * Cfg::LDB);          MOE_SYNC();
                MOE_BWAIT(R0, 16); MOE_BWRITE(MOE_SB(0), R0); MOE_BLOAD(R3, q0 + (size_t)3 * BK * Cfg::LDB);          MOE_SYNC();
            }
            if (!has_next) break;
            bsrc = bnext;
        }
        MOE_BWAIT(R1, 0);
        MOE_SYNC();
        return;
    }
    int lane_c = lane; asm volatile("" : "+v"(lane_c));
    const int wr = wid >> 1, wc = wid & 1, fr = lane_c & 15, fq = lane_c >> 4;
    constexpr int NP = RG / 2;
    const int aoff = lds_byte(fr, fq * 8), boff = lds_byte(wc * 64 + fr, fq * 8);
#define MOE_STAGE(slot, gbase, v) do { _Pragma("unroll") for (int _i = 0; _i < NP; ++_i) \
        __builtin_amdgcn_global_load_lds((const unsigned*)((const char*)(gbase) + (v)[_i]), (PG8_LAS unsigned*)(lds + MOE_SA(slot) + (wid + 4 * _i) * 1024), 16, 0, 0); } while (0)
    unsigned vA[NP];
    C.a_voffs(u, wid, lane, vA);
    const char* const A0 = (const char*)C.abase();
    f32x4 acc[10][4];
#pragma unroll
    for (int m = 0; m < 10; ++m)
#pragma unroll
        for (int n = 0; n < 4; ++n) acc[m][n] = (f32x4){0.f, 0.f, 0.f, 0.f};
    int sl = 0;
    MOE_STAGE(0, A0, vA);
    MOE_STAGE(1, A0 + kstep, vA);
    asm volatile("s_waitcnt vmcnt(10)" ::: "memory");
    MOE_SYNC();
    for (int ui = 0;; ++ui) {
        const bool has_next = C.next(ui + 1, un);
#pragma unroll 1
        for (int t = 0; t < nt; ++t) {
            const bool tail = (t + 2 >= nt);
            const int s2 = sl == 0 ? 2 : sl - 1;
            if (t == nt - 2 && has_next) C.a_voffs(un, wid, lane, vA);
            MOE_STAGE(s2, A0 + (size_t)(tail ? t + 2 - nt : t + 2) * kstep, vA);
            const PG8_LAS unsigned char* ab = lds + MOE_SA(sl) + wr * (10 * 2048) + aoff;
            const PG8_LAS unsigned char* bb = lds + MOE_SB(t & 1) + boff;
            bf16x8 Bf[4][2], Af[2][2];
#define MOE_LDA(buf, m_) do { _Pragma("unroll") for (int k = 0; k < 2; ++k) Af[buf][k] = *(const PG8_LAS bf16x8*)(ab + (m_) * 2048 + k * 1024); } while (0)
#pragma unroll
            for (int n = 0; n < 4; ++n)
#pragma unroll
                for (int k = 0; k < 2; ++k) Bf[n][k] = *(const PG8_LAS bf16x8*)(bb + n * 2048 + k * 1024);
            MOE_LDA(0, 0);
#pragma unroll
            for (int m = 0; m < 10; ++m) {
                __builtin_amdgcn_sched_barrier(0);
                __builtin_amdgcn_s_setprio(1);
                acc[m][0] = __builtin_amdgcn_mfma_f32_16x16x32_bf16(Bf[0][0], Af[m & 1][0], acc[m][0], 0, 0, 0);
                __builtin_amdgcn_sched_barrier(0);
                if (m < 9) MOE_LDA((m + 1) & 1, m + 1);
                __builtin_amdgcn_sched_barrier(0);
                acc[m][0] = __builtin_amdgcn_mfma_f32_16x16x32_bf16(Bf[0][1], Af[m & 1][1], acc[m][0], 0, 0, 0);
#pragma unroll
                for (int n = 1; n < 4; ++n)
#pragma unroll
                    for (int k = 0; k < 2; ++k) acc[m][n] = __builtin_amdgcn_mfma_f32_16x16x32_bf16(Bf[n][k], Af[m & 1][k], acc[m][n], 0, 0, 0);
                __builtin_amdgcn_s_setprio(0);
                __builtin_amdgcn_sched_barrier(0);
            }
#undef MOE_LDA
            asm volatile("s_waitcnt vmcnt(10)" ::: "memory");
            MOE_SYNC();
            sl = sl == 2 ? 0 : sl + 1;
        }
        C.epilogue(acc, u, wr, wc, fr, fq);
        if (!has_next) break;
#pragma unroll
        for (int m = 0; m < 10; ++m)
#pragma unroll
            for (int n = 0; n < 4; ++n) acc[m][n] = (f32x4){0.f, 0.f, 0.f, 0.f};
        u = un;
    }
    asm volatile("s_waitcnt vmcnt(0)" ::: "memory");
    MOE_SYNC();
#undef MOE_STAGE
}
#undef MOE_SA
#undef MOE_SB
#undef MOE_SYNC
#undef MOE_BLOAD
#undef MOE_BWAIT
#undef MOE_BWRITE
}

namespace {
typedef unsigned short bf16_t;
typedef float f32x4 __attribute__((ext_vector_type(4)));
typedef unsigned u32x4 __attribute__((ext_vector_type(4)));
typedef unsigned u32x2 __attribute__((ext_vector_type(2)));

constexpr int kS = 4096, kT = 8192, kD = 2048;
constexpr int kNC = 8784;
constexpr int kNP = 8960;
constexpr int kNT = 512;
constexpr int kTopK = 256;
constexpr int kNE = 64, kFF = 512, kSlots = 2 * kT;
constexpr int kChunk = 32, kNChunk = kS / kChunk;
constexpr int kStageBytes = 155648;
constexpr int kLdsBytes = kStageBytes + 64 + 1024 + 1024;

constexpr size_t al256(size_t x) { return (x + 255) & ~(size_t)255; }
constexpr size_t O_bar = 0;
constexpr size_t O_ecnt = O_bar + al256((size_t)XCD_BAR_WORDS * 4);
constexpr size_t O_WguT = O_ecnt + 512 + 64 * 128;
constexpr size_t O_WdT = O_WguT + 256;
constexpr size_t O_WinT = O_WdT + 256;
constexpr size_t O_WpT = O_WinT + al256((size_t)kNP * kD * 2);
constexpr size_t O_WoutT = O_WpT + al256((size_t)2 * kD * 1024 * 2);
constexpr size_t O_u_bf = O_WoutT + al256((size_t)kD * kD * 2);
constexpr size_t O_q_bf = O_u_bf + al256((size_t)kT * kD * 2);
constexpr size_t O_k_bf = O_q_bf + al256((size_t)kT * 1024 * 2);
constexpr size_t O_vT = O_k_bf + al256((size_t)kT * 256 * 2);
constexpr size_t O_qi_bf = O_vT + al256((size_t)kT * 256 * 2);
constexpr size_t O_ki_bf = O_qi_bf + al256((size_t)kT * 1024 * 2);
constexpr size_t O_gg_bf = O_ki_bf + al256((size_t)kT * 64 * 2);
constexpr size_t O_sga_bf = O_gg_bf + al256((size_t)kT * 1024 * 2);
constexpr size_t O_sgr_bf = O_sga_bf + al256((size_t)kT * kD * 2);
constexpr size_t O_ab_bf = O_sgr_bf + al256((size_t)kT * kD * 2);
constexpr size_t O_merged_bf = O_ab_bf + al256((size_t)2 * kT * 1024 * 2);
constexpr size_t O_wi = O_merged_bf + al256((size_t)kT * kD * 2);
constexpr size_t O_xr = O_wi + al256((size_t)kT * 16 * 4);
constexpr size_t O_bufA = O_xr + al256((size_t)kT * 1024 * 4);
constexpr size_t O_bufB = O_bufA + al256((size_t)kT * 1024 * 4);
constexpr size_t O_chA = O_bufB + al256((size_t)kT * 1024 * 4);
constexpr size_t O_chH = O_chA + al256((size_t)2 * kNChunk * 1024 * 4);
constexpr size_t O_carry = O_chH + al256((size_t)2 * kNChunk * 1024 * 4);
constexpr size_t O_x2 = O_carry + al256((size_t)2 * kNChunk * 1024 * 4);
constexpr size_t O_ew = O_x2 + al256((size_t)kT * kD * 4);
constexpr size_t O_lw = O_ew + al256((size_t)kSlots * 4);
constexpr size_t O_mask = O_lw + al256((size_t)32768 * 4);
constexpr size_t O_eid = O_mask + al256((size_t)kT * 512);
constexpr size_t O_ltok = O_eid + al256((size_t)kSlots * 4);
constexpr size_t O_slotpos = O_ltok + al256((size_t)32768 * 4);
constexpr size_t O_mtp = O_slotpos + al256((size_t)kSlots * 4);
constexpr size_t O_sc = O_mtp + al256((size_t)512);
constexpr size_t O_WrT = O_sc + al256((size_t)kT * kS * 4);
constexpr size_t O_rstd = O_WrT + al256((size_t)2 * 96 * kD * 2);
constexpr size_t O_lrs = O_rstd + al256((size_t)kT * 4);
constexpr size_t O_WgT = O_lrs + al256((size_t)32768 * 4);
constexpr size_t O_spl = O_WgT + al256((size_t)2 * 8 * 128 * 128 * 2);
constexpr size_t O_tokr = O_spl + al256((size_t)1024 * 4);
constexpr size_t O_wrk = O_tokr + al256((size_t)kNE * 16384 * 4);
constexpr size_t O_srank = O_wrk + al256((size_t)kNE * 16384 * 4);
constexpr size_t kWsBytes = O_srank + al256((size_t)kSlots * 4);
struct Params {
    const float *x, *norm1_g, *w_in, *conv_w, *conv_b, *lru_wa, *lru_ba, *lru_wx, *lru_bx, *lru_lambda, *w_proj_attn,
        *w_proj_rnn, *w_out, *rel_bias, *norm2_g, *w_group, *b_group, *w_er, *b_er, *w_gate, *w_up, *w_down, *norm_f_g;
    float* out;
    unsigned char* ws;
    int wave, pad_;
    __device__ __forceinline__ unsigned* bar() const { return (unsigned*)(ws + O_bar); }
    __device__ __forceinline__ bf16_t* WguT() const { return (bf16_t*)(ws + O_WguT); }
    __device__ __forceinline__ bf16_t* WdT() const { return (bf16_t*)(ws + O_WdT); }
    __device__ __forceinline__ bf16_t* WinT() const { return (bf16_t*)(ws + O_WinT); }
    __device__ __forceinline__ bf16_t* WpT() const { return (bf16_t*)(ws + O_WpT); }
    __device__ __forceinline__ bf16_t* WoutT() const { return (bf16_t*)(ws + O_WoutT); }
    __device__ __forceinline__ bf16_t* u_bf() const { return (bf16_t*)(ws + O_u_bf); }
    __device__ __forceinline__ bf16_t* q_bf() const { return (bf16_t*)(ws + O_q_bf); }
    __device__ __forceinline__ bf16_t* k_bf() const { return (bf16_t*)(ws + O_k_bf); }
    __device__ __forceinline__ bf16_t* vT() const { return (bf16_t*)(ws + O_vT); }
    __device__ __forceinline__ bf16_t* qi_bf() const { return (bf16_t*)(ws + O_qi_bf); }
    __device__ __forceinline__ bf16_t* ki_bf() const { return (bf16_t*)(ws + O_ki_bf); }
    __device__ __forceinline__ bf16_t* gg_bf() const { return (bf16_t*)(ws + O_gg_bf); }
    __device__ __forceinline__ bf16_t* sga_bf() const { return (bf16_t*)(ws + O_sga_bf); }
    __device__ __forceinline__ bf16_t* sgr_bf() const { return (bf16_t*)(ws + O_sgr_bf); }
    __device__ __forceinline__ bf16_t* ab_bf() const { return (bf16_t*)(ws + O_ab_bf); }
    __device__ __forceinline__ bf16_t* merged_bf() const { return (bf16_t*)(ws + O_merged_bf); }
    __device__ __forceinline__ float* wi() const { return (float*)(ws + O_wi); }
    __device__ __forceinline__ float* xr() const { return (float*)(ws + O_xr); }
    __device__ __forceinline__ float* bufA() const { return (float*)(ws + O_bufA); }
    __device__ __forceinline__ float* bufB() const { return (float*)(ws + O_bufB); }
    __device__ __forceinline__ float* chA() const { return (float*)(ws + O_chA); }
    __device__ __forceinline__ float* chH() const { return (float*)(ws + O_chH); }
    __device__ __forceinline__ float* carry() const { return (float*)(ws + O_carry); }
    __device__ __forceinline__ float* x2() const { return (float*)(ws + O_x2); }
    __device__ __forceinline__ float* ew() const { return (float*)(ws + O_ew); }
    __device__ __forceinline__ float* lw() const { return (float*)(ws + O_lw); }
    __device__ __forceinline__ unsigned char* mask() const { return (unsigned char*)(ws + O_mask); }
    __device__ __forceinline__ int* eid() const { return (int*)(ws + O_eid); }
    __device__ __forceinline__ int* ltok() const { return (int*)(ws + O_ltok); }
    __device__ __forceinline__ int* slotpos() const { return (int*)(ws + O_slotpos); }
    __device__ __forceinline__ int* mtp() const { return (int*)(ws + O_mtp); }
    __device__ __forceinline__ float* sc() const { return (float*)(ws + O_sc); }
    __device__ __forceinline__ bf16_t* WrT() const { return (bf16_t*)(ws + O_WrT); }
    __device__ __forceinline__ float* rstd() const { return (float*)(ws + O_rstd); }
    __device__ __forceinline__ float* lrs() const { return (float*)(ws + O_lrs); }
    __device__ __forceinline__ bf16_t* WgT() const { return (bf16_t*)(ws + O_WgT); }
    __device__ __forceinline__ float* spl() const { return (float*)(ws + O_spl); }
    __device__ __forceinline__ int* ecnt() const { return (int*)(ws + O_ecnt); }
    __device__ __forceinline__ int* tokr() const { return (int*)(ws + O_tokr); }
    __device__ __forceinline__ float* wrk() const { return (float*)(ws + O_wrk); }
    __device__ __forceinline__ int* srank() const { return (int*)(ws + O_srank); }
    __device__ __forceinline__ bf16_t* u2_bf() const { return (bf16_t*)(ws + O_u_bf); }
    __device__ __forceinline__ bf16_t* h_bf() const { return (bf16_t*)(ws + O_q_bf); }
    __device__ __forceinline__ bf16_t* y_bf() const { return (bf16_t*)(ws + O_sga_bf); }
    __device__ __forceinline__ float* tmp() const { return (float*)(ws + O_bufA); }
};

__device__ __forceinline__ int tidx_w(int wave) {
    int lane; asm volatile("v_mbcnt_lo_u32_b32 %0, -1, 0\n\tv_mbcnt_hi_u32_b32 %0, -1, %0" : "=v"(lane));
    return wave * 64 + lane;
}
#define tidx() tidx_w(p.wave)
__device__ __forceinline__ float bf2f(bf16_t b) { return __uint_as_float(((unsigned)b) << 16); }
__device__ __forceinline__ bf16_t f2bf(float f) { unsigned u = __float_as_uint(f); u += 0x7FFFu + ((u >> 16) & 1u); return (bf16_t)(u >> 16); }
__device__ __forceinline__ unsigned pk2(float lo, float hi) { return pg8::cvt_pk_bf16(lo, hi); }

__device__ __forceinline__ float wave_sum(float v) {
#pragma unroll
    for (int o = 32; o; o >>= 1) v += __shfl_xor(v, o);
    return v;
}
__device__ __forceinline__ float wave_sum_dpp(float v) {
#define WS_DPP(ctrl) v += __uint_as_float((unsigned)__builtin_amdgcn_update_dpp(0, (int)__float_as_uint(v), ctrl, 0xF, 0xF, true))
    WS_DPP(0xB1); WS_DPP(0x4E); WS_DPP(0x141); WS_DPP(0x140);
#undef WS_DPP
    const int iv = (int)__float_as_uint(v);
    return (__uint_as_float((unsigned)__builtin_amdgcn_readlane(iv, 0)) + __uint_as_float((unsigned)__builtin_amdgcn_readlane(iv, 16)))
         + (__uint_as_float((unsigned)__builtin_amdgcn_readlane(iv, 32)) + __uint_as_float((unsigned)__builtin_amdgcn_readlane(iv, 48)));
}
__device__ __forceinline__ int wave_sum_i(int v) {
#pragma unroll
    for (int o = 32; o; o >>= 1) v += __shfl_xor(v, o);
    return v;
}
__device__ __forceinline__ float block_sum(float v, float* red, int wave) {
    v = wave_sum(v);
    __syncthreads();
    if ((tidx_w(wave) & 63) == 0) red[wave] = v;
    __syncthreads();
    float s = 0.f;
#pragma unroll
    for (int i = 0; i < 8; ++i) s += red[i];
    return s;
}
__device__ __forceinline__ float sigmoidf_(float x) { return __builtin_amdgcn_rcpf(1.0f + __expf(-x)); }
__device__ __forceinline__ float gelu_tanh(float x) {
    const float y2 = 1.5957691216057308f * (x + 0.044715f * x * x * x);
    return x * __builtin_amdgcn_rcpf(1.0f + __expf(-y2));
}
__device__ __forceinline__ int swap23(int v) { return (v & ~12) | ((v & 4) << 1) | ((v & 8) >> 1); }
__device__ __forceinline__ size_t vt_index(int b, int g, int d, int s) { return ((size_t)((b * 2 + g) * 128 + d)) * kS + (size_t)((s & ~15) | swap23(s & 15)); }

__device__ __forceinline__ void xpose_item(const float* __restrict__ W, int ldw, bf16_t* __restrict__ WT, int Kt, int k0, int ncol, bool valid, size_t orow) {
    f32x4 v[32];
    const float* src = W + (size_t)k0 * ldw + (valid ? ncol : 0);
#pragma unroll
    for (int kk = 0; kk < 32; ++kk) v[kk] = *(const f32x4*)(src + (size_t)kk * ldw);
    if (valid) {
#pragma unroll
        for (int j = 0; j < 4; ++j) {
            bf16_t* dst = WT + (orow + j) * (size_t)Kt + k0;
#pragma unroll
            for (int q = 0; q < 4; ++q) {
                u32x4 o;
                o.x = pk2(v[8 * q + 0][j], v[8 * q + 1][j]); o.y = pk2(v[8 * q + 2][j], v[8 * q + 3][j]);
                o.z = pk2(v[8 * q + 4][j], v[8 * q + 5][j]); o.w = pk2(v[8 * q + 6][j], v[8 * q + 7][j]);
                *(u32x4*)(dst + 8 * q) = o;
            }
        }
    }
}
constexpr int XI_IN = (kD / 32) * 35;
constexpr int XI_P = (1024 / 32) * (kD / 256);
constexpr int XI_O = (kD / 32) * (kD / 256);
constexpr int XI_E = 3 * 128;
constexpr int XI_LATE = 2 * XI_P + XI_O;
__device__ __forceinline__ void xpose_in_item(const Params& p, int r, int lane) {
    const int nb = r % 35, kb = r / 35, n = nb * 256 + 4 * lane;
    xpose_item(p.w_in, kNC, p.WinT(), kD, kb * 32, n, n < kNC, (size_t)(n < 2640 ? n : n + 176));
}
__device__ __forceinline__ void xpose_late_item(const Params& p, int r, int lane) {
    if (r < 2 * XI_P) {
        const int which = r / XI_P; r -= which * XI_P;
        const int nb = r & 7, kb = r >> 3, n = nb * 256 + 4 * lane;
        xpose_item(which ? p.w_proj_rnn : p.w_proj_attn, kD, p.WpT(), 1024, kb * 32, n, true, (size_t)(which * kD + n));
        return;
    }
    r -= 2 * XI_P;
    if (r < XI_O) {
        const int nb = r & 7, kb = r >> 3, n = nb * 256 + 4 * lane;
        xpose_item(p.w_out, kD, p.WoutT(), kD, kb * 32, n, true, (size_t)n);
        return;
    }
}
__device__ __forceinline__ void ph_convert_late(const Params& p, int qi = 0) {
    const int lane = tidx() & 63;
    constexpr int BATCH = 8;
    for (;;) {
        int it = 0;
        if (lane == 0) it = atomicAdd(p.ecnt() + 64 + qi, BATCH);
        it = __builtin_amdgcn_readfirstlane(it);
        if (it >= XI_LATE) break;
#pragma unroll 1
        for (int k = 0; k < BATCH; ++k) if (it + k < XI_LATE) xpose_late_item(p, it + k, lane);
    }
}
__device__ __forceinline__ void norm1_rows2(const Params& p, int m0, int m1, int lane) {
    const f32x4* xa = (const f32x4*)(p.x + (size_t)m0 * kD) + lane;
    const f32x4* xb = (const f32x4*)(p.x + (size_t)m1 * kD) + lane;
    const f32x4* gr = (const f32x4*)p.norm1_g + lane;
    f32x4 va[8], vb[8]; float sa = 0.f, sb = 0.f;
#pragma unroll
    for (int j = 0; j < 8; ++j) { va[j] = xa[64 * j]; vb[j] = xb[64 * j]; }
#pragma unroll
    for (int j = 0; j < 8; ++j) {
        sa += (va[j].x * va[j].x + va[j].y * va[j].y) + (va[j].z * va[j].z + va[j].w * va[j].w);
        sb += (vb[j].x * vb[j].x + vb[j].y * vb[j].y) + (vb[j].z * vb[j].z + vb[j].w * vb[j].w);
    }
    const float ca = rsqrtf(wave_sum(sa) * (1.0f / kD) + 1e-6f), cb = rsqrtf(wave_sum(sb) * (1.0f / kD) + 1e-6f);
    u32x2* oa = (u32x2*)(p.u_bf() + (size_t)m0 * kD) + lane;
    u32x2* ob = (u32x2*)(p.u_bf() + (size_t)m1 * kD) + lane;
#pragma unroll
    for (int j = 0; j < 8; ++j) {
        const f32x4 g = gr[64 * j];
        u32x2 o; o.x = pk2(va[j].x * ca * g.x, va[j].y * ca * g.y); o.y = pk2(va[j].z * ca * g.z, va[j].w * ca * g.w); oa[64 * j] = o;
        u32x2 q; q.x = pk2(vb[j].x * cb * g.x, vb[j].y * cb * g.y); q.y = pk2(vb[j].z * cb * g.z, vb[j].w * cb * g.w); ob[64 * j] = q;
    }
}
__device__ __forceinline__ void ph_prologue(const Params& p, float* lds) {
    const int tid = tidx(), lane = tid & 63, wave = tid >> 6;
    const int gw = blockIdx.x * 8 + wave, NGW = gridDim.x * 8;
    for (int it = gw; it < XI_IN; it += NGW) xpose_in_item(p, it, lane);
    for (int m = gw; m < kT / 2; m += NGW) norm1_rows2(p, m, m + kT / 2, lane);
}
__device__ __forceinline__ void ph_tables(const Params& p) {
    const int tid = tidx();
    const int nb = gridDim.x == 256 ? 160 : gridDim.x, b0 = gridDim.x == 256 ? (int)blockIdx.x - 96 : (int)blockIdx.x;
    if (b0 < 0) return;
    for (int idx = b0 * kNT + tid; idx < 96 * kD; idx += nb * kNT) {
        const int n = idx >> 11, k = idx & (kD - 1);
        const float v = n < 8 ? p.w_group[(size_t)k * 8 + n] : (n < 72 ? p.w_er[(size_t)k * 64 + (n - 8)] : 0.f);
        const bf16_t hi = f2bf(v);
        const int piece = (((k >> 8) * 16 + ((k >> 4) & 15)) * 6 + 2 * (n >> 5)) * 64 + ((k >> 3) & 1) * 32 + (n & 31);
        p.WrT()[(size_t)piece * 8 + (k & 7)] = hi; p.WrT()[(size_t)(piece + 64) * 8 + (k & 7)] = f2bf(v - bf2f(hi));
    }
    for (int idx = b0 * kNT + tid; idx < 2 * 8 * 128 * 128; idx += nb * kNT) {
        const int which = idx >> 17, n = (idx >> 14) & 7, d = (idx >> 7) & 127, cp = idx & 127, c = (cp & ~15) | swap23(cp & 15);
        p.WgT()[idx] = f2bf((which ? p.lru_wx : p.lru_wa)[(size_t)n * 16384 + c * 128 + d]);
    }
    for (int idx = b0 * kNT + tid; idx < 1024; idx += nb * kNT) p.spl()[idx] = log1pf(expf(-p.lru_lambda[idx]));
}

struct EpiProj {
    static constexpr bool PERM = true, AFTER_DRAIN = false, CHAIN = false;
    Params p;
    template <int ACT>
    __device__ __forceinline__ void store_bf16(const pg8::f32x4 (&acc)[2][2][4][2], bf16_t* base, int ldc, int row0, int col0) const {
#pragma unroll
        for (int ai = 0; ai < 2; ++ai)
#pragma unroll
            for (int m = 0; m < 4; ++m) {
                bf16_t* rowp = base + (size_t)(row0 + ai * 128 + m * 16) * ldc + col0;
#pragma unroll
                for (int bj = 0; bj < 2; ++bj) {
                    pg8::f32x4 v0 = acc[ai][bj][m][0], v1 = acc[ai][bj][m][1];
                    if (ACT == 1) {
#pragma unroll
                        for (int j = 0; j < 4; ++j) { v0[j] = gelu_tanh(v0[j]); v1[j] = gelu_tanh(v1[j]); }
                    }
                    if (ACT == 2) {
#pragma unroll
                        for (int j = 0; j < 4; ++j) { v0[j] = sigmoidf_(v0[j]); v1[j] = sigmoidf_(v1[j]); }
                    }
                    u32x4 w; w.x = pk2(v0[0], v0[1]); w.y = pk2(v0[2], v0[3]); w.z = pk2(v1[0], v1[1]); w.w = pk2(v1[2], v1[3]);
                    *(u32x4*)(rowp + bj * 128) = w;
                }
            }
    }
    __device__ __forceinline__ void operator()(const pg8::f32x4 (&acc)[2][2][4][2], const pg8::Unit& u, int wr, int wc, int fr, int fq) const {
        const int row0 = u.pm * 256 + wr * 64 + fr, cc0 = wc * 32 + 8 * fq;
        const int pn = u.pn;
        if (pn < 4) store_bf16<0>(acc, p.q_bf(), 1024, row0, pn * 256 + cc0);
        else if (pn == 4) store_bf16<0>(acc, p.k_bf(), 256, row0, cc0);
        else if (pn == 5) {
#pragma unroll
            for (int ai = 0; ai < 2; ++ai)
#pragma unroll
                for (int m = 0; m < 4; ++m) {
                    const int row = row0 + ai * 128 + m * 16, b = row >> 12, s = row & (kS - 1);
#pragma unroll
                    for (int bj = 0; bj < 2; ++bj)
#pragma unroll
                        for (int n = 0; n < 2; ++n)
#pragma unroll
                            for (int j = 0; j < 4; ++j) {
                                const int c = cc0 + bj * 128 + n * 4 + j;
                                p.vT()[vt_index(b, c >> 7, c & 127, s)] = f2bf(acc[ai][bj][m][n][j]);
                            }
                }
        }
        else if (pn < 10) store_bf16<0>(acc, p.qi_bf(), 1024, row0, (pn - 6) * 256 + cc0);
        else if (pn == 10) {
#pragma unroll
            for (int ai = 0; ai < 2; ++ai)
#pragma unroll
                for (int m = 0; m < 4; ++m) {
                    const int row = row0 + ai * 128 + m * 16;
                    const pg8::f32x4 v0 = acc[ai][0][m][0], v1 = acc[ai][0][m][1];
                    if (cc0 < 64) {
                        u32x4 w; w.x = pk2(v0[0], v0[1]); w.y = pk2(v0[2], v0[3]); w.z = pk2(v1[0], v1[1]); w.w = pk2(v1[2], v1[3]);
                        *(u32x4*)(p.ki_bf() + (size_t)row * 64 + cc0) = w;
                    } else if (cc0 < 80) {
                        float* d = p.wi() + (size_t)row * 16 + (cc0 - 64);
                        *(pg8::f32x4*)d = v0; *(pg8::f32x4*)(d + 4) = v1;
                    }
                }
        }
        else if (pn < 15) {
#pragma unroll
            for (int ai = 0; ai < 2; ++ai)
#pragma unroll
                for (int m = 0; m < 4; ++m) {
                    float* rowp = p.xr() + (size_t)(row0 + ai * 128 + m * 16) * 1024 + (pn - 11) * 256 + cc0;
#pragma unroll
                    for (int bj = 0; bj < 2; ++bj) { *(pg8::f32x4*)(rowp + bj * 128) = acc[ai][bj][m][0]; *(pg8::f32x4*)(rowp + bj * 128 + 4) = acc[ai][bj][m][1]; }
                }
        }
        else if (pn < 19) store_bf16<1>(acc, p.gg_bf(), 1024, row0, (pn - 15) * 256 + cc0);
        else store_bf16<2>(acc, pn < 27 ? p.sga_bf() : p.sgr_bf(), kD, row0, ((pn - 19) & 7) * 256 + cc0);
    }
};

__device__ __forceinline__ void unpack8(const u32x4 w, float (&f)[8]) {
    f[0] = __uint_as_float(w.x << 16); f[1] = __uint_as_float(w.x & 0xFFFF0000u);
    f[2] = __uint_as_float(w.y << 16); f[3] = __uint_as_float(w.y & 0xFFFF0000u);
    f[4] = __uint_as_float(w.z << 16); f[5] = __uint_as_float(w.z & 0xFFFF0000u);
    f[6] = __uint_as_float(w.w << 16); f[7] = __uint_as_float(w.w & 0xFFFF0000u);
}

struct EpiMerge {
    static constexpr bool PERM = true, AFTER_DRAIN = false, CHAIN = true;
    Params p;
    __device__ __forceinline__ bool chain(pg8::f32x4 (&acc)[2][2][4][2], const pg8::Unit& u, int wr, int wc, int fr, int fq) const {
        const bool second = u.pn >= 8;
        const int row0 = (u.pm & 31) * 256 + wr * 64 + fr, col0 = (u.pn & 7) * 256 + wc * 32 + 8 * fq;
#pragma unroll
        for (int ai = 0; ai < 2; ++ai)
#pragma unroll
            for (int m = 0; m < 4; ++m) {
                const size_t ro = (size_t)(row0 + ai * 128 + m * 16) * kD + col0;
#pragma unroll
                for (int bj = 0; bj < 2; ++bj) {
                    float gr[8]; unpack8(*(const u32x4*)(p.sgr_bf() + ro + bj * 128), gr);
                    if (!second) {
                        float ga[8]; unpack8(*(const u32x4*)(p.sga_bf() + ro + bj * 128), ga);
#pragma unroll
                        for (int j = 0; j < 4; ++j) { acc[ai][bj][m][0][j] *= ga[j] * __builtin_amdgcn_rcpf(gr[j]); acc[ai][bj][m][1][j] *= ga[4 + j] * __builtin_amdgcn_rcpf(gr[4 + j]); }
                    } else {
                        pg8::f32x4 v0 = acc[ai][bj][m][0], v1 = acc[ai][bj][m][1];
#pragma unroll
                        for (int j = 0; j < 4; ++j) { v0[j] *= gr[j]; v1[j] *= gr[4 + j]; }
                        u32x4 w; w.x = pk2(v0[0], v0[1]); w.y = pk2(v0[2], v0[3]); w.z = pk2(v1[0], v1[1]); w.w = pk2(v1[2], v1[3]);
                        *(u32x4*)(p.merged_bf() + ro + bj * 128) = w;
                    }
                }
            }
        return !second;
    }
};
struct MergeOrder {
    pg8::StaticOrder base;
    __device__ bool next(int i, pg8::Unit& u) const {
        if (!base.next(i >> 1, u)) return false;
        if (i & 1) { u.pm += 32; u.pn += 8; }
        return true;
    }
    __device__ __forceinline__ void a_ready(const pg8::Unit&) const {}
    __device__ __forceinline__ void done(const pg8::Unit&) const {}
};
struct EpiWout {
    static constexpr bool PERM = true, AFTER_DRAIN = false, CHAIN = false;
    Params p;
    __device__ __forceinline__ void operator()(const pg8::f32x4 (&acc)[2][2][4][2], const pg8::Unit& u, int wr, int wc, int fr, int fq) const {
        const int row0 = u.pm * 256 + wr * 64 + fr, col0 = u.pn * 256 + wc * 32 + 8 * fq;
#pragma unroll
        for (int ai = 0; ai < 2; ++ai)
#pragma unroll
            for (int m = 0; m < 4; ++m) {
                const size_t ro = (size_t)(row0 + ai * 128 + m * 16) * kD + col0;
#pragma unroll
                for (int bj = 0; bj < 2; ++bj) {
                    const float* xs = p.x + ro + bj * 128; float* xd = p.x2() + ro + bj * 128;
                    *(pg8::f32x4*)xd = *(const pg8::f32x4*)xs + acc[ai][bj][m][0];
                    *(pg8::f32x4*)(xd + 4) = *(const pg8::f32x4*)(xs + 4) + acc[ai][bj][m][1];
                }
            }
    }
};

enum { PH_INDEX = 0, PH_ATTN, PH_RNNA, PH_SCAN, PH_CARRY, PH_FIX, PH_ROUTE, PH_LISTS, PH_FINAL, PH_COUNT };

__device__ __forceinline__ int phase_units(int ph) {
    switch (ph) {
        case PH_INDEX: return kT;
        case PH_ATTN: return kT;
        case PH_RNNA: return kT;
        case PH_SCAN: return 2 * kNChunk * 2;
        case PH_CARRY: return 4;
        case PH_FIX: return kT;
        case PH_ROUTE: return kT;
        case PH_LISTS: return kNE;
        case PH_FINAL: return kT;
    }
    return 0;
}

__device__ __forceinline__ unsigned fkey(float f) { unsigned b = __float_as_uint(f); return (b & 0x80000000u) ? ~b : (b | 0x80000000u); }


typedef short bf16x8_t __attribute__((ext_vector_type(8)));
typedef float f32x16_t __attribute__((ext_vector_type(16)));

constexpr int kIdxChunk = 256;

__device__ __forceinline__ void idx_stage_chunk(const Params& p, int b, int ci, unsigned char* buf, int wave, int lane) {
#pragma unroll
    for (int i = 0; i < 4; ++i) {
        const int q = wave * 4 + i;
        const int key = 8 * q + (lane >> 3), cpos = lane & 7;
        const bf16_t* src = p.ki_bf() + (size_t)(b * kS + ci * kIdxChunk + key) * 64 + ((cpos ^ ((key >> 1) & 7)) * 8);
        __builtin_amdgcn_global_load_lds((const unsigned*)src, (LAS unsigned*)(buf + q * 1024), 16, 0, 0);
    }
}

__device__ __forceinline__ void index_item(const Params& p, int b, int tb, unsigned char* smem, int mode = 3) {
    const int tid_l = tidx();
    const int tid = tid_l, lane = tid & 63, wave = __builtin_amdgcn_readfirstlane(tid >> 6);
    const int tg = wave & 3, kp = wave >> 2, hi = lane >> 5, l31 = lane & 31;
    const int pos0 = tb * 16;
    const int wpos0 = pos0 + 4 * tg;
    const size_t trow0 = (size_t)b * kS + wpos0;
    bf16x8_t af[2][4]; float wv[2][16];
    {
        const int rho = l31, atok = (rho >> 2) & 1, ahead = (rho & 3) + 4 * (rho >> 3);
#pragma unroll
        for (int mt = 0; mt < 2; ++mt) {
            const bf16_t* qrow = p.qi_bf() + (trow0 + 2 * mt + atok) * 1024 + ahead * 64 + 8 * hi;
#pragma unroll
            for (int kk = 0; kk < 4; ++kk) af[mt][kk] = *(const bf16x8_t*)(qrow + 16 * kk);
            const float* wrow = p.wi() + (trow0 + 2 * mt + hi) * 16;
#pragma unroll
            for (int r = 0; r < 16; r += 4) { const f32x4 w4 = *(const f32x4*)(wrow + r); wv[mt][r] = w4.x * 0.03125f; wv[mt][r + 1] = w4.y * 0.03125f; wv[mt][r + 2] = w4.z * 0.03125f; wv[mt][r + 3] = w4.w * 0.03125f; }
        }
    }
    const int nchunk = (mode & 1) ? (pos0 + 15) / kIdxChunk + 1 : 0;
    __syncthreads();
    if (mode & 1) idx_stage_chunk(p, b, 0, smem, wave, lane);
    asm volatile("s_waitcnt vmcnt(0)" ::: "memory");
    __syncthreads();
    const int rdoff = l31 * 128, rdswz = (l31 >> 1) & 7;
    for (int ci = 0; ci < nchunk; ++ci) {
        if (ci + 1 < nchunk) idx_stage_chunk(p, b, ci + 1, smem + ((ci + 1) & 1) * 32768, wave, lane);
        const unsigned char* buf = smem + (ci & 1) * 32768;
#pragma unroll 1
        for (int kt = kp; kt < 8; kt += 2) {
            const int key0 = ci * kIdxChunk + kt * 32;
            if (key0 > wpos0 + 3) break;
            bf16x8_t bfr[4];
#pragma unroll
            for (int kk = 0; kk < 4; ++kk) bfr[kk] = *(const bf16x8_t*)(buf + kt * 4096 + rdoff + (((2 * kk + hi) ^ rdswz) * 16));
#pragma unroll
            for (int mt = 0; mt < 2; ++mt) {
                f32x16_t acc;
#pragma unroll
                for (int r = 0; r < 16; ++r) acc[r] = 0.f;
#pragma unroll
                for (int kk = 0; kk < 4; ++kk) acc = __builtin_amdgcn_mfma_f32_32x32x16_bf16(af[mt][kk], bfr[kk], acc, 0, 0, 0);
                float sc = 0.f;
#pragma unroll
                for (int r = 0; r < 16; ++r) sc = fmaf(fmaxf(acc[r], 0.f), wv[mt][r], sc);
                p.sc()[(trow0 + 2 * mt + hi) * kS + key0 + l31] = sc;
            }
        }
        asm volatile("s_waitcnt vmcnt(0)" ::: "memory");
        __syncthreads();
    }
#pragma unroll 1
    for (int tt = 0; tt < ((mode & 2) ? 2 : 0); ++tt) {
        const int pos = pos0 + 2 * wave + tt;
        const size_t trow = (size_t)b * kS + pos;
        const float* srow = p.sc() + trow * kS;
        unsigned key[64];
#pragma unroll
        for (int g = 0; g < 4; ++g) {
            if (g == 0 || 1024 * g <= pos) {
                float v[16];
#pragma unroll
                for (int jj = 0; jj < 16; ++jj) { const int s = 64 * (16 * g + jj) + lane; v[jj] = srow[s <= pos ? s : pos]; }
#pragma unroll
                for (int jj = 0; jj < 16; ++jj) {
                    const int s = 64 * (16 * g + jj) + lane;
                    const unsigned bb = __float_as_uint(v[jj]);
                    key[16 * g + jj] = (s <= pos) ? ((bb & 0x80000000u) ? ~bb : (bb | 0x80000000u)) : 0u;
                }
            } else {
#pragma unroll
                for (int jj = 0; jj < 16; ++jj) key[16 * g + jj] = 0u;
            }
        }
        unsigned long long mine = 0ull;
        if (pos + 1 <= kTopK) {
#pragma unroll
            for (int j = 0; j < 4; ++j) { const unsigned long long wj = __ballot(64 * j + lane <= pos); if (lane == j) mine = wj; }
        } else {
            unsigned Kth = 0u; bool exact = false;
#pragma unroll 1
            for (int bit = 31; bit >= 0; --bit) {
                const unsigned cand = Kth | (1u << bit);
                int cl = 0;
#pragma unroll
                for (int g = 0; g < 4; ++g) {
                    if (g == 0 || 1024 * g <= pos) {
#pragma unroll
                        for (int j = 16 * g; j < 16 * g + 16; ++j) cl += __popcll(__ballot(key[j] >= cand));
                    }
                }
                const int cnt = cl;
                if (cnt >= kTopK) { Kth = cand; if (cnt == kTopK) { exact = true; break; } }
            }
            if (exact) {
#pragma unroll
                for (int j = 0; j < 64; ++j) { const unsigned long long wj = __ballot(key[j] >= Kth); if (lane == j) mine = wj; }
            } else {
                int cgt = 0;
#pragma unroll
                for (int j = 0; j < 64; ++j) cgt += __popcll(__ballot(key[j] > Kth));
                const int need = kTopK - cgt;
                int running = 0;
                const unsigned long long lt = (1ull << lane) - 1ull;
#pragma unroll
                for (int j = 0; j < 64; ++j) {
                    const unsigned long long eq = __ballot(key[j] == Kth);
                    const int rank = running + __popcll(eq & lt);
                    const bool sel = key[j] > Kth || (key[j] == Kth && rank < need);
                    const unsigned long long wj = __ballot(sel);
                    if (lane == j) mine = wj;
                    running += __popcll(eq);
                }
            }
        }
        *(unsigned long long*)(p.mask() + trow * 512 + lane * 8) = mine;
    }
}

__device__ __forceinline__ void ph_index_mfma(const Params& p, unsigned char* smem, int mode = 3) {
    for (int i = blockIdx.x; i < 256; i += gridDim.x) {
        const int b = i & 1;
#pragma unroll 1
        for (int k = 0; k < 2; ++k) index_item(p, b, k ? (i >> 1) : 255 - (i >> 1), smem, mode);
    }
    __syncthreads();
}

__device__ __forceinline__ int rel_bucket(int n) {
    if (n < 16) return n;
    const float v = logf((float)n / 16.0f) / 2.0794415416798357f * 16.0f;
    int l = 16 + (int)v;
    return l < 31 ? l : 31;
}

__device__ __forceinline__ void att_stage_pair(const Params& p, int b, int g, int i, unsigned char* buf, int wave, int lane) {
    const int kind = wave >> 2, par = (wave >> 1) & 1, j = 2 * i + par;
#pragma unroll
    for (int ii = 0; ii < 8; ++ii) {
        const int pc = (wave & 1) * 8 + ii;
        const bf16_t* src;
        if (kind == 0) { const int key = 4 * pc + (lane >> 4), cpos = lane & 15; src = p.k_bf() + (size_t)(b * kS + 64 * j + key) * 256 + g * 128 + ((cpos ^ (key & 15)) * 8); }
        else           { const int d = 8 * pc + (lane >> 3), cpos = lane & 7; src = p.vT() + (size_t)((b * 2 + g) * 128 + d) * kS + 64 * j + ((cpos ^ ((d >> 1) & 7)) * 8); }
        __builtin_amdgcn_global_load_lds((const unsigned*)src, (LAS unsigned*)(buf + kind * 32768 + par * 16384 + pc * 1024), 16, 0, 0);
    }
}
__device__ __forceinline__ float half_max(float x) { auto rr = __builtin_amdgcn_permlane32_swap(__float_as_uint(x), __float_as_uint(x), false, false); return fmaxf(__uint_as_float(rr[0]), __uint_as_float(rr[1])); }
__device__ __forceinline__ float half_sum(float x) { auto rr = __builtin_amdgcn_permlane32_swap(__float_as_uint(x), __float_as_uint(x), false, false); return __uint_as_float(rr[0]) + __uint_as_float(rr[1]); }

__device__ __forceinline__ void attn_item(const Params& p, int b, int h, int qb, unsigned char* smem) {
    const int tid_l = tidx();
    const int tid = tid_l, lane = tid & 63, wave = __builtin_amdgcn_readfirstlane(tid >> 6);
    const int rw = wave & 3, kp = wave >> 2, hi = lane >> 5, l31 = lane & 31;
    const int g = h >> 2, r0 = 128 * qb + 32 * rw, row = r0 + l31;
    const size_t trow = (size_t)b * kS + row;
    float* tbl = (float*)(smem + kStageBytes + 64);
    constexpr float LOG2E = 1.4426950408889634f, C2 = 1.4426950408889634f * 0.08838834764831845f;
    __syncthreads();
    const float tb0 = p.rel_bias[rel_bucket(tid & 127) * 8 + h], tb1 = p.rel_bias[31 * 8 + h];
    bf16x8_t qf[8];
    {
        const bf16_t* qrow = p.q_bf() + trow * 1024 + h * 128 + 8 * hi;
#pragma unroll
        for (int kk = 0; kk < 8; ++kk) qf[kk] = *(const bf16x8_t*)(qrow + 16 * kk);
    }
    f32x16_t o[4];
#pragma unroll
    for (int a = 0; a < 4; ++a)
#pragma unroll
        for (int r = 0; r < 16; ++r) o[a][r] = 0.f;
    float m = -1e30f, l = 0.f;
    att_stage_pair(p, b, g, 0, smem, wave, lane);
    const unsigned long long* mrow = (const unsigned long long*)(p.mask() + trow * 512);
    unsigned long long mw_next;
    asm volatile("global_load_dwordx2 %0, %1, off" : "=v"(mw_next) : "v"(mrow + kp) : "memory");
    if (tid < 256) tbl[tid] = tid < 128 ? (tb0 - tb1) * LOG2E : 0.f;
    asm volatile("s_waitcnt vmcnt(0)" : "+v"(mw_next) :: "memory");
    __syncthreads();
    const int kswz = l31 & 15;
    for (int i = 0; i <= qb; ++i) {
        if (i < qb) att_stage_pair(p, b, g, i + 1, smem + ((i + 1) & 1) * 65536, wave, lane);
        const int j = 2 * i + kp;
        const unsigned long long mw = mw_next;
        asm volatile("global_load_dwordx2 %0, %1, off" : "=v"(mw_next) : "v"(mrow + ((j + 2) < 64 ? (j + 2) : 63)) : "memory");
        if (64 * j <= r0 + 31) {
            const unsigned char* kb = smem + (i & 1) * 65536 + kp * 16384;
            const unsigned char* vb = kb + 32768;
            int kofs = l31 * 256, ksw = kswz * 16 ^ hi * 16; asm volatile("" : "+v"(kofs), "+v"(ksw));
            f32x16_t s0, s1;
#pragma unroll
            for (int r = 0; r < 16; ++r) { s0[r] = 0.f; s1[r] = 0.f; }
            {
                bf16x8_t ka[2][2];
                { const int co = kofs + ksw; ka[0][0] = *(const bf16x8_t*)(kb + co); ka[0][1] = *(const bf16x8_t*)(kb + 8192 + co); }
#pragma unroll
                for (int kk = 0; kk < 8; ++kk) {
                    if (kk < 7) { const int co = kofs + ((32 * (kk + 1)) ^ ksw); ka[(kk + 1) & 1][0] = *(const bf16x8_t*)(kb + co); ka[(kk + 1) & 1][1] = *(const bf16x8_t*)(kb + 8192 + co); }
                    s0 = __builtin_amdgcn_mfma_f32_32x32x16_bf16(ka[kk & 1][0], qf[kk], s0, 0, 0, 0);
                    s1 = __builtin_amdgcn_mfma_f32_32x32x16_bf16(ka[kk & 1][1], qf[kk], s1, 0, 0, 0);
                }
            }
            const bool needb = (64 * j + 191 > r0);
            const unsigned mlo = (unsigned)(mw) >> (4 * hi), mhi = (unsigned)(mw >> 32) >> (4 * hi);
            const unsigned NEGB = 0xFF800000u;
#define ATT_MASK(x, w, c) __uint_as_float((__float_as_uint(x) & (unsigned)__builtin_amdgcn_sbfe((int)(w), (c), 1)) | (NEGB & ~(unsigned)__builtin_amdgcn_sbfe((int)(w), (c), 1)))
            float mn, ps = 0.f, alpha;
            if (needb) {
                const int dq = row - 64 * j - 4 * hi;
#pragma unroll
                for (int r = 0; r < 16; ++r) {
                    const int c = (r & 3) + 8 * (r >> 2);
                    int d0 = dq - c, d1 = dq - c - 32;
                    d0 = d0 < 0 ? 0 : (d0 > 255 ? 255 : d0); d1 = d1 < 0 ? 0 : (d1 > 255 ? 255 : d1);
                    const float x0 = fmaf(s0[r], C2, tbl[d0]), x1 = fmaf(s1[r], C2, tbl[d1]);
                    s0[r] = ATT_MASK(x0, mlo, c); s1[r] = ATT_MASK(x1, mhi, c);
                }
                float mx = s0[0];
#pragma unroll
                for (int r = 1; r < 16; ++r) mx = fmaxf(mx, s0[r]);
#pragma unroll
                for (int r = 0; r < 16; ++r) mx = fmaxf(mx, s1[r]);
                mx = half_max(mx);
                mn = fmaxf(m, mx);
                alpha = __builtin_amdgcn_exp2f(m - mn);
#pragma unroll
                for (int r = 0; r < 16; ++r) { s0[r] = __builtin_amdgcn_exp2f(s0[r] - mn); s1[r] = __builtin_amdgcn_exp2f(s1[r] - mn); ps += s0[r] + s1[r]; }
            } else {
#pragma unroll
                for (int r = 0; r < 16; ++r) {
                    const int c = (r & 3) + 8 * (r >> 2);
                    s0[r] = ATT_MASK(s0[r], mlo, c); s1[r] = ATT_MASK(s1[r], mhi, c);
                }
                float mx = s0[0];
#pragma unroll
                for (int r = 1; r < 16; ++r) mx = fmaxf(mx, s0[r]);
#pragma unroll
                for (int r = 0; r < 16; ++r) mx = fmaxf(mx, s1[r]);
                mx = half_max(mx);
                mn = fmaxf(m, mx * C2);
                alpha = __builtin_amdgcn_exp2f(m - mn);
                const float nmn = -mn;
#pragma unroll
                for (int r = 0; r < 16; ++r) { s0[r] = __builtin_amdgcn_exp2f(fmaf(s0[r], C2, nmn)); s1[r] = __builtin_amdgcn_exp2f(fmaf(s1[r], C2, nmn)); ps += s0[r] + s1[r]; }
            }
#undef ATT_MASK
            m = mn;
            ps = half_sum(ps);
            l = l * alpha + ps;
            if (__any(alpha != 1.f)) {
#pragma unroll
                for (int a = 0; a < 4; ++a)
#pragma unroll
                    for (int r = 0; r < 16; ++r) o[a][r] *= alpha;
            }
            bf16x8_t pf[4];
#pragma unroll
            for (int s = 0; s < 2; ++s) {
                u32x4 w0, w1;
                w0.x = pk2(s0[8 * s + 0], s0[8 * s + 1]); w0.y = pk2(s0[8 * s + 2], s0[8 * s + 3]); w0.z = pk2(s0[8 * s + 4], s0[8 * s + 5]); w0.w = pk2(s0[8 * s + 6], s0[8 * s + 7]);
                w1.x = pk2(s1[8 * s + 0], s1[8 * s + 1]); w1.y = pk2(s1[8 * s + 2], s1[8 * s + 3]); w1.z = pk2(s1[8 * s + 4], s1[8 * s + 5]); w1.w = pk2(s1[8 * s + 6], s1[8 * s + 7]);
                pf[s] = *reinterpret_cast<bf16x8_t*>(&w0); pf[2 + s] = *reinterpret_cast<bf16x8_t*>(&w1);
            }
            int vofs = l31 * 128, vsw = (((l31 >> 1) & 7) * 16) ^ (hi * 16); asm volatile("" : "+v"(vofs), "+v"(vsw));
            {
                bf16x8_t va[2][4];
#pragma unroll
                for (int ks = 0; ks < 4; ++ks) va[0][ks] = *(const bf16x8_t*)(vb + vofs + ((32 * ks) ^ vsw));
#pragma unroll
                for (int a = 0; a < 4; ++a) {
                    if (a < 3) {
#pragma unroll
                        for (int ks = 0; ks < 4; ++ks) va[(a + 1) & 1][ks] = *(const bf16x8_t*)(vb + (a + 1) * 4096 + vofs + ((32 * ks) ^ vsw));
                    }
#pragma unroll
                    for (int ks = 0; ks < 4; ++ks) o[a] = __builtin_amdgcn_mfma_f32_32x32x16_bf16(va[a & 1][ks], pf[ks], o[a], 0, 0, 0);
                    __builtin_amdgcn_sched_barrier(0);
                }
            }
        }
        asm volatile("s_waitcnt vmcnt(0)" : "+v"(mw_next) :: "memory");
        __syncthreads();
    }
    float* xch = (float*)smem + rw * (66 * 64);
    if (kp == 1) {
#pragma unroll
        for (int a = 0; a < 4; ++a)
#pragma unroll
            for (int r = 0; r < 16; ++r) xch[(a * 16 + r) * 64 + lane] = o[a][r];
        xch[64 * 64 + lane] = m; xch[65 * 64 + lane] = l;
    }
    __syncthreads();
    if (kp == 0) {
        const float m1 = xch[64 * 64 + lane], l1 = xch[65 * 64 + lane];
        const float mn = fmaxf(m, m1), a0 = __builtin_amdgcn_exp2f(m - mn), a1 = __builtin_amdgcn_exp2f(m1 - mn);
        const float inv = 1.0f / (l * a0 + l1 * a1);
        int rowb = r0 + (lane & 31); asm volatile("" : "+v"(rowb));
        bf16_t* orow = p.ab_bf() + ((size_t)b * kS + rowb) * 1024 + h * 128 + 4 * hi;
#pragma unroll
        for (int a = 0; a < 4; ++a)
#pragma unroll
            for (int k4 = 0; k4 < 4; ++k4) {
                float v[4];
#pragma unroll
                for (int e = 0; e < 4; ++e) { const int r = 4 * k4 + e; v[e] = (o[a][r] * a0 + xch[(a * 16 + r) * 64 + lane] * a1) * inv; }
                u32x2 w; w.x = pk2(v[0], v[1]); w.y = pk2(v[2], v[3]);
                *(u32x2*)(orow + 32 * a + 8 * k4) = w;
            }
    }
}
__device__ __forceinline__ void ph_attn_mfma(const Params& p, unsigned char* smem) {
    for (int i = blockIdx.x; i < 256; i += gridDim.x) {
        const int bh = i & 15;
#pragma unroll 1
        for (int k = 0; k < 2; ++k) attn_item(p, bh >> 3, bh & 7, k ? (i >> 4) : 31 - (i >> 4), smem);
    }
    __syncthreads();
}

__device__ __forceinline__ float neg_expm1(float x) {
    if (x > -0.1f) return -x * (1.0f + x * (0.5f + x * (0.16666667f + x * (0.041666668f + x * 0.0083333338f))));
    return 1.0f - __expf(x);
}
template <int mt>
__device__ __forceinline__ void rnn1_mt(const Params& p, const float (&xc)[8][8], const bf16x8_t (&bfr)[8], int n, int token, int b, int chunk, int hi, int l31) {
        f32x16_t accr, acci;
#pragma unroll
        for (int r = 0; r < 16; ++r) { accr[r] = 0.f; acci[r] = 0.f; }
        const bf16_t* wa = p.WgT() + (size_t)((n * 128 + 32 * mt + l31) * 128) + 8 * hi;
        const bf16_t* wx = wa + 8 * 128 * 128;
#pragma unroll
        for (int ks = 0; ks < 8; ++ks) {
            const bf16x8_t fa = *(const bf16x8_t*)(wa + 16 * ks), fx = *(const bf16x8_t*)(wx + 16 * ks);
            accr = __builtin_amdgcn_mfma_f32_32x32x16_bf16(fa, bfr[ks], accr, 0, 0, 0);
            acci = __builtin_amdgcn_mfma_f32_32x32x16_bf16(fx, bfr[ks], acci, 0, 0, 0);
            if ((ks & 3) == 3) __builtin_amdgcn_sched_barrier(0);
        }
        float av[16], bv[16];
#pragma unroll
        for (int k4 = 0; k4 < 4; ++k4) {
            const int c0 = n * 128 + 32 * mt + 8 * k4 + 4 * hi;
            const f32x4 ba = *(const f32x4*)(p.lru_ba + c0), bx = *(const f32x4*)(p.lru_bx + c0), sp = *(const f32x4*)(p.spl() + c0);
#pragma unroll
            for (int e = 0; e < 4; ++e) {
                const int r = 4 * k4 + e;
                const float x = xc[2 * mt + (r >> 3)][(r & 3) + 4 * ((r >> 2) & 1)];
                const float rg = 1.0f / (1.0f + __expf(-(accr[r] + ba[e]))), ig = 1.0f / (1.0f + __expf(-(acci[r] + bx[e])));
                const float la = -8.0f * rg * sp[e];
                av[r] = __expf(la);
                bv[r] = sqrtf(neg_expm1(2.0f * la)) * (ig * x);
            }
        }
#define RNN_DPP_STEP(CTRL, RMASK) do { _Pragma("unroll") for (int r = 0; r < 16; ++r) { \
            const float ap = __uint_as_float((unsigned)__builtin_amdgcn_update_dpp((int)0x3F800000, (int)__float_as_uint(av[r]), CTRL, RMASK, 0xF, false)); \
            const float bp = __uint_as_float((unsigned)__builtin_amdgcn_update_dpp(0, (int)__float_as_uint(bv[r]), CTRL, RMASK, 0xF, false)); \
            bv[r] = fmaf(av[r], bp, bv[r]); av[r] *= ap; } } while (0)
        RNN_DPP_STEP(0x111, 0xF); RNN_DPP_STEP(0x112, 0xF); RNN_DPP_STEP(0x114, 0xF); RNN_DPP_STEP(0x118, 0xF); RNN_DPP_STEP(0x142, 0xA);
#undef RNN_DPP_STEP
#pragma unroll
        for (int k4 = 0; k4 < 4; ++k4) {
            const int c0 = n * 128 + 32 * mt + 8 * k4 + 4 * hi;
            const f32x4 va = (f32x4){av[4 * k4], av[4 * k4 + 1], av[4 * k4 + 2], av[4 * k4 + 3]}, vb = (f32x4){bv[4 * k4], bv[4 * k4 + 1], bv[4 * k4 + 2], bv[4 * k4 + 3]};
            *(f32x4*)(p.bufA() + (size_t)token * 1024 + c0) = va;
            *(f32x4*)(p.bufB() + (size_t)token * 1024 + c0) = vb;
            if (l31 == 31) {
                *(f32x4*)(p.chA() + (size_t)(b * kNChunk + chunk) * 1024 + c0) = va;
                *(f32x4*)(p.chH() + (size_t)(b * kNChunk + chunk) * 1024 + c0) = vb;
            }
        }

}
__device__ __forceinline__ void rnn1_item(const Params& p, int tg, int n) {
    asm volatile("" : "+s"(n));
    const int tid = tidx(), lane = tid & 63, hi = lane >> 5, l31 = lane & 31;
    const int token = tg * 32 + l31, pos = token & (kS - 1);
    float xc[8][8];
#pragma unroll
    for (int ks = 0; ks < 8; ++ks)
#pragma unroll
        for (int hf = 0; hf < 2; ++hf) {
            const int c0 = n * 128 + 16 * ks + 4 * hi + 8 * hf;
            f32x4 a = *(const f32x4*)(p.conv_b + c0);
#pragma unroll
            for (int j = 0; j < 4; ++j) {
                const f32x4 w = *(const f32x4*)(p.conv_w + j * 1024 + c0);
                const bool inside = pos - 3 + j >= 0;
                f32x4 x = *(const f32x4*)(p.xr() + (size_t)(inside ? token - 3 + j : token) * 1024 + c0);
                const float keep = inside ? 1.0f : 0.0f;
                a = a + (x * keep) * w;
            }
            xc[ks][4 * hf + 0] = a.x; xc[ks][4 * hf + 1] = a.y; xc[ks][4 * hf + 2] = a.z; xc[ks][4 * hf + 3] = a.w;
            if (hf == 1 && (ks & 1)) __builtin_amdgcn_sched_barrier(0);
        }
    bf16x8_t bfr[8];
#pragma unroll
    for (int ks = 0; ks < 8; ++ks) {
        u32x4 w; w.x = pk2(xc[ks][0], xc[ks][1]); w.y = pk2(xc[ks][2], xc[ks][3]); w.z = pk2(xc[ks][4], xc[ks][5]); w.w = pk2(xc[ks][6], xc[ks][7]);
        bfr[ks] = *reinterpret_cast<bf16x8_t*>(&w);
    }
    const int b = token >> 12, chunk = pos >> 5;
    __builtin_amdgcn_sched_barrier(0);
    rnn1_mt<0>(p, xc, bfr, n, token, b, chunk, hi, l31);
    __builtin_amdgcn_sched_barrier(0);
    rnn1_mt<1>(p, xc, bfr, n, token, b, chunk, hi, l31);
    __builtin_amdgcn_sched_barrier(0);
    rnn1_mt<2>(p, xc, bfr, n, token, b, chunk, hi, l31);
    __builtin_amdgcn_sched_barrier(0);
    rnn1_mt<3>(p, xc, bfr, n, token, b, chunk, hi, l31);
}
__device__ __forceinline__ void ph_rnn1(const Params& p) {
    const int wave = __builtin_amdgcn_readfirstlane(tidx() >> 6);
    for (int tg = blockIdx.x; tg < kT / 32; tg += gridDim.x) rnn1_item(p, tg, wave);
}
__device__ __forceinline__ void ph_rnn2(const Params& p, float* lds) {
    const int tid = tidx();
    float* A = lds; float* H = lds + kNChunk * 64;
    for (int u = blockIdx.x; u < 32; u += gridDim.x) {
        const int b = u >> 4, c0 = (u & 15) * 64;
        __syncthreads();
        for (int idx = tid; idx < kNChunk * 64; idx += kNT) {
            const size_t gi = (size_t)(b * kNChunk + (idx >> 6)) * 1024 + c0 + (idx & 63);
            A[idx] = p.chA()[gi]; H[idx] = p.chH()[gi];
        }
        __syncthreads();
        if (tid < 64) {
            float Hc = 0.f;
            for (int ch = 0; ch < kNChunk; ++ch) {
                p.carry()[(size_t)(b * kNChunk + ch) * 1024 + c0 + tid] = Hc;
                Hc = fmaf(A[ch * 64 + tid], Hc, H[ch * 64 + tid]);
            }
        }
    }
    __syncthreads();
}
__device__ __forceinline__ void ph_rnn3(const Params& p) {
    const int tid = tidx(), c4 = (tid & 255) * 4, tsub = tid >> 8;
    for (int cu = blockIdx.x; cu < kT / 32; cu += gridDim.x) {
        const f32x4 cin = *(const f32x4*)(p.carry() + (size_t)cu * 1024 + c4);
#pragma unroll 4
        for (int s = 0; s < 16; ++s) {
            const size_t i = (size_t)(cu * 32 + 2 * s + tsub) * 1024 + c4;
            const f32x4 ca = *(const f32x4*)(p.bufA() + i), hl = *(const f32x4*)(p.bufB() + i);
            const u32x2 gg = *(const u32x2*)(p.gg_bf() + i);
            const f32x4 h = hl + ca * cin;
            u32x2 o;
            o.x = pk2(h.x * __uint_as_float(gg.x << 16), h.y * __uint_as_float(gg.x & 0xFFFF0000u));
            o.y = pk2(h.z * __uint_as_float(gg.y << 16), h.w * __uint_as_float(gg.y & 0xFFFF0000u));
            *(u32x2*)(p.ab_bf() + (size_t)kT * 1024 + i) = o;
        }
    }
}

__device__ __forceinline__ void route_item(const Params& p, int item, unsigned char* smem, bool commit = true) {
    const int tid = tidx(), lane = tid & 63, wave = __builtin_amdgcn_readfirstlane(tid >> 6), hi = lane >> 5, l31 = lane & 31;
    const int t0 = item * 32;
    float* part = (float*)smem;
    float* ssp = (float*)(smem + 131072);
    float* lg = ssp + 32;
    float* rs = lg + 32 * 96;
    float* gl = rs + 32;
    float* bias = gl + 2048;
    const f32x4 gpre = *(const f32x4*)(p.norm2_g + 4 * tid);
    const float bpre = tid < 8 ? p.b_group[tid] : (tid < 72 ? p.b_er[tid - 8] : 0.f);
    f32x16_t acc[3];
#pragma unroll
    for (int a = 0; a < 3; ++a)
#pragma unroll
        for (int r = 0; r < 16; ++r) acc[a][r] = 0.f;
    float ss[4] = {0.f, 0.f, 0.f, 0.f};
    const float* xbase = p.x2() + (size_t)(t0 + 4 * wave) * kD + 4 * lane;
    bf16_t* obase = p.u2_bf() + (size_t)(t0 + 4 * wave) * kD + 4 * lane;
    const bf16_t* wfr = p.WrT() + (size_t)lane * 8;
    const int wks = lane >> 2, whi = (lane >> 1) & 1;
    f32x4 xv[4][4];
#pragma unroll
    for (int j = 0; j < 4; ++j)
#pragma unroll
        for (int i = 0; i < 4; ++i) xv[j][i] = *(const f32x4*)(xbase + (size_t)j * kD + 256 * i);
    __syncthreads();
    *(f32x4*)(gl + 4 * tid) = gpre;
    if (tid < 72) bias[tid] = bpre;
    __syncthreads();
#pragma unroll
    for (int kc = 0; kc < 2; ++kc) {
        f32x4 g4[4];
#pragma unroll
        for (int i = 0; i < 4; ++i) g4[i] = *(const f32x4*)(gl + 1024 * kc + 256 * i + 4 * lane);
        int wbase = wks * 2048 + whi * 512 + (lane & 1) * 8, wrot = 4 * wave + 2 * wks + whi;
        asm volatile("" : "+v"(wbase), "+v"(wrot));
#pragma unroll
        for (int j = 0; j < 4; ++j) {
#pragma unroll
            for (int i = 0; i < 4; ++i) {
                const f32x4 x = xv[j][i];
                ss[j] += (x.x * x.x + x.y * x.y) + (x.z * x.z + x.w * x.w);
                const f32x4 a = x * g4[i];
                u32x2 h; h.x = pk2(a.x, a.y); h.y = pk2(a.z, a.w);
                *(u32x2*)(obase + (size_t)j * kD + 1024 * kc + 256 * i) = h;
                u32x2 lo;
                lo.x = pk2(a.x - __uint_as_float(h.x << 16), a.y - __uint_as_float(h.x & 0xFFFF0000u));
                lo.y = pk2(a.z - __uint_as_float(h.y << 16), a.w - __uint_as_float(h.y & 0xFFFF0000u));
                unsigned char* d = smem + i * 32768 + wbase + ((wrot + j) & 31) * 16;
                *(u32x2*)d = h; *(u32x2*)(d + 1024) = lo;
            }
        }
        if (kc == 0) {
#pragma unroll
            for (int j = 0; j < 4; ++j)
#pragma unroll
                for (int i = 0; i < 4; ++i) xv[j][i] = *(const f32x4*)(xbase + (size_t)j * kD + 1024 + 256 * i);
        }
        if (kc == 1) {
#pragma unroll
            for (int j = 0; j < 4; ++j) { const float s = wave_sum_dpp(ss[j]); if (lane == 0) ssp[4 * wave + j] = s; }
        }
        __syncthreads();
        bf16x8_t wq[2][6];
#pragma unroll
        for (int f = 0; f < 6; ++f) wq[0][f] = *(const bf16x8_t*)(wfr + (size_t)(((64 * kc + 8 * wave) * 6 + f) * 64) * 8);
#pragma unroll
        for (int i = 0; i < 8; ++i) {
            const int ks = 8 * wave + i;
            if (i + 1 < 8) {
#pragma unroll
                for (int f = 0; f < 6; ++f) wq[(i + 1) & 1][f] = *(const bf16x8_t*)(wfr + (size_t)(((64 * kc + ks + 1) * 6 + f) * 64) * 8);
            }
            const unsigned char* s = smem + ((ks * 2) * 2 + hi) * 512 + ((l31 + 2 * ks + hi) & 31) * 16;
            const bf16x8_t ah = *(const bf16x8_t*)s, alo = *(const bf16x8_t*)(s + 1024);
            __builtin_amdgcn_sched_barrier(0);
#pragma unroll
            for (int nt = 0; nt < 3; ++nt) {
                const bf16x8_t bh = wq[i & 1][2 * nt], bl = wq[i & 1][2 * nt + 1];
                acc[nt] = __builtin_amdgcn_mfma_f32_32x32x16_bf16(ah, bh, acc[nt], 0, 0, 0);
                acc[nt] = __builtin_amdgcn_mfma_f32_32x32x16_bf16(ah, bl, acc[nt], 0, 0, 0);
                acc[nt] = __builtin_amdgcn_mfma_f32_32x32x16_bf16(alo, bh, acc[nt], 0, 0, 0);
            }
            __builtin_amdgcn_sched_barrier(0);
        }
        __syncthreads();
    }
#pragma unroll
    for (int nt = 0; nt < 3; ++nt)
#pragma unroll
        for (int r = 0; r < 16; ++r) part[wave * 3072 + (nt * 16 + r) * 64 + lane] = acc[nt][r];
    __syncthreads();
    for (int o = tid; o < 3072; o += kNT) {
        float s = 0.f;
#pragma unroll
        for (int w = 0; w < 8; ++w) s += part[w * 3072 + o];
        const int nt = o >> 10, r = (o >> 6) & 15, ln = o & 63;
        const int trow = (r & 3) + 8 * (r >> 2) + 4 * (ln >> 5), col = 32 * nt + (ln & 31);
        lg[trow * 96 + col] = s;
    }
    if (tid < 32) {
        const float s = ssp[tid];
        const float r = rsqrtf(s * (1.0f / kD) + 1e-6f);
        rs[tid] = r; p.rstd()[t0 + tid] = r;
    }
    __syncthreads();
    if (tid < 32 && commit) {
        const int t = t0 + tid;
        const float r = rs[tid];
        const float* lgt = lg + tid * 96;
        float glg[8];
#pragma unroll
        for (int i = 0; i < 8; ++i) glg[i] = lgt[i] * r + bias[i];
        int g = 0; float m = glg[0];
#pragma unroll
        for (int i = 1; i < 8; ++i) if (glg[i] > m) { m = glg[i]; g = i; }
        float den = 0.f;
#pragma unroll
        for (int i = 0; i < 8; ++i) den += expf(glg[i] - m);
        const float psel = 1.0f / den;
        float el[8];
#pragma unroll
        for (int i = 0; i < 8; ++i) el[i] = lgt[8 + g * 8 + i] * r + bias[8 + g * 8 + i];
        int e0 = 0; float v0 = el[0];
#pragma unroll
        for (int i = 1; i < 8; ++i) if (el[i] > v0) { v0 = el[i]; e0 = i; }
        int e1 = -1; float v1 = -INFINITY;
#pragma unroll
        for (int i = 0; i < 8; ++i) if (i != e0 && el[i] > v1) { v1 = el[i]; e1 = i; }
        const float ex = expf(v1 - v0);
        const float w0 = 1.0f / (1.0f + ex), w1 = ex / (1.0f + ex);
        const int ea = g * 8 + e0, eb = g * 8 + e1;
        const int ra = atomicAdd(p.ecnt() + 128 + 32 * ea, 1), rb = atomicAdd(p.ecnt() + 128 + 32 * eb, 1);
        p.eid()[t * 2 + 0] = ea; p.eid()[t * 2 + 1] = eb;
        p.srank()[t * 2 + 0] = ra; p.srank()[t * 2 + 1] = rb;
        p.tokr()[ea * 16384 + ra] = t; p.tokr()[eb * 16384 + rb] = t;
        p.wrk()[ea * 16384 + ra] = psel * w0; p.wrk()[eb * 16384 + rb] = psel * w1;
    }
}
__device__ __forceinline__ void ph_route_mfma(const Params& p, unsigned char* smem, bool commit = true) {
    for (int i = blockIdx.x; i < kT / 32; i += gridDim.x) route_item(p, i, smem, commit);
    __syncthreads();
}

__device__ __forceinline__ void build_expert_tab(const Params& p, int* tab) {
    const int tid = tidx();
    __syncthreads();
    if (tid < 64) {
        const int c = p.ecnt()[128 + 32 * tid], tiles = (c + moe::MT - 1) / moe::MT;
        int inc = tiles, cin = c;
#pragma unroll
        for (int o = 1; o < 64; o <<= 1) { const int n = __shfl_up(inc, o), n2 = __shfl_up(cin, o); if (tid >= o) { inc += n; cin += n2; } }
        tab[tid] = inc - tiles; tab[65 + tid] = c; tab[129 + tid] = cin - c;
        if (tid == 63) { tab[64] = inc; tab[193] = cin; }
    }
    __syncthreads();
}

__device__ __forceinline__ int find_expert(const int* __restrict__ mtp, int mg) {
    int l; asm volatile("v_mbcnt_lo_u32_b32 %0, -1, 0\n\tv_mbcnt_hi_u32_b32 %0, -1, %0" : "=v"(l));
    const int v = mtp[l < 63 ? l + 1 : 63];
    return __popcll(__ballot(l < 63 && v <= mg));
}
struct MoeCfg1 {
    static constexpr int K = kD, LDB = kFF;
    Params p; const int* tab; int G, c;
    __device__ __forceinline__ bool next(int i, moe::Unit& u) const {
        const int cc = (G == 256) ? (((c & 7) * 4 + (c >> 6)) * 8 + ((c >> 3) & 7)) : c;
        const int L = i * G + cc, total = tab[kNE] * 8;
        if (L >= total) return false;
        u.pm = L >> 3; u.pn = L & 7; u.ex = find_expert(tab, u.pm);
        return true;
    }
    __device__ __forceinline__ void a_voffs(const moe::Unit& u, int wid, int lane, unsigned (&v)[10]) const {
        const int rb = (u.pm - tab[u.ex]) * moe::MT, cnt = tab[65 + u.ex];
        const int* lst = p.tokr() + u.ex * 16384;
#pragma unroll
        for (int i = 0; i < 10; ++i) {
            int R, Cc; pg8::stage_rc((wid + 4 * i) * 1024 + lane * 16, R, Cc);
            const int r = rb + R;
            const int t = lst[r < cnt ? r : cnt - 1];
            v[i] = (unsigned)(t * kD + Cc) * 2u;
        }
    }
    __device__ __forceinline__ const void* abase() const { return p.u2_bf(); }
    __device__ __forceinline__ const float* bsrc(const moe::Unit& u, int nq) const {
        const int col = 64 * u.pn + 32 * (nq >> 4) + 16 * ((nq >> 3) & 1) + 4 * (nq & 3);
        return (((nq >> 2) & 1) ? p.w_up : p.w_gate) + (size_t)u.ex * kD * kFF + col;
    }
    __device__ __forceinline__ void epilogue(const pg8::f32x4 (&acc)[10][4], const moe::Unit& u, int wr, int wc, int fr, int fq) const {
        const int cnt = tab[65 + u.ex], rk0 = (u.pm - tab[u.ex]) * moe::MT + wr * 160 + fr, row0 = tab[129 + u.ex];
        const int col = 64 * u.pn + 32 * wc + 4 * fq;
#pragma unroll
        for (int m = 0; m < 10; ++m) {
            const int rank = rk0 + 16 * m, rc = rank < cnt ? rank : cnt - 1;
            const float w = p.wrk()[u.ex * 16384 + rc], rs = p.rstd()[p.tokr()[u.ex * 16384 + rc]];
            bf16_t* rowp = p.h_bf() + (size_t)(row0 + rank) * kFF + col;
#pragma unroll
            for (int q = 0; q < 2; ++q) {
                float h[4];
#pragma unroll
                for (int j = 0; j < 4; ++j) { const float g = acc[m][2 * q][j] * rs, uu = acc[m][2 * q + 1][j] * rs; h[j] = g / (1.0f + __expf(-g)) * uu * w; }
                u32x2 o; o.x = pk2(h[0], h[1]); o.y = pk2(h[2], h[3]);
                if (rank < cnt) *(u32x2*)(rowp + 16 * q) = o;
            }
        }
    }
};
struct MoeCfg2 {
    static constexpr int K = kFF, LDB = kD;
    Params p; const int* tab; int G, c;
    __device__ __forceinline__ bool next(int i, moe::Unit& u) const {
        const int cc = (G == 256) ? (((c & 7) * 2 + (c >> 7)) * 16 + ((c >> 3) & 15)) : c;
        const int L = i * G + cc, total = tab[kNE] * 16;
        if (L >= total) return false;
        u.pm = L >> 4; u.pn = L & 15; u.ex = find_expert(tab, u.pm);
        return true;
    }
    __device__ __forceinline__ void a_voffs(const moe::Unit& u, int wid, int lane, unsigned (&v)[10]) const {
        const int row0 = tab[129 + u.ex] + (u.pm - tab[u.ex]) * moe::MT;
#pragma unroll
        for (int i = 0; i < 10; ++i) { int R, Cc; pg8::stage_rc((wid + 4 * i) * 1024 + lane * 16, R, Cc); v[i] = (unsigned)((row0 + R) * kFF + Cc) * 2u; }
    }
    __device__ __forceinline__ const void* abase() const { return p.h_bf(); }
    __device__ __forceinline__ const float* bsrc(const moe::Unit& u, int nq) const { return p.w_down + (size_t)u.ex * kFF * kD + 128 * u.pn + 4 * nq; }
    __device__ __forceinline__ void epilogue(const pg8::f32x4 (&acc)[10][4], const moe::Unit& u, int wr, int wc, int fr, int fq) const {
        const int cnt = tab[65 + u.ex], rk0 = (u.pm - tab[u.ex]) * moe::MT + wr * 160 + fr, row0 = tab[129 + u.ex];
        const int col = 128 * u.pn + 64 * wc + 4 * fq;
#pragma unroll
        for (int m = 0; m < 10; ++m) {
            const int rank = rk0 + 16 * m;
            bf16_t* rowp = p.y_bf() + (size_t)(row0 + rank) * kD + col;
#pragma unroll
            for (int n = 0; n < 4; ++n) {
                const pg8::f32x4 v = acc[m][n];
                u32x2 o; o.x = pk2(v[0], v[1]); o.y = pk2(v[2], v[3]);
                if (rank < cnt) *(u32x2*)(rowp + 16 * n) = o;
            }
        }
    }
};

__device__ __forceinline__ void final_row(const Params& p, int t, const int* tab, int lane) {
    const int pa = tab[129 + p.eid()[2 * t]] + p.srank()[2 * t], pb = tab[129 + p.eid()[2 * t + 1]] + p.srank()[2 * t + 1];
    const f32x4* xr = (const f32x4*)(p.x2() + (size_t)t * kD) + lane;
    const u32x2* ya = (const u32x2*)(p.y_bf() + (size_t)pa * kD) + lane;
    const u32x2* yb = (const u32x2*)(p.y_bf() + (size_t)pb * kD) + lane;
    f32x4 v[8]; u32x2 a[8], c[8];
#pragma unroll
    for (int j = 0; j < 8; ++j) { v[j] = xr[64 * j]; a[j] = ya[64 * j]; c[j] = yb[64 * j]; }
    float ss = 0.f;
#pragma unroll
    for (int j = 0; j < 8; ++j) {
        v[j].x += __uint_as_float(a[j].x << 16) + __uint_as_float(c[j].x << 16);
        v[j].y += __uint_as_float(a[j].x & 0xFFFF0000u) + __uint_as_float(c[j].x & 0xFFFF0000u);
        v[j].z += __uint_as_float(a[j].y << 16) + __uint_as_float(c[j].y << 16);
        v[j].w += __uint_as_float(a[j].y & 0xFFFF0000u) + __uint_as_float(c[j].y & 0xFFFF0000u);
        ss += (v[j].x * v[j].x + v[j].y * v[j].y) + (v[j].z * v[j].z + v[j].w * v[j].w);
    }
    const float sc = rsqrtf(wave_sum(ss) * (1.0f / kD) + 1e-6f);
    const f32x4* gr = (const f32x4*)p.norm_f_g + lane;
    f32x4* orow = (f32x4*)(p.out + (size_t)t * kD) + lane;
#pragma unroll
    for (int j = 0; j < 8; ++j) { const f32x4 g = gr[64 * j]; orow[64 * j] = (f32x4){v[j].x * sc * g.x, v[j].y * sc * g.y, v[j].z * sc * g.z, v[j].w * sc * g.w}; }
}
__device__ __forceinline__ void ph_final2(const Params& p, const int* tab) {
    const int tid = tidx(), lane = tid & 63;
    for (int t = blockIdx.x * 8 + p.wave; t < kT; t += gridDim.x * 8) final_row(p, t, tab, lane);
}

#define GRID_BARRIER() xcd_barrier(bar)
__global__ void __launch_bounds__(512, 2) k_mega(Params p_in) {
    Params p = p_in;
    p.wave = __builtin_amdgcn_readfirstlane(threadIdx.x >> 6);
    extern __shared__ __attribute__((aligned(16))) unsigned char smem[];
    float* lds = (float*)smem;
    PG8_LAS unsigned char* ldsl = (PG8_LAS unsigned char*)smem;
    volatile LAS unsigned* xbw = (volatile LAS unsigned*)(smem + kStageBytes);
    if (tidx() < 4) xbw[tidx()] = 0u;
    __syncthreads();
    XcdBarrier bar = xcd_barrier_post(p.bar(), xbw, (unsigned)p.wave);
    const int G = gridDim.x, c = blockIdx.x;

    ph_prologue(p, lds);
    GRID_BARRIER();
    {
        pg8::Gemm g{p.u_bf(), p.WinT(), kT, kNP, kD};
        pg8::StaticOrder S; S.init(kT, kNP, G, c);
        EpiProj E{p};
        pg8::gemm_phase<EpiProj, pg8::StaticOrder, false>(ldsl, g, S, E, nullptr, p.wave);
    }
    ph_convert_late(p);
    ph_tables(p);
    GRID_BARRIER();
    ph_rnn1(p);
    ph_index_mfma(p, smem);
    GRID_BARRIER();
    ph_rnn2(p, lds);
    ph_attn_mfma(p, smem);
    GRID_BARRIER();
    ph_rnn3(p);
    GRID_BARRIER();
    {
        pg8::Gemm g{p.ab_bf(), p.WpT(), 2 * kT, 2 * kD, 1024};
        MergeOrder S; S.base.init(kT, kD, G, c);
        EpiMerge E{p};
        pg8::gemm_phase<EpiMerge, MergeOrder, false>(ldsl, g, S, E, nullptr, p.wave);
    }
    GRID_BARRIER();
    {
        pg8::Gemm g{p.merged_bf(), p.WoutT(), kT, kD, kD};
        pg8::StaticOrder S; S.init(kT, kD, G, c);
        EpiWout E{p};
        pg8::gemm_phase<EpiWout, pg8::StaticOrder, false>(ldsl, g, S, E, nullptr, p.wave);
    }
    GRID_BARRIER();
    ph_route_mfma(p, smem);
    GRID_BARRIER();
    int* etab = (int*)(smem + kStageBytes + 64 + 1024);
    build_expert_tab(p, etab);
    {
        MoeCfg1 C1{p, etab, G, c};
        moe::gemm<MoeCfg1>(ldsl, C1, p.wave);
    }
    GRID_BARRIER();
    {
        MoeCfg2 C2{p, etab, G, c};
        moe::gemm<MoeCfg2>(ldsl, C2, p.wave);
    }
    GRID_BARRIER();
    ph_final2(p, etab);
}
}

extern "C" void kernel_launch(void* const* d_in, const int* in_sizes, int n_in, void* d_out, int out_size, void* d_ws, size_t ws_size,
                              hipStream_t stream) {
    Params p{};
    const float* const* in = (const float* const*)d_in;
    p.x = in[0]; p.norm1_g = in[1]; p.w_in = in[2]; p.conv_w = in[3]; p.conv_b = in[4]; p.lru_wa = in[5]; p.lru_ba = in[6];
    p.lru_wx = in[7]; p.lru_bx = in[8]; p.lru_lambda = in[9]; p.w_proj_attn = in[10]; p.w_proj_rnn = in[11]; p.w_out = in[12];
    p.rel_bias = in[13]; p.norm2_g = in[14]; p.w_group = in[15]; p.b_group = in[16]; p.w_er = in[17]; p.b_er = in[18];
    p.w_gate = in[19]; p.w_up = in[20]; p.w_down = in[21]; p.norm_f_g = in[22];
    p.out = (float*)d_out;
    p.ws = (unsigned char*)d_ws;
    if (kWsBytes > ws_size) fprintf(stderr, "workspace too small: need %zu, have %zu\n", (size_t)kWsBytes, ws_size);
    static int grid = 0;
    if (!grid) {
        int dev = 0, cus = 0, per_cu = 0;
        (void)hipGetDevice(&dev);
        (void)hipDeviceGetAttribute(&cus, hipDeviceAttributeMultiprocessorCount, dev);
        if (hipFuncSetAttribute((const void*)k_mega, hipFuncAttributeMaxDynamicSharedMemorySize, kLdsBytes) != hipSuccess) fprintf(stderr, "hipFuncSetAttribute failed\n");
        (void)hipOccupancyMaxActiveBlocksPerMultiprocessor(&per_cu, (const void*)k_mega, kNT, kLdsBytes);
        if (per_cu < 1) fprintf(stderr, "occupancy query says %d blocks/CU\n", per_cu);
        (void)hipGetLastError();
        grid = cus;
    }
    (void)hipMemsetAsync(p.ws + O_bar, 0, O_WguT - O_bar, stream);
    hipLaunchKernelGGL(k_mega, dim3(grid), dim3(kNT), kLdsBytes, stream, p);
}
```

```cpp
#include <hip/hip_runtime.h>
#include <stdint.h>
#include <cstdio>

#define XB_TMO      128
#define XB_XCNT(j)  (256  + 64 * (j))
#define XB_XSUB(j)  (1280 + 64 * (j))
#define XB_XGEN(j)  (2304 + 64 * (j))
#define XB_TOP      3328
#define XB_TOPGEN   3392
#define XCD_BAR_WORDS 3456
#define XB_SPIN_CAP (1u << 18)
#define LAS __attribute__((address_space(3)))

__device__ __forceinline__ unsigned xb_ld(unsigned* p)              { return __hip_atomic_load(p, __ATOMIC_RELAXED, __HIP_MEMORY_SCOPE_AGENT); }
__device__ __forceinline__ unsigned xb_add(unsigned* p, unsigned v) { return __hip_atomic_fetch_add(p, v, __ATOMIC_RELAXED, __HIP_MEMORY_SCOPE_AGENT); }
__device__ __forceinline__ unsigned xb_xcc_id() { return (unsigned)__builtin_amdgcn_s_getreg((3 << 11) | 20) & 0xFu; }
#define XB_SPIN(cond, bar) do { unsigned _sp = 0; while (cond) { __builtin_amdgcn_s_sleep(1); \
    if ((++_sp & 255u) == 0u) { if (xb_ld(&(bar)[XB_TMO])) break; if (_sp > XB_SPIN_CAP) { atomicAdd(&(bar)[XB_TMO], 1u); break; } } } } while (0)

struct XcdBarrier {
    unsigned* bar; unsigned x; unsigned wave;
    volatile LAS unsigned* st;
};

__device__ __forceinline__ bool xb_is_thread0(unsigned wave) { unsigned l; asm volatile("v_mbcnt_lo_u32_b32 %0, -1, 0\n\tv_mbcnt_hi_u32_b32 %0, -1, %0" : "=v"(l)); return wave == 0u && l == 0u; }
__device__ __forceinline__ XcdBarrier xcd_barrier_post(unsigned* bar, volatile LAS unsigned* st, unsigned wave) {
    XcdBarrier b; b.bar = bar; b.x = xb_xcc_id(); b.st = st; b.wave = wave;
    if (xb_is_thread0(wave)) (void)xb_add(&bar[XB_XCNT(b.x)], 1u);
    return b;
}
__device__ __forceinline__ void xcd_barrier_complete(unsigned* bar, unsigned x, unsigned& nloc, unsigned& nx) {
    const unsigned G = gridDim.x * gridDim.y * gridDim.z;
    unsigned sum, cnt, mine, sp = 0u;
    for (;;) {
        sum = 0u; cnt = 0u; mine = 0u;
#pragma unroll
        for (unsigned j = 0; j < 16; ++j) { const unsigned c = xb_ld(&bar[XB_XCNT(j)]); sum += c; cnt += (c > 0u) ? 1u : 0u; mine = (j == x) ? c : mine; }
        if (sum == G) break;
        __builtin_amdgcn_s_sleep(1);
        if ((++sp & 255u) == 0u) { if (xb_ld(&bar[XB_TMO])) break; if (sp > XB_SPIN_CAP) { atomicAdd(&bar[XB_TMO], 1u); break; } }
    }
    nloc = mine > 0u ? mine : 1u; nx = cnt > 0u ? cnt : 1u;
}

__device__ __forceinline__ void xcd_barrier(const XcdBarrier& b) {
    asm volatile("s_waitcnt vmcnt(0)" ::: "memory");
    __syncthreads();
    if (xb_is_thread0(b.wave)) {
        unsigned* bar = b.bar;
        __builtin_amdgcn_s_waitcnt(0);
        unsigned nloc = b.st[0], nx = b.st[1];
        if (nloc == 0u) { xcd_barrier_complete(bar, b.x, nloc, nx); b.st[0] = nloc; b.st[1] = nx; }
        const unsigned old = xb_add(&bar[XB_XSUB(b.x)], 1u);
        const unsigned gen = old / nloc;
        if (old + 1u == (gen + 1u) * nloc) {
            __builtin_amdgcn_fence(__ATOMIC_RELEASE, "agent");
            asm volatile("s_waitcnt vmcnt(0)" ::: "memory");
            const unsigned og = xb_add(&bar[XB_TOP], 1u);
            const unsigned tg = og / nx;
            if (og + 1u == (tg + 1u) * nx) xb_add(&bar[XB_TOPGEN], 1u);
            else XB_SPIN(xb_ld(&bar[XB_TOPGEN]) == tg, bar);
            __builtin_amdgcn_fence(__ATOMIC_ACQUIRE, "agent");
            xb_add(&bar[XB_XGEN(b.x)], 1u);
            asm volatile("s_waitcnt vmcnt(0)" ::: "memory");
        } else {
            XB_SPIN(xb_ld(&bar[XB_XGEN(b.x)]) == gen, bar);
            __builtin_amdgcn_fence(__ATOMIC_ACQUIRE, "agent");
            asm volatile("s_waitcnt vmcnt(0)" ::: "memory");
        }
    }
    __syncthreads();
}


namespace pg8 {
#define PG8_LAS __attribute__((address_space(3)))
typedef unsigned short bf16_t;
typedef short bf16x8 __attribute__((ext_vector_type(8)));
typedef float f32x4 __attribute__((ext_vector_type(4)));
typedef unsigned u32x4 __attribute__((ext_vector_type(4)));
constexpr int BM = 256, BK = 64, HALF = 128, HTB = HALF * BK * 2  , STAGE_BYTES = 8 * HTB, NXCD = 8, WGM = 8;

__host__ __device__ __forceinline__ int lds_byte(int r, int c) { const int st = (r >> 4) * 2 + (c >> 5), rr = r & 15, cc = c & 31, ob = rr * 64 + cc * 2; return st * 1024 + (ob ^ (((ob >> 9) & 1) << 5)); }
__host__ __device__ __forceinline__ void stage_rc(int b, int& R, int& C) { const int st = b / 1024, sb = b % 1024, swz = sb ^ (((sb >> 9) & 1) << 5); R = (st >> 1) * 16 + swz / 64; C = (st & 1) * 32 + (swz % 64) / 2; }
__host__ __device__ __forceinline__ int perm32(int rho) { const int n = rho >> 4, i = rho & 15; return 8 * (i >> 2) + 4 * n + (i & 3); }

struct Unit { int pm, pn, kh; };
struct Gemm { const bf16_t* A; const bf16_t* Bt; int M, N, K; };

struct StaticOrder {
    static constexpr bool KSPLIT = false;
    int nM, nN, nwg, G, c;
    __host__ __device__ void init(int M, int N, int G_, int c_) { nM = M / BM; nN = N / BM; nwg = nM * nN; G = G_; c = c_; }
    __host__ __device__ bool next(int i, Unit& u) const {
        const long L = (long)i * G + c; if (L >= nwg) return false;
        int wgid = (int)L; { const int q = nwg / NXCD, r = nwg % NXCD, xcd = wgid % NXCD, off = wgid / NXCD; wgid = (xcd < r ? xcd * (q + 1) : r * (q + 1) + (xcd - r) * q) + off; }
        const int nig = WGM * nN, gid = wgid / nig, fm = gid * WGM, gsz = (nM - fm) < WGM ? (nM - fm) : WGM;
        u.pm = fm + ((wgid % nig) % gsz); u.pn = (wgid % nig) / gsz; u.kh = 0; return true;
    }
    __device__ __forceinline__ void a_ready(const Unit&) const {}
    __device__ __forceinline__ void done(const Unit&) const {}
};
__device__ __forceinline__ unsigned cvt_pk_bf16(float lo, float hi) { unsigned r; asm volatile("s_nop 0\n\tv_cvt_pk_bf16_f32 %0, %1, %2" : "=v"(r) : "v"(lo), "v"(hi)); return r; }
__device__ __forceinline__ unsigned cvt_pk_bf16_ld(float lo, float hi) { unsigned r; asm volatile("v_cvt_pk_bf16_f32 %0, %1, %2" : "=v"(r) : "v"(lo), "v"(hi)); return r; }
typedef float f32x2 __attribute__((ext_vector_type(2)));
__device__ __forceinline__ f32x2 gelu_pk(f32x2 v) {
    const f32x2 av = __builtin_elementwise_abs(v), d = av * 0.2316418882f + 1.0f;
    f32x2 t; t.x = __builtin_amdgcn_rcpf(d.x); t.y = __builtin_amdgcn_rcpf(d.y);
    f32x2 q = t * 0.5307027145f + (-0.7265760135f); q = q * t + 0.7107068705f; q = q * t + (-0.142248368f); q = q * t + 0.127414796f; q = q * t;
    const f32x2 s = (v * v) * (-0.72134752044f);
    f32x2 e; e.x = __builtin_amdgcn_exp2f(s.x); e.y = __builtin_amdgcn_exp2f(s.y);
    const f32x2 m = v * (q * e), r = v - m;
    f32x2 o; o.x = v.x < 0.f ? m.x : r.x; o.y = v.y < 0.f ? m.y : r.y; return o;
}

template <class Epi, class Sched, bool STAMP = false>
__device__ __forceinline__ void gemm_phase(PG8_LAS unsigned char* lds, const Gemm g, const Sched& S, const Epi& E, unsigned long long* stamps, int wave0) {
    int lane_l; asm volatile("v_mbcnt_lo_u32_b32 %0, -1, 0\n\tv_mbcnt_hi_u32_b32 %0, -1, %0" : "=v"(lane_l)); const int tid = wave0 * 64 + lane_l, wid = __builtin_amdgcn_readfirstlane(tid >> 6), lane = tid & 63, wr = wid >> 2, wc = wid & 3, fr = lane & 15, fq = lane >> 4;
    const int K = g.K, nt = K / BK;
    int ts_lo = 0, ts_hi = 0, nts = 0; const unsigned long long rt_entry = STAMP ? (unsigned long long)wall_clock64() : 0ull;
#define PG8_STAMP() do { if (STAMP && wid == 0 && nts < 64) { const unsigned long long _c = (unsigned long long)clock64(); \
        ts_lo = (lane == nts) ? (int)(unsigned)_c : ts_lo; ts_hi = (lane == nts) ? (int)(unsigned)(_c >> 32) : ts_hi; ++nts; } } while (0)
    PG8_STAMP();
    unsigned voffA[2], voffB[2];
#pragma unroll
    for (int i = 0; i < 2; ++i) { int R, C; stage_rc(tid * 16 + i * 8192, R, C); const int Rb = Epi::PERM ? ((R & ~31) + perm32(R & 31)) : R;
        voffA[i] = (unsigned)(R * K + C) * 2u; voffB[i] = (unsigned)(Rb * K + C) * 2u; }
    const size_t kstep = (size_t)(BK * 2);
    const size_t hstep = (size_t)HALF * K * 2;
    const size_t tstep = 2 * hstep;
    const unsigned ldsw = (unsigned)wid * 1024u;
    const int aoff = lds_byte(wr * 64 + fr, fq * 8), boff = lds_byte(wc * 32 + fr, fq * 8);
#define PG8_SA(b, h) (((b) * 2 + (h)) * HTB)
#define PG8_SB(b, h) ((4 + (b) * 2 + (h)) * HTB)
#define PG8_STAGE(bufoff, gbase, voff) do { _Pragma("unroll") for (int _i = 0; _i < 2; ++_i) \
        __builtin_amdgcn_global_load_lds((const unsigned*)((const char*)(gbase) + (voff)[_i]), (PG8_LAS unsigned*)(lds + (bufoff) + ldsw + _i * 8192), 16, 0, 0); } while (0)
#define PG8_LDA(dst, b, h) do { _Pragma("unroll") for (int m = 0; m < 4; ++m) _Pragma("unroll") for (int k = 0; k < 2; ++k) dst[m][k] = *(const PG8_LAS bf16x8*)(lds + PG8_SA(b, h) + aoff + m * 2048 + k * 1024); } while (0)
#define PG8_LDB(dst, b, h) do { _Pragma("unroll") for (int n = 0; n < 2; ++n) _Pragma("unroll") for (int k = 0; k < 2; ++k) dst[n][k] = *(const PG8_LAS bf16x8*)(lds + PG8_SB(b, h) + boff + n * 2048 + k * 1024); } while (0)
#define PG8_MMA(ai, bj, At, Bt) do { __builtin_amdgcn_s_setprio(1); _Pragma("unroll") for (int m = 0; m < 4; ++m) _Pragma("unroll") for (int n = 0; n < 2; ++n) _Pragma("unroll") for (int k = 0; k < 2; ++k) \
        acc[ai][bj][m][n] = __builtin_amdgcn_mfma_f32_16x16x32_bf16(Bt[n][k], At[m][k], acc[ai][bj][m][n], 0, 0, 0); __builtin_amdgcn_s_setprio(0); } while (0)
#define PG8_WAIT_V(n) asm volatile("s_waitcnt vmcnt(" #n ")" ::: "memory")
#define PG8_WAIT_L(n) asm volatile("s_waitcnt lgkmcnt(" #n ")" ::: "memory")
#define PG8_BAR __builtin_amdgcn_s_barrier()
#define PG8_SCHED __builtin_amdgcn_sched_barrier(0)
    Unit cur, nxt; int ui = 0; bool drained = false;
    if (!S.next(0, cur)) return;
    f32x4 acc[2][2][4][2];
#pragma unroll
    for (int a = 0; a < 2; ++a)
#pragma unroll
        for (int b = 0; b < 2; ++b)
#pragma unroll
            for (int m = 0; m < 4; ++m)
#pragma unroll
                for (int n = 0; n < 2; ++n) acc[a][b][m][n] = (f32x4){0.f, 0.f, 0.f, 0.f};
    bf16x8 At[4][2], B0[2][2], B1[2][2];
#define PG8_KOFF(u_) ((Sched::KSPLIT && (u_).kh != 0 && (((u_).kh - 1) & 1)) ? (size_t)(nt / 2) * kstep : (size_t)0)
    const char* cA = (const char*)g.A + (size_t)cur.pm * tstep + PG8_KOFF(cur); const char* cB = (const char*)g.Bt + (size_t)cur.pn * tstep + PG8_KOFF(cur);
    S.a_ready(cur);
    PG8_STAGE(PG8_SB(0, 0), cB, voffB); PG8_STAGE(PG8_SA(0, 0), cA, voffA); PG8_STAGE(PG8_SB(0, 1), cB + hstep, voffB); PG8_STAGE(PG8_SA(0, 1), cA + hstep, voffA);
    if (wr == 1) PG8_BAR;
    PG8_WAIT_V(4); PG8_BAR;
    PG8_STAGE(PG8_SB(1, 0), cB + kstep, voffB); PG8_STAGE(PG8_SA(1, 0), cA + kstep, voffA); PG8_STAGE(PG8_SB(1, 1), cB + hstep + kstep, voffB);
    PG8_WAIT_V(6); PG8_BAR;
    PG8_STAMP();
    for (;;) {
        const bool has_next = S.next(ui + 1, nxt);
        const char* nA = has_next ? (const char*)g.A + (size_t)nxt.pm * tstep + PG8_KOFF(nxt) : cA; const char* nB = has_next ? (const char*)g.Bt + (size_t)nxt.pn * tstep + PG8_KOFF(nxt) : cB;
        const int ntu = (Sched::KSPLIT && cur.kh != 0) ? nt / 2 : nt;
        for (int t = 0; t < ntu; t += 2) {
            const bool last = (t == ntu - 2);
            const char* a1 = cA + (size_t)(t + 1) * kstep;
            const char* a2 = last ? nA : cA + (size_t)(t + 2) * kstep; const char* b2 = last ? nB : cB + (size_t)(t + 2) * kstep;
            const char* a3 = a2 + kstep; const char* b3 = b2 + kstep;
            if (last && has_next) S.a_ready(nxt);
            PG8_LDB(B0, 0, 0); PG8_SCHED; PG8_LDA(At, 0, 0); PG8_STAGE(PG8_SA(1, 1), a1 + hstep, voffA);
            PG8_WAIT_L(8); PG8_BAR; PG8_WAIT_L(0); PG8_MMA(0, 0, At, B0); PG8_BAR; PG8_SCHED;
            PG8_LDB(B1, 0, 1); PG8_STAGE(PG8_SB(0, 0), b2, voffB);
            PG8_BAR; PG8_WAIT_L(0); PG8_MMA(0, 1, At, B1); PG8_BAR;
            PG8_LDA(At, 0, 1); PG8_STAGE(PG8_SA(0, 0), a2, voffA);
            PG8_BAR; PG8_WAIT_L(0); PG8_MMA(1, 0, At, B0); PG8_BAR; PG8_SCHED;
            PG8_STAGE(PG8_SB(0, 1), b2 + hstep, voffB);
            PG8_WAIT_V(6); PG8_BAR; PG8_MMA(1, 1, At, B1); PG8_BAR;
            PG8_LDB(B0, 1, 0); PG8_SCHED; PG8_LDA(At, 1, 0); PG8_STAGE(PG8_SA(0, 1), a2 + hstep, voffA);
            PG8_WAIT_L(8); PG8_BAR; PG8_WAIT_L(0); PG8_MMA(0, 0, At, B0); PG8_BAR; PG8_SCHED;
            PG8_LDB(B1, 1, 1); PG8_STAGE(PG8_SB(1, 0), b3, voffB);
            PG8_BAR; PG8_WAIT_L(0); PG8_MMA(0, 1, At, B1); PG8_BAR;
            PG8_LDA(At, 1, 1); PG8_STAGE(PG8_SA(1, 0), a3, voffA);
            PG8_BAR; PG8_WAIT_L(0); PG8_MMA(1, 0, At, B0); PG8_BAR; PG8_SCHED;
            PG8_STAGE(PG8_SB(1, 1), b3 + hstep, voffB);
            PG8_WAIT_V(6); PG8_BAR; PG8_MMA(1, 1, At, B1); PG8_BAR;
        }
        PG8_STAMP();
        bool keep_acc = false;
        if constexpr (!Epi::AFTER_DRAIN) {
            if constexpr (Epi::CHAIN) keep_acc = E.chain(acc, cur, wr, wc, fr, fq);
            else {
                bool do_epi = true;
                if constexpr (Sched::KSPLIT) {
                    if (cur.kh != 0) {
                        PG8_WAIT_V(0); if (wr == 0) PG8_BAR; PG8_BAR; drained = true;
                        do_epi = E.ksplit(acc, cur, wid, lane);
                    }
                }
                if (do_epi) E(acc, cur, wr, wc, fr, fq);
            }
            S.done(cur);
        }
        PG8_STAMP();
        if (!has_next) break;
        if (!keep_acc) {
#pragma unroll
            for (int a = 0; a < 2; ++a)
#pragma unroll
                for (int b = 0; b < 2; ++b)
#pragma unroll
                    for (int m = 0; m < 4; ++m)
#pragma unroll
                        for (int n = 0; n < 2; ++n) acc[a][b][m][n] = (f32x4){0.f, 0.f, 0.f, 0.f};
        }
        cur = nxt; cA = nA; cB = nB; ++ui;
    }
    if (!drained) {
    PG8_WAIT_V(0);
    if (wr == 0) PG8_BAR;
    PG8_BAR;
    }
    if constexpr (Epi::AFTER_DRAIN) { E.fused(acc, cur, wr, wc, fr, fq, lds, wid, lane); S.done(cur); }
    PG8_STAMP();
    if (STAMP && wid == 0) { stamps[lane] = lane < nts ? (((unsigned long long)(unsigned)ts_hi << 32) | (unsigned)ts_lo) : 0ull;
        if (lane == 62) stamps[62] = rt_entry; if (lane == 63) stamps[63] = (unsigned long long)wall_clock64(); }
#undef PG8_STAMP
#undef PG8_KOFF
#undef PG8_SA
#undef PG8_SB
#undef PG8_STAGE
#undef PG8_LDA
#undef PG8_LDB
#undef PG8_MMA
#undef PG8_WAIT_V
#undef PG8_WAIT_L
#undef PG8_BAR
#undef PG8_SCHED
}

struct UnitX { int pm, pn, ex; };
template <class Epi, class Sched>
__device__ __forceinline__ void gemm_phase2(PG8_LAS unsigned char* lds, const Gemm g, const Sched& S, const Epi& E, int wave0) {
    int lane_l; asm volatile("v_mbcnt_lo_u32_b32 %0, -1, 0\n\tv_mbcnt_hi_u32_b32 %0, -1, %0" : "=v"(lane_l)); const int tid = wave0 * 64 + lane_l, wid = __builtin_amdgcn_readfirstlane(tid >> 6), lane = tid & 63, wr = wid >> 2, wc = wid & 3, fr = lane & 15, fq = lane >> 4;
    const int K = g.K, nt = K / BK;
    int RA[2], CA[2]; unsigned voffB[2];
#pragma unroll
    for (int i = 0; i < 2; ++i) { int R, C; stage_rc(tid * 16 + i * 8192, R, C); const int Rb = Epi::PERM ? ((R & ~31) + perm32(R & 31)) : R;
        RA[i] = R; CA[i] = C; voffB[i] = (unsigned)(Rb * K + C) * 2u; }
    const size_t kstep = (size_t)(BK * 2);
    const size_t hstep = (size_t)HALF * K * 2;
    const unsigned ldsw = (unsigned)wid * 1024u;
    const int aoff = lds_byte(wr * 64 + fr, fq * 8), boff = lds_byte(wc * 32 + fr, fq * 8);
#define PG8_SA(b, h) (((b) * 2 + (h)) * HTB)
#define PG8_SB(b, h) ((4 + (b) * 2 + (h)) * HTB)
#define PG8_STAGE(bufoff, gbase, voff) do { _Pragma("unroll") for (int _i = 0; _i < 2; ++_i) \
        __builtin_amdgcn_global_load_lds((const unsigned*)((const char*)(gbase) + (voff)[_i]), (PG8_LAS unsigned*)(lds + (bufoff) + ldsw + _i * 8192), 16, 0, 0); } while (0)
#define PG8_LDA(dst, b, h) do { _Pragma("unroll") for (int m = 0; m < 4; ++m) _Pragma("unroll") for (int k = 0; k < 2; ++k) dst[m][k] = *(const PG8_LAS bf16x8*)(lds + PG8_SA(b, h) + aoff + m * 2048 + k * 1024); } while (0)
#define PG8_LDB(dst, b, h) do { _Pragma("unroll") for (int n = 0; n < 2; ++n) _Pragma("unroll") for (int k = 0; k < 2; ++k) dst[n][k] = *(const PG8_LAS bf16x8*)(lds + PG8_SB(b, h) + boff + n * 2048 + k * 1024); } while (0)
#define PG8_MMA(ai, bj, At, Bt) do { __builtin_amdgcn_s_setprio(1); _Pragma("unroll") for (int m = 0; m < 4; ++m) _Pragma("unroll") for (int n = 0; n < 2; ++n) _Pragma("unroll") for (int k = 0; k < 2; ++k) \
        acc[ai][bj][m][n] = __builtin_amdgcn_mfma_f32_16x16x32_bf16(Bt[n][k], At[m][k], acc[ai][bj][m][n], 0, 0, 0); __builtin_amdgcn_s_setprio(0); } while (0)
#define PG8_WAIT_V(n) asm volatile("s_waitcnt vmcnt(" #n ")" ::: "memory")
#define PG8_WAIT_L(n) asm volatile("s_waitcnt lgkmcnt(" #n ")" ::: "memory")
#define PG8_BAR __builtin_amdgcn_s_barrier()
#define PG8_SCHED __builtin_amdgcn_sched_barrier(0)
    UnitX cur, nxt; int ui = 0;
    if (!S.next(0, cur)) return;
    f32x4 acc[2][2][4][2];
#pragma unroll
    for (int a = 0; a < 2; ++a)
#pragma unroll
        for (int b = 0; b < 2; ++b)
#pragma unroll
            for (int m = 0; m < 4; ++m)
#pragma unroll
                for (int n = 0; n < 2; ++n) acc[a][b][m][n] = (f32x4){0.f, 0.f, 0.f, 0.f};
    bf16x8 At[4][2], B0[2][2], B1[2][2];
    unsigned vC0[2], vC1[2], vN0[2], vN1[2];
    S.a_voffs(cur, RA, CA, vC0, vC1);
    const char* const A0 = (const char*)g.A;
    const char* cB = (const char*)g.Bt + S.b_off(cur);
    PG8_STAGE(PG8_SB(0, 0), cB, voffB); PG8_STAGE(PG8_SA(0, 0), A0, vC0); PG8_STAGE(PG8_SB(0, 1), cB + hstep, voffB); PG8_STAGE(PG8_SA(0, 1), A0, vC1);
    if (wr == 1) PG8_BAR;
    PG8_WAIT_V(4); PG8_BAR;
    PG8_STAGE(PG8_SB(1, 0), cB + kstep, voffB); PG8_STAGE(PG8_SA(1, 0), A0 + kstep, vC0); PG8_STAGE(PG8_SB(1, 1), cB + hstep + kstep, voffB);
    PG8_WAIT_V(6); PG8_BAR;
    for (;;) {
        const bool has_next = S.next(ui + 1, nxt);
        const char* nB = has_next ? (const char*)g.Bt + S.b_off(nxt) : cB;
        if (has_next) S.a_voffs(nxt, RA, CA, vN0, vN1);
        else { vN0[0] = vC0[0]; vN0[1] = vC0[1]; vN1[0] = vC1[0]; vN1[1] = vC1[1]; }
        for (int t = 0; t < nt; t += 2) {
            const bool last = (t == nt - 2);
            const char* a1 = A0 + (size_t)(t + 1) * kstep;
            const char* a2 = last ? A0 : A0 + (size_t)(t + 2) * kstep; const char* b2 = last ? nB : cB + (size_t)(t + 2) * kstep;
            const char* a3 = a2 + kstep; const char* b3 = b2 + kstep;
            unsigned w0[2], w1[2];
            w0[0] = last ? vN0[0] : vC0[0]; w0[1] = last ? vN0[1] : vC0[1]; w1[0] = last ? vN1[0] : vC1[0]; w1[1] = last ? vN1[1] : vC1[1];
            PG8_LDB(B0, 0, 0); PG8_SCHED; PG8_LDA(At, 0, 0); PG8_STAGE(PG8_SA(1, 1), a1, vC1);
            PG8_WAIT_L(8); PG8_BAR; PG8_WAIT_L(0); PG8_MMA(0, 0, At, B0); PG8_BAR; PG8_SCHED;
            PG8_LDB(B1, 0, 1); PG8_STAGE(PG8_SB(0, 0), b2, voffB);
            PG8_BAR; PG8_WAIT_L(0); PG8_MMA(0, 1, At, B1); PG8_BAR;
            PG8_LDA(At, 0, 1); PG8_STAGE(PG8_SA(0, 0), a2, w0);
            PG8_BAR; PG8_WAIT_L(0); PG8_MMA(1, 0, At, B0); PG8_BAR; PG8_SCHED;
            PG8_STAGE(PG8_SB(0, 1), b2 + hstep, voffB);
            PG8_WAIT_V(6); PG8_BAR; PG8_MMA(1, 1, At, B1); PG8_BAR;
            PG8_LDB(B0, 1, 0); PG8_SCHED; PG8_LDA(At, 1, 0); PG8_STAGE(PG8_SA(0, 1), a2, w1);
            PG8_WAIT_L(8); PG8_BAR; PG8_WAIT_L(0); PG8_MMA(0, 0, At, B0); PG8_BAR; PG8_SCHED;
            PG8_LDB(B1, 1, 1); PG8_STAGE(PG8_SB(1, 0), b3, voffB);
            PG8_BAR; PG8_WAIT_L(0); PG8_MMA(0, 1, At, B1); PG8_BAR;
            PG8_LDA(At, 1, 1); PG8_STAGE(PG8_SA(1, 0), a3, w0);
            PG8_BAR; PG8_WAIT_L(0); PG8_MMA(1, 0, At, B0); PG8_BAR; PG8_SCHED;
            PG8_STAGE(PG8_SB(1, 1), b3 + hstep, voffB);
            PG8_WAIT_V(6); PG8_BAR; PG8_MMA(1, 1, At, B1); PG8_BAR;
        }
        E(acc, cur, wr, wc, fr, fq);
        if (!has_next) break;
#pragma unroll
        for (int a = 0; a < 2; ++a)
#pragma unroll
            for (int b = 0; b < 2; ++b)
#pragma unroll
                for (int m = 0; m < 4; ++m)
#pragma unroll
                    for (int n = 0; n < 2; ++n) acc[a][b][m][n] = (f32x4){0.f, 0.f, 0.f, 0.f};
        cur = nxt; cB = nB; ++ui;
        vC0[0] = vN0[0]; vC0[1] = vN0[1]; vC1[0] = vN1[0]; vC1[1] = vN1[1];
    }
    PG8_WAIT_V(0);
    if (wr == 0) PG8_BAR;
    PG8_BAR;
#undef PG8_SA
#undef PG8_SB
#undef PG8_STAGE
#undef PG8_LDA
#undef PG8_LDB
#undef PG8_MMA
#undef PG8_WAIT_V
#undef PG8_WAIT_L
#undef PG8_BAR
#undef PG8_SCHED
}
}


namespace moe {
using pg8::bf16x8; using pg8::f32x4; using pg8::lds_byte; using pg8::stage_rc; using pg8::HTB; using pg8::BK; using pg8::HALF;
struct Unit { int pm, pn, ex; };
typedef unsigned u32x4_t __attribute__((ext_vector_type(4)));
constexpr int MT = 352, RG = MT / 16, MG = RG / 2, ASLOT = RG * 2048;
#define MOE_SA(s) ((s) * ASLOT)
#define MOE_SB(b) (2 * ASLOT + (b) * HTB)
#define MOE_SYNC() do { asm volatile("s_waitcnt lgkmcnt(0)" ::: "memory"); __builtin_amdgcn_s_barrier(); asm volatile("" ::: "memory"); } while (0)
#define MOE_BLOAD(R, src) do { const float* _s = (src); \
        asm volatile("global_load_dwordx4 %0, %8, off nt\n\tglobal_load_dwordx4 %1, %9, off nt\n\tglobal_load_dwordx4 %2, %10, off nt\n\tglobal_load_dwordx4 %3, %11, off nt\n\t" \
                     "global_load_dwordx4 %4, %12, off nt\n\tglobal_load_dwordx4 %5, %13, off nt\n\tglobal_load_dwordx4 %6, %14, off nt\n\tglobal_load_dwordx4 %7, %15, off nt" \
                     : "=&v"(R[0]), "=&v"(R[1]), "=&v"(R[2]), "=&v"(R[3]), "=&v"(R[4]), "=&v"(R[5]), "=&v"(R[6]), "=&v"(R[7]) \
                     : "v"(_s), "v"(_s + (size_t)1 * Cfg::LDB), "v"(_s + (size_t)2 * Cfg::LDB), "v"(_s + (size_t)3 * Cfg::LDB), \
                       "v"(_s + (size_t)4 * Cfg::LDB), "v"(_s + (size_t)5 * Cfg::LDB), "v"(_s + (size_t)6 * Cfg::LDB), "v"(_s + (size_t)7 * Cfg::LDB) : "memory"); } while (0)
#define MOE_BWAIT(R, n) asm volatile("s_waitcnt vmcnt(" #n ")" : "+v"(R[0]), "+v"(R[1]), "+v"(R[2]), "+v"(R[3]), "+v"(R[4]), "+v"(R[5]), "+v"(R[6]), "+v"(R[7]) :: "memory")
#define MOE_BWRITE(slot, R) do { _Pragma("unroll") for (int _i = 0; _i < 4; ++_i) { u32x4_t _w; \
        _w.x = pg8::cvt_pk_bf16_ld(R[0][_i], R[1][_i]); _w.y = pg8::cvt_pk_bf16_ld(R[2][_i], R[3][_i]); _w.z = pg8::cvt_pk_bf16_ld(R[4][_i], R[5][_i]); _w.w = pg8::cvt_pk_bf16_ld(R[6][_i], R[7][_i]); \
        *(PG8_LAS u32x4_t*)(lds + (slot) + bw[_i]) = _w; } } while (0)

template <class Cfg>
__device__ __forceinline__ void gemm(PG8_LAS unsigned char* lds, const Cfg& C, int wave0) {
    int tid_l; { int lane_; asm volatile("v_mbcnt_lo_u32_b32 %0, -1, 0\n\tv_mbcnt_hi_u32_b32 %0, -1, %0 ; moe K=%1" : "=v"(lane_) : "i"(Cfg::K)); tid_l = wave0 * 64 + lane_; }
    const int tid = tid_l, wid = __builtin_amdgcn_readfirstlane(tid >> 6), lane = tid & 63;
    constexpr int K = Cfg::K, nt = K / BK;
    static_assert(nt % 4 == 0 && nt >= 8, "K-tile count");
    const size_t kstep = (size_t)(BK * 2);
    Unit u, un;
    if (!C.next(0, u)) return;
    if (wid >= 4) {
        int t256_l; asm volatile("v_mbcnt_lo_u32_b32 %0, -1, 0\n\tv_mbcnt_hi_u32_b32 %0, -1, %0 ; moe loader K=%1" : "=v"(t256_l) : "i"(Cfg::K)); t256_l += (wid - 4) * 64;
        const int t256 = t256_l, nq = t256 & 31, kq = t256 >> 5;
        unsigned bw[4];
#pragma unroll
        for (int i = 0; i < 4; ++i) bw[i] = (unsigned)lds_byte(4 * nq + i, 8 * kq);
        const float* bsrc = C.bsrc(u, nq) + (size_t)(8 * kq) * Cfg::LDB;
        f32x4 R0[8], R1[8], R2[8], R3[8];
        __builtin_amdgcn_s_waitcnt(0);
        MOE_BLOAD(R0, bsrc);
        MOE_BWAIT(R0, 0);
        MOE_BWRITE(MOE_SB(0), R0);
        MOE_BLOAD(R1, bsrc + (size_t)1 * BK * Cfg::LDB);
        MOE_BLOAD(R2, bsrc + (size_t)2 * BK * Cfg::LDB);
        MOE_BLOAD(R3, bsrc + (size_t)3 * BK * Cfg::LDB);
        MOE_SYNC();
        for (int ui = 0;; ++ui) {
            const bool has_next = C.next(ui + 1, un);
            const float* bnext = has_next ? C.bsrc(un, nq) + (size_t)(8 * kq) * Cfg::LDB : bsrc;
#pragma unroll 1
            for (int t = 0; t < nt; t += 4) {
                const bool tail = (t + 4 >= nt);
                const float* q0 = tail ? bnext : bsrc + (size_t)(t + 4) * BK * Cfg::LDB;
                MOE_BWAIT(R1, 16); MOE_BWRITE(MOE_SB(1), R1); MOE_BLOAD(R0, q0);                                     MOE_SYNC();
                MOE_BWAIT(R2, 16); MOE_BWRITE(MOE_SB(0), R2); MOE_BLOAD(R1, q0 + (size_t)1 * BK * Cfg::LDB);          MOE_SYNC();
                MOE_BWAIT(R3, 16); MOE_BWRITE(MOE_SB(1), R3); MOE_BLOAD(R2, q0 + (size_t)2 * BK * Cfg::LDB);          MOE_SYNC();
                MOE_BWAIT(R0, 16); MOE_BWRITE(MOE_SB(0), R0); MOE_BLOAD(R3, q0 + (size_t)3 * BK * Cfg::LDB);          MOE_SYNC();
            }
            if (!has_next) break;
            bsrc = bnext;
        }
        MOE_BWAIT(R1, 0);
        MOE_SYNC();
        return;
    }
    int lane_c = lane; asm volatile("" : "+v"(lane_c));
    const int wr = wid >> 1, wc = wid & 1, fr = lane_c & 15, fq = lane_c >> 4;
    constexpr int NP = RG / 2;
    const int aoff = lds_byte(fr, fq * 8), boff = lds_byte(wc * 64 + fr, fq * 8);
#define MOE_STAGE(slot, gbase, v) do { _Pragma("unroll") for (int _i = 0; _i < NP; ++_i) \
        __builtin_amdgcn_global_load_lds((const unsigned*)((const char*)(gbase) + (v)[_i]), (PG8_LAS unsigned*)(lds + MOE_SA(slot) + (wid + 4 * _i) * 1024), 16, 0, 0); } while (0)
    unsigned vA[NP];
    C.a_voffs(u, wid, lane, vA);
    const char* const A0 = (const char*)C.abase();
    f32x4 acc[MG][4];
#pragma unroll
    for (int m = 0; m < MG; ++m)
#pragma unroll
        for (int n = 0; n < 4; ++n) acc[m][n] = (f32x4){0.f, 0.f, 0.f, 0.f};
    int sl = 0;
    MOE_STAGE(0, A0, vA);
    asm volatile("s_waitcnt vmcnt(0)" ::: "memory");
    MOE_SYNC();
    for (int ui = 0;; ++ui) {
        const bool has_next = C.next(ui + 1, un);
#pragma unroll 1
        for (int t = 0; t < nt; ++t) {
            const bool tail = (t + 1 >= nt);
            MOE_STAGE(sl ^ 1, A0 + (size_t)(tail ? 0 : t + 1) * kstep, vA);
            if (t == nt - 2 && has_next) { int lane2; asm volatile("v_mbcnt_lo_u32_b32 %0, -1, 0\n\tv_mbcnt_hi_u32_b32 %0, -1, %0 ; moe voffs K=%1" : "=v"(lane2) : "i"(Cfg::K)); C.a_voffs(un, wid, lane2, vA); }
            const PG8_LAS unsigned char* ab = lds + MOE_SA(sl) + wr * (MG * 2048) + aoff;
            const PG8_LAS unsigned char* bb = lds + MOE_SB(t & 1) + boff;
            bf16x8 Bf[4][2], Af[2][2];
#define MOE_LDA(buf, m_) do { _Pragma("unroll") for (int k = 0; k < 2; ++k) Af[buf][k] = *(const PG8_LAS bf16x8*)(ab + (m_) * 2048 + k * 1024); } while (0)
#pragma unroll
            for (int n = 0; n < 4; ++n)
#pragma unroll
                for (int k = 0; k < 2; ++k) Bf[n][k] = *(const PG8_LAS bf16x8*)(bb + n * 2048 + k * 1024);
            MOE_LDA(0, 0);
#pragma unroll
            for (int m = 0; m < MG; ++m) {
                __builtin_amdgcn_sched_barrier(0);
                __builtin_amdgcn_s_setprio(1);
                acc[m][0] = __builtin_amdgcn_mfma_f32_16x16x32_bf16(Bf[0][0], Af[m & 1][0], acc[m][0], 0, 0, 0);
                __builtin_amdgcn_sched_barrier(0);
                if (m < MG - 1) MOE_LDA((m + 1) & 1, m + 1);
                __builtin_amdgcn_sched_barrier(0);
                acc[m][0] = __builtin_amdgcn_mfma_f32_16x16x32_bf16(Bf[0][1], Af[m & 1][1], acc[m][0], 0, 0, 0);
#pragma unroll
                for (int n = 1; n < 4; ++n)
#pragma unroll
                    for (int k = 0; k < 2; ++k) acc[m][n] = __builtin_amdgcn_mfma_f32_16x16x32_bf16(Bf[n][k], Af[m & 1][k], acc[m][n], 0, 0, 0);
                __builtin_amdgcn_s_setprio(0);
                __builtin_amdgcn_sched_barrier(0);
            }
#undef MOE_LDA
            asm volatile("s_waitcnt vmcnt(0)" ::: "memory");
            MOE_SYNC();
            sl ^= 1;
        }
        { int le; asm volatile("v_mbcnt_lo_u32_b32 %0, -1, 0\n\tv_mbcnt_hi_u32_b32 %0, -1, %0 ; moe epi K=%1" : "=v"(le) : "i"(Cfg::K));
          C.epilogue(acc, u, wr, wc, le & 15, le >> 4); }
        if (!has_next) break;
#pragma unroll
        for (int m = 0; m < MG; ++m)
#pragma unroll
            for (int n = 0; n < 4; ++n) acc[m][n] = (f32x4){0.f, 0.f, 0.f, 0.f};
        u = un;
    }
    asm volatile("s_waitcnt vmcnt(0)" ::: "memory");
    MOE_SYNC();
#undef MOE_STAGE
}
#undef MOE_SA
#undef MOE_SB
#undef MOE_SYNC
#undef MOE_BLOAD
#undef MOE_BWAIT
#undef MOE_BWRITE
}

namespace {
typedef unsigned short bf16_t;
typedef float f32x4 __attribute__((ext_vector_type(4)));
typedef unsigned u32x4 __attribute__((ext_vector_type(4)));
typedef unsigned u32x2 __attribute__((ext_vector_type(2)));

constexpr int kS = 4096, kT = 8192, kD = 2048;
constexpr int kNC = 8784;
constexpr int kNP = 8960;
constexpr int kNT = 512;
constexpr int kTopK = 256;
constexpr int kNE = 64, kFF = 512, kSlots = 2 * kT;
constexpr int kChunk = 32, kNChunk = kS / kChunk;
constexpr int kStageBytes = 155648;
constexpr int kLdsBytes = kStageBytes + 64 + 1024 + 1024;

constexpr size_t al256(size_t x) { return (x + 255) & ~(size_t)255; }
constexpr size_t O_bar = 0;
constexpr size_t O_ecnt = O_bar + al256((size_t)XCD_BAR_WORDS * 4);
constexpr size_t O_WguT = O_ecnt + 512 + 64 * 128 + 512;
constexpr size_t O_WdT = O_WguT + 256;
constexpr size_t O_WinT = O_WdT + 256;
constexpr size_t O_WpT = O_WinT + al256((size_t)kNP * kD * 2);
constexpr size_t O_WoutT = O_WpT + al256((size_t)2 * kD * 1024 * 2);
constexpr size_t O_u_bf = O_WoutT + al256((size_t)kD * kD * 2);
constexpr size_t O_q_bf = O_u_bf + al256((size_t)kT * kD * 2);
constexpr size_t O_k_bf = O_q_bf + al256((size_t)kT * 1024 * 2);
constexpr size_t O_vT = O_k_bf + al256((size_t)kT * 256 * 2);
constexpr size_t O_qi_bf = O_vT + al256((size_t)kT * 256 * 2);
constexpr size_t O_ki_bf = O_qi_bf + al256((size_t)kT * 1024 * 2);
constexpr size_t O_gg_bf = O_ki_bf + al256((size_t)kT * 64 * 2);
constexpr size_t O_sga_bf = O_gg_bf + al256((size_t)kT * 1024 * 2);
constexpr size_t O_sgr_bf = O_sga_bf + al256((size_t)kT * kD * 2);
constexpr size_t O_ab_bf = O_sgr_bf + al256((size_t)kT * kD * 2);
constexpr size_t O_merged_bf = O_ab_bf + al256((size_t)2 * kT * 1024 * 2);
constexpr size_t O_wi = O_merged_bf + al256((size_t)kT * kD * 2);
constexpr size_t O_xr = O_wi + al256((size_t)kT * 16 * 4);
constexpr size_t O_bufA = O_xr + al256((size_t)kT * 1024 * 4);
constexpr size_t O_bufB = O_bufA + al256((size_t)kT * 1024 * 4);
constexpr size_t O_chA = O_bufB + al256((size_t)kT * 1024 * 4);
constexpr size_t O_chH = O_chA + al256((size_t)2 * kNChunk * 1024 * 4);
constexpr size_t O_carry = O_chH + al256((size_t)2 * kNChunk * 1024 * 4);
constexpr size_t O_x2 = O_carry + al256((size_t)2 * kNChunk * 1024 * 4);
constexpr size_t O_ew = O_x2 + al256((size_t)kT * kD * 4);
constexpr size_t O_lw = O_ew + al256((size_t)kSlots * 4);
constexpr size_t O_mask = O_lw + al256((size_t)32768 * 4);
constexpr size_t O_eid = O_mask + al256((size_t)kT * 512);
constexpr size_t O_ltok = O_eid + al256((size_t)kSlots * 4);
constexpr size_t O_slotpos = O_ltok + al256((size_t)32768 * 4);
constexpr size_t O_mtp = O_slotpos + al256((size_t)kSlots * 4);
constexpr size_t O_sc = O_mtp + al256((size_t)512);
constexpr size_t O_WrT = O_sc + al256((size_t)kT * kS * 4);
constexpr size_t O_rstd = O_WrT + al256((size_t)2 * 96 * kD * 2);
constexpr size_t O_lrs = O_rstd + al256((size_t)kT * 4);
constexpr size_t O_WgT = O_lrs + al256((size_t)32768 * 4);
constexpr size_t O_spl = O_WgT + al256((size_t)2 * 8 * 128 * 128 * 2);
constexpr size_t O_tokr = O_spl + al256((size_t)1024 * 4);
constexpr size_t O_wrk = O_tokr + al256((size_t)kNE * 16384 * 4);
constexpr size_t O_srank = O_wrk + al256((size_t)kNE * 16384 * 4);
constexpr size_t kWsBytes = O_srank + al256((size_t)kSlots * 4);
struct Params {
    const float *x, *norm1_g, *w_in, *conv_w, *conv_b, *lru_wa, *lru_ba, *lru_wx, *lru_bx, *lru_lambda, *w_proj_attn,
        *w_proj_rnn, *w_out, *rel_bias, *norm2_g, *w_group, *b_group, *w_er, *b_er, *w_gate, *w_up, *w_down, *norm_f_g;
    float* out;
    unsigned char* ws;
    int wave, pad_;
    __device__ __forceinline__ unsigned* bar() const { return (unsigned*)(ws + O_bar); }
    __device__ __forceinline__ bf16_t* WguT() const { return (bf16_t*)(ws + O_WguT); }
    __device__ __forceinline__ bf16_t* WdT() const { return (bf16_t*)(ws + O_WdT); }
    __device__ __forceinline__ bf16_t* WinT() const { return (bf16_t*)(ws + O_WinT); }
    __device__ __forceinline__ bf16_t* WpT() const { return (bf16_t*)(ws + O_WpT); }
    __device__ __forceinline__ bf16_t* WoutT() const { return (bf16_t*)(ws + O_WoutT); }
    __device__ __forceinline__ bf16_t* u_bf() const { return (bf16_t*)(ws + O_u_bf); }
    __device__ __forceinline__ bf16_t* q_bf() const { return (bf16_t*)(ws + O_q_bf); }
    __device__ __forceinline__ bf16_t* k_bf() const { return (bf16_t*)(ws + O_k_bf); }
    __device__ __forceinline__ bf16_t* vT() const { return (bf16_t*)(ws + O_vT); }
    __device__ __forceinline__ bf16_t* qi_bf() const { return (bf16_t*)(ws + O_qi_bf); }
    __device__ __forceinline__ bf16_t* ki_bf() const { return (bf16_t*)(ws + O_ki_bf); }
    __device__ __forceinline__ bf16_t* gg_bf() const { return (bf16_t*)(ws + O_gg_bf); }
    __device__ __forceinline__ bf16_t* sga_bf() const { return (bf16_t*)(ws + O_sga_bf); }
    __device__ __forceinline__ bf16_t* sgr_bf() const { return (bf16_t*)(ws + O_sgr_bf); }
    __device__ __forceinline__ bf16_t* ab_bf() const { return (bf16_t*)(ws + O_ab_bf); }
    __device__ __forceinline__ bf16_t* merged_bf() const { return (bf16_t*)(ws + O_merged_bf); }
    __device__ __forceinline__ float* wi() const { return (float*)(ws + O_wi); }
    __device__ __forceinline__ float* xr() const { return (float*)(ws + O_xr); }
    __device__ __forceinline__ float* bufA() const { return (float*)(ws + O_bufA); }
    __device__ __forceinline__ float* bufB() const { return (float*)(ws + O_bufB); }
    __device__ __forceinline__ float* chA() const { return (float*)(ws + O_chA); }
    __device__ __forceinline__ float* chH() const { return (float*)(ws + O_chH); }
    __device__ __forceinline__ float* carry() const { return (float*)(ws + O_carry); }
    __device__ __forceinline__ float* x2() const { return (float*)(ws + O_x2); }
    __device__ __forceinline__ float* ew() const { return (float*)(ws + O_ew); }
    __device__ __forceinline__ float* lw() const { return (float*)(ws + O_lw); }
    __device__ __forceinline__ unsigned char* mask() const { return (unsigned char*)(ws + O_mask); }
    __device__ __forceinline__ int* eid() const { return (int*)(ws + O_eid); }
    __device__ __forceinline__ int* ltok() const { return (int*)(ws + O_ltok); }
    __device__ __forceinline__ int* slotpos() const { return (int*)(ws + O_slotpos); }
    __device__ __forceinline__ int* mtp() const { return (int*)(ws + O_mtp); }
    __device__ __forceinline__ float* sc() const { return (float*)(ws + O_sc); }
    __device__ __forceinline__ bf16_t* WrT() const { return (bf16_t*)(ws + O_WrT); }
    __device__ __forceinline__ float* rstd() const { return (float*)(ws + O_rstd); }
    __device__ __forceinline__ float* lrs() const { return (float*)(ws + O_lrs); }
    __device__ __forceinline__ bf16_t* WgT() const { return (bf16_t*)(ws + O_WgT); }
    __device__ __forceinline__ float* spl() const { return (float*)(ws + O_spl); }
    __device__ __forceinline__ int* ecnt() const { return (int*)(ws + O_ecnt); }
    __device__ __forceinline__ int* tokr() const { return (int*)(ws + O_tokr); }
    __device__ __forceinline__ float* wrk() const { return (float*)(ws + O_wrk); }
    __device__ __forceinline__ int* srank() const { return (int*)(ws + O_srank); }
    __device__ __forceinline__ bf16_t* u2_bf() const { return (bf16_t*)(ws + O_u_bf); }
    __device__ __forceinline__ bf16_t* h_bf() const { return (bf16_t*)(ws + O_q_bf); }
    __device__ __forceinline__ bf16_t* y_bf() const { return (bf16_t*)(ws + O_sga_bf); }
    __device__ __forceinline__ float* tmp() const { return (float*)(ws + O_bufA); }
};

__device__ __forceinline__ int tidx_w(int wave) {
    int lane; asm volatile("v_mbcnt_lo_u32_b32 %0, -1, 0\n\tv_mbcnt_hi_u32_b32 %0, -1, %0" : "=v"(lane));
    return wave * 64 + lane;
}
#define tidx() tidx_w(p.wave)
__device__ __forceinline__ float bf2f(bf16_t b) { return __uint_as_float(((unsigned)b) << 16); }
__device__ __forceinline__ bf16_t f2bf(float f) { unsigned u = __float_as_uint(f); u += 0x7FFFu + ((u >> 16) & 1u); return (bf16_t)(u >> 16); }
__device__ __forceinline__ unsigned pk2(float lo, float hi) { return pg8::cvt_pk_bf16(lo, hi); }

__device__ __forceinline__ float wave_sum(float v) {
#pragma unroll
    for (int o = 32; o; o >>= 1) v += __shfl_xor(v, o);
    return v;
}
__device__ __forceinline__ float wave_sum_dpp(float v) {
#define WS_DPP(ctrl) v += __uint_as_float((unsigned)__builtin_amdgcn_update_dpp(0, (int)__float_as_uint(v), ctrl, 0xF, 0xF, true))
    WS_DPP(0xB1); WS_DPP(0x4E); WS_DPP(0x141); WS_DPP(0x140);
#undef WS_DPP
    const int iv = (int)__float_as_uint(v);
    return (__uint_as_float((unsigned)__builtin_amdgcn_readlane(iv, 0)) + __uint_as_float((unsigned)__builtin_amdgcn_readlane(iv, 16)))
         + (__uint_as_float((unsigned)__builtin_amdgcn_readlane(iv, 32)) + __uint_as_float((unsigned)__builtin_amdgcn_readlane(iv, 48)));
}
__device__ __forceinline__ int wave_sum_i_dpp(int v) {
#define WS_DPP(ctrl) v += __builtin_amdgcn_update_dpp(0, v, ctrl, 0xF, 0xF, true)
    WS_DPP(0xB1); WS_DPP(0x4E); WS_DPP(0x141); WS_DPP(0x140);
#undef WS_DPP
    return (__builtin_amdgcn_readlane(v, 0) + __builtin_amdgcn_readlane(v, 16)) + (__builtin_amdgcn_readlane(v, 32) + __builtin_amdgcn_readlane(v, 48));
}
__device__ __forceinline__ int wave_sum_i(int v) {
#pragma unroll
    for (int o = 32; o; o >>= 1) v += __shfl_xor(v, o);
    return v;
}
__device__ __forceinline__ float block_sum(float v, float* red, int wave) {
    v = wave_sum(v);
    __syncthreads();
    if ((tidx_w(wave) & 63) == 0) red[wave] = v;
    __syncthreads();
    float s = 0.f;
#pragma unroll
    for (int i = 0; i < 8; ++i) s += red[i];
    return s;
}
__device__ __forceinline__ float sigmoidf_(float x) { return __builtin_amdgcn_rcpf(1.0f + __expf(-x)); }
__device__ __forceinline__ float gelu_tanh(float x) {
    const float y2 = 1.5957691216057308f * (x + 0.044715f * x * x * x);
    return x * __builtin_amdgcn_rcpf(1.0f + __expf(-y2));
}
__device__ __forceinline__ int swap23(int v) { return (v & ~12) | ((v & 4) << 1) | ((v & 8) >> 1); }
__device__ __forceinline__ size_t vt_index(int b, int g, int d, int s) { return ((size_t)((b * 2 + g) * 128 + d)) * kS + (size_t)((s & ~15) | swap23(s & 15)); }

__device__ __forceinline__ void xpose_item(const float* __restrict__ W, int ldw, bf16_t* __restrict__ WT, int Kt, int k0, int ncol, bool valid, size_t orow) {
    f32x4 v[32];
    const float* src = W + (size_t)k0 * ldw + (valid ? ncol : 0);
#pragma unroll
    for (int kk = 0; kk < 32; ++kk) v[kk] = __builtin_nontemporal_load((const f32x4*)(src + (size_t)kk * ldw));
    if (valid) {
#pragma unroll
        for (int j = 0; j < 4; ++j) {
            bf16_t* dst = WT + (orow + j) * (size_t)Kt + k0;
#pragma unroll
            for (int q = 0; q < 4; ++q) {
                u32x4 o;
                o.x = pg8::cvt_pk_bf16_ld(v[8 * q + 0][j], v[8 * q + 1][j]); o.y = pg8::cvt_pk_bf16_ld(v[8 * q + 2][j], v[8 * q + 3][j]);
                o.z = pg8::cvt_pk_bf16_ld(v[8 * q + 4][j], v[8 * q + 5][j]); o.w = pg8::cvt_pk_bf16_ld(v[8 * q + 6][j], v[8 * q + 7][j]);
                *(u32x4*)(dst + 8 * q) = o;
            }
        }
    }
}
constexpr int XI_IN = (kD / 32) * 35;
constexpr int XI_P = (1024 / 32) * (kD / 256);
constexpr int XI_O = (kD / 32) * (kD / 256);
constexpr int XI_E = 3 * 128;
constexpr int XI_LATE = 2 * XI_P + XI_O;
__device__ __forceinline__ void xpose_in_item(const Params& p, int r, int lane) {
    const int nb = r % 35, kb = r / 35, n = nb * 256 + 4 * lane;
    xpose_item(p.w_in, kNC, p.WinT(), kD, kb * 32, n, n < kNC, (size_t)(n < 2640 ? n : n + 176));
}
__device__ __forceinline__ void xpose_late_item(const Params& p, int r, int lane) {
    if (r < 2 * XI_P) {
        const int which = r / XI_P; r -= which * XI_P;
        const int nb = r & 7, kb = r >> 3, n = nb * 256 + 4 * lane;
        xpose_item(which ? p.w_proj_rnn : p.w_proj_attn, kD, p.WpT(), 1024, kb * 32, n, true, (size_t)(which * kD + n));
        return;
    }
    r -= 2 * XI_P;
    if (r < XI_O) {
        const int nb = r & 7, kb = r >> 3, n = nb * 256 + 4 * lane;
        xpose_item(p.w_out, kD, p.WoutT(), kD, kb * 32, n, true, (size_t)n);
        return;
    }
}
__device__ __forceinline__ void ph_convert_late(const Params& p, int qi = 0) {
    const int lane = tidx() & 63;
    constexpr int BATCH = 1;
    for (;;) {
        int it = 0;
        if (lane == 0) it = atomicAdd(p.ecnt() + 64 + qi, BATCH);
        it = __builtin_amdgcn_readfirstlane(it);
        if (it >= XI_LATE) break;
#pragma unroll 1
        for (int k = 0; k < BATCH; ++k) if (it + k < XI_LATE) xpose_late_item(p, it + k, lane);
    }
}
__device__ __forceinline__ void norm1_load(const Params& p, int m0, int m1, int lane, f32x4 (&va)[8], f32x4 (&vb)[8]) {
    const f32x4* xa = (const f32x4*)(p.x + (size_t)m0 * kD) + lane;
    const f32x4* xb = (const f32x4*)(p.x + (size_t)m1 * kD) + lane;
#pragma unroll
    for (int j = 0; j < 8; ++j) { va[j] = __builtin_nontemporal_load(xa + 64 * j); vb[j] = __builtin_nontemporal_load(xb + 64 * j); }
}
__device__ __forceinline__ void norm1_finish(const Params& p, int m0, int m1, int lane, const f32x4 (&va)[8], const f32x4 (&vb)[8], const f32x4 (&gv)[8]) {
    float sa = 0.f, sb = 0.f;
#pragma unroll
    for (int j = 0; j < 8; ++j) {
        sa += (va[j].x * va[j].x + va[j].y * va[j].y) + (va[j].z * va[j].z + va[j].w * va[j].w);
        sb += (vb[j].x * vb[j].x + vb[j].y * vb[j].y) + (vb[j].z * vb[j].z + vb[j].w * vb[j].w);
    }
    const float ca = rsqrtf(wave_sum(sa) * (1.0f / kD) + 1e-6f), cb = rsqrtf(wave_sum(sb) * (1.0f / kD) + 1e-6f);
    u32x2* oa = (u32x2*)(p.u_bf() + (size_t)m0 * kD) + lane;
    u32x2* ob = (u32x2*)(p.u_bf() + (size_t)m1 * kD) + lane;
#pragma unroll
    for (int j = 0; j < 8; ++j) {
        const f32x4 g = gv[j];
        u32x2 o; o.x = pk2(va[j].x * ca * g.x, va[j].y * ca * g.y); o.y = pk2(va[j].z * ca * g.z, va[j].w * ca * g.w); oa[64 * j] = o;
        u32x2 q; q.x = pk2(vb[j].x * cb * g.x, vb[j].y * cb * g.y); q.y = pk2(vb[j].z * cb * g.z, vb[j].w * cb * g.w); ob[64 * j] = q;
    }
}
__device__ __forceinline__ void ph_prologue(const Params& p, float* lds) {
    const int tid = tidx(), lane = tid & 63, wave = tid >> 6;
    const int gw = blockIdx.x * 8 + wave, NGW = gridDim.x * 8;
    for (int it = gw; it < XI_IN; it += NGW) xpose_in_item(p, it, lane);
    const int skip = (NGW == 2048 && XI_IN > NGW && XI_IN < 2 * NGW) ? XI_IN - NGW : 0;
    if (gw >= skip) {
        const int st = NGW - skip;
        int m = gw - skip;
        if (m < kT / 2) {
            f32x4 gv[8], va[8], vb[8];
            const f32x4* gr = (const f32x4*)p.norm1_g + lane;
#pragma unroll
            for (int j = 0; j < 8; ++j) gv[j] = gr[64 * j];
            norm1_load(p, m, m + kT / 2, lane, va, vb);
            for (;;) {
                const int mn = m + st;
                f32x4 na[8], nb[8];
                if (mn < kT / 2) norm1_load(p, mn, mn + kT / 2, lane, na, nb);
                norm1_finish(p, m, m + kT / 2, lane, va, vb, gv);
                if (mn >= kT / 2) break;
#pragma unroll
                for (int j = 0; j < 8; ++j) { va[j] = na[j]; vb[j] = nb[j]; }
                m = mn;
            }
        }
    }
}
__device__ __forceinline__ void ph_tables(const Params& p) {
    const int tid = tidx();
    const int nb = gridDim.x, b0 = (int)blockIdx.x;
    const int stride = nb * kNT;
    for (int idx0 = b0 * kNT + tid; idx0 < 96 * kD; idx0 += 4 * stride) {
        float v[4];
#pragma unroll
        for (int q = 0; q < 4; ++q) {
            const int idx = idx0 + q * stride < 96 * kD ? idx0 + q * stride : idx0, n = idx >> 11, k = idx & (kD - 1);
            v[q] = n < 8 ? p.w_group[(size_t)k * 8 + n] : (n < 72 ? p.w_er[(size_t)k * 64 + (n - 8)] : 0.f);
        }
#pragma unroll
        for (int q = 0; q < 4; ++q) {
            const int idx = idx0 + q * stride;
            if (idx < 96 * kD) {
                const int n = idx >> 11, k = idx & (kD - 1);
                const bf16_t hi = f2bf(v[q]);
                const int piece = (((k >> 8) * 16 + ((k >> 4) & 15)) * 6 + 2 * (n >> 5)) * 64 + ((k >> 3) & 1) * 32 + (n & 31);
                p.WrT()[(size_t)piece * 8 + (k & 7)] = hi; p.WrT()[(size_t)(piece + 64) * 8 + (k & 7)] = f2bf(v[q] - bf2f(hi));
            }
        }
    }
    for (int idx0 = b0 * kNT + tid; idx0 < 2 * 8 * 128 * 128; idx0 += 4 * stride) {
        float v[4];
#pragma unroll
        for (int q = 0; q < 4; ++q) {
            const int idx = idx0 + q * stride < 2 * 8 * 128 * 128 ? idx0 + q * stride : idx0;
            const int which = idx >> 17, n = (idx >> 14) & 7, d = (idx >> 7) & 127, cp = idx & 127, c = (cp & ~15) | swap23(cp & 15);
            v[q] = (which ? p.lru_wx : p.lru_wa)[(size_t)n * 16384 + c * 128 + d];
        }
#pragma unroll
        for (int q = 0; q < 4; ++q) { const int idx = idx0 + q * stride; if (idx < 2 * 8 * 128 * 128) p.WgT()[idx] = f2bf(v[q]); }
    }
    for (int idx = b0 * kNT + tid; idx < 1024; idx += nb * kNT) p.spl()[idx] = log1pf(expf(-p.lru_lambda[idx]));
}

struct ProjOrder {
    static constexpr bool KSPLIT = true;
    pg8::StaticOrder base;
    __device__ bool next(int i, pg8::Unit& u) const {
        if (base.G != 256 || base.nwg != 1120) return base.next(i, u);
        if (i < 4) return base.next(i, u);
        if (i > 4 || base.c >= 192) return false;
        const int j = (base.c & 7) + 8 * (base.c >> 4);
        pg8::StaticOrder t = base; t.c = j;
        if (!t.next(4, u)) return false;
        u.kh = 1 + 2 * j + ((base.c >> 3) & 1);
        return true;
    }
    __device__ __forceinline__ void a_ready(const pg8::Unit&) const {}
    __device__ __forceinline__ void done(const pg8::Unit&) const {}
};
struct EpiProj {
    static constexpr bool PERM = true, AFTER_DRAIN = false, CHAIN = false;
    Params p;
    __device__ __forceinline__ bool ksplit(pg8::f32x4 (&acc)[2][2][4][2], const pg8::Unit& u, int wid, int lane) const {
        const int code = u.kh - 1, half = code & 1, pair = code >> 1;
        float* part = p.sc() + (size_t)pair * 65536 + (size_t)(wid * 64 + lane) * 4;
        unsigned* flag = (unsigned*)(p.ws + O_ecnt + 512 + 64 * 128) + pair;
        if (half == 1) {
#pragma unroll
            for (int a = 0; a < 2; ++a)
#pragma unroll
                for (int bb = 0; bb < 2; ++bb)
#pragma unroll
                    for (int m = 0; m < 4; ++m)
#pragma unroll
                        for (int n = 0; n < 2; ++n) *(pg8::f32x4*)(part + (size_t)(((a * 2 + bb) * 4 + m) * 2 + n) * 2048) = acc[a][bb][m][n];
            asm volatile("s_waitcnt vmcnt(0)" ::: "memory");
            __syncthreads();
            if (wid == 0 && lane == 0) {
                __builtin_amdgcn_fence(__ATOMIC_RELEASE, "agent");
                asm volatile("s_waitcnt vmcnt(0)" ::: "memory");
                __hip_atomic_store(flag, 1u, __ATOMIC_RELAXED, __HIP_MEMORY_SCOPE_AGENT);
            }
            return false;
        } else {
            if (wid == 0 && lane == 0) {
                XB_SPIN(xb_ld(flag) == 0u, p.bar());
                __builtin_amdgcn_fence(__ATOMIC_ACQUIRE, "agent");
                asm volatile("s_waitcnt vmcnt(0)" ::: "memory");
            }
            __syncthreads();
#pragma unroll
            for (int a = 0; a < 2; ++a)
#pragma unroll
                for (int bb = 0; bb < 2; ++bb)
#pragma unroll
                    for (int m = 0; m < 4; ++m)
#pragma unroll
                        for (int n = 0; n < 2; ++n) acc[a][bb][m][n] += *(const pg8::f32x4*)(part + (size_t)(((a * 2 + bb) * 4 + m) * 2 + n) * 2048);
            return true;
        }
    }
    template <int ACT>
    __device__ __forceinline__ void store_bf16(const pg8::f32x4 (&acc)[2][2][4][2], bf16_t* base, int ldc, int row0, int col0) const {
#pragma unroll
        for (int ai = 0; ai < 2; ++ai)
#pragma unroll
            for (int m = 0; m < 4; ++m) {
                bf16_t* rowp = base + (size_t)(row0 + ai * 128 + m * 16) * ldc + col0;
#pragma unroll
                for (int bj = 0; bj < 2; ++bj) {
                    pg8::f32x4 v0 = acc[ai][bj][m][0], v1 = acc[ai][bj][m][1];
                    if (ACT == 1) {
#pragma unroll
                        for (int j = 0; j < 4; ++j) { v0[j] = gelu_tanh(v0[j]); v1[j] = gelu_tanh(v1[j]); }
                    }
                    if (ACT == 2) {
#pragma unroll
                        for (int j = 0; j < 4; ++j) { v0[j] = sigmoidf_(v0[j]); v1[j] = sigmoidf_(v1[j]); }
                    }
                    u32x4 w; w.x = pk2(v0[0], v0[1]); w.y = pk2(v0[2], v0[3]); w.z = pk2(v1[0], v1[1]); w.w = pk2(v1[2], v1[3]);
                    *(u32x4*)(rowp + bj * 128) = w;
                }
            }
    }
    __device__ __forceinline__ void operator()(const pg8::f32x4 (&acc)[2][2][4][2], const pg8::Unit& u, int wr, int wc, int fr, int fq) const {
        const int row0 = u.pm * 256 + wr * 64 + fr, cc0 = wc * 32 + 8 * fq;
        const int pn = u.pn;
        if (pn < 4) store_bf16<0>(acc, p.q_bf(), 1024, row0, pn * 256 + cc0);
        else if (pn == 4) store_bf16<0>(acc, p.k_bf(), 256, row0, cc0);
        else if (pn == 5) {
#pragma unroll
            for (int ai = 0; ai < 2; ++ai)
#pragma unroll
                for (int m = 0; m < 4; ++m) {
                    const int row = row0 + ai * 128 + m * 16, b = row >> 12, s = row & (kS - 1);
#pragma unroll
                    for (int bj = 0; bj < 2; ++bj)
#pragma unroll
                        for (int n = 0; n < 2; ++n)
#pragma unroll
                            for (int j = 0; j < 4; ++j) {
                                const int c = cc0 + bj * 128 + n * 4 + j;
                                p.vT()[vt_index(b, c >> 7, c & 127, s)] = f2bf(acc[ai][bj][m][n][j]);
                            }
                }
        }
        else if (pn < 10) store_bf16<0>(acc, p.qi_bf(), 1024, row0, (pn - 6) * 256 + cc0);
        else if (pn == 10) {
#pragma unroll
            for (int ai = 0; ai < 2; ++ai)
#pragma unroll
                for (int m = 0; m < 4; ++m) {
                    const int row = row0 + ai * 128 + m * 16;
                    const pg8::f32x4 v0 = acc[ai][0][m][0], v1 = acc[ai][0][m][1];
                    if (cc0 < 64) {
                        u32x4 w; w.x = pk2(v0[0], v0[1]); w.y = pk2(v0[2], v0[3]); w.z = pk2(v1[0], v1[1]); w.w = pk2(v1[2], v1[3]);
                        *(u32x4*)(p.ki_bf() + (size_t)row * 64 + cc0) = w;
                    } else if (cc0 < 80) {
                        float* d = p.wi() + (size_t)row * 16 + (cc0 - 64);
                        *(pg8::f32x4*)d = v0; *(pg8::f32x4*)(d + 4) = v1;
                    }
                }
        }
        else if (pn < 15) {
#pragma unroll
            for (int ai = 0; ai < 2; ++ai)
#pragma unroll
                for (int m = 0; m < 4; ++m) {
                    float* rowp = p.xr() + (size_t)(row0 + ai * 128 + m * 16) * 1024 + (pn - 11) * 256 + cc0;
#pragma unroll
                    for (int bj = 0; bj < 2; ++bj) { *(pg8::f32x4*)(rowp + bj * 128) = acc[ai][bj][m][0]; *(pg8::f32x4*)(rowp + bj * 128 + 4) = acc[ai][bj][m][1]; }
                }
        }
        else if (pn < 19) store_bf16<1>(acc, p.gg_bf(), 1024, row0, (pn - 15) * 256 + cc0);
        else store_bf16<2>(acc, pn < 27 ? p.sga_bf() : p.sgr_bf(), kD, row0, ((pn - 19) & 7) * 256 + cc0);
    }
};

__device__ __forceinline__ void unpack8(const u32x4 w, float (&f)[8]) {
    f[0] = __uint_as_float(w.x << 16); f[1] = __uint_as_float(w.x & 0xFFFF0000u);
    f[2] = __uint_as_float(w.y << 16); f[3] = __uint_as_float(w.y & 0xFFFF0000u);
    f[4] = __uint_as_float(w.z << 16); f[5] = __uint_as_float(w.z & 0xFFFF0000u);
    f[6] = __uint_as_float(w.w << 16); f[7] = __uint_as_float(w.w & 0xFFFF0000u);
}

struct EpiMerge {
    static constexpr bool PERM = true, AFTER_DRAIN = false, CHAIN = true;
    Params p;
    __device__ __forceinline__ bool chain(pg8::f32x4 (&acc)[2][2][4][2], const pg8::Unit& u, int wr, int wc, int fr, int fq) const {
        const bool second = u.pn >= 8;
        const int row0 = (u.pm & 31) * 256 + wr * 64 + fr, col0 = (u.pn & 7) * 256 + wc * 32 + 8 * fq;
#pragma unroll
        for (int ai = 0; ai < 2; ++ai) {
            u32x4 gr_[4][2], ga_[4][2];
#pragma unroll
            for (int m = 0; m < 4; ++m) {
                const size_t ro = (size_t)(row0 + ai * 128 + m * 16) * kD + col0;
#pragma unroll
                for (int bj = 0; bj < 2; ++bj) {
                    gr_[m][bj] = *(const u32x4*)(p.sgr_bf() + ro + bj * 128);
                    if (!second) ga_[m][bj] = *(const u32x4*)(p.sga_bf() + ro + bj * 128);
                }
            }
#pragma unroll
            for (int m = 0; m < 4; ++m) {
                const size_t ro = (size_t)(row0 + ai * 128 + m * 16) * kD + col0;
#pragma unroll
                for (int bj = 0; bj < 2; ++bj) {
                    float gr[8]; unpack8(gr_[m][bj], gr);
                    if (!second) {
                        float ga[8]; unpack8(ga_[m][bj], ga);
#pragma unroll
                        for (int j = 0; j < 4; ++j) { acc[ai][bj][m][0][j] *= ga[j] * __builtin_amdgcn_rcpf(gr[j]); acc[ai][bj][m][1][j] *= ga[4 + j] * __builtin_amdgcn_rcpf(gr[4 + j]); }
                    } else {
                        pg8::f32x4 v0 = acc[ai][bj][m][0], v1 = acc[ai][bj][m][1];
#pragma unroll
                        for (int j = 0; j < 4; ++j) { v0[j] *= gr[j]; v1[j] *= gr[4 + j]; }
                        u32x4 w; w.x = pk2(v0[0], v0[1]); w.y = pk2(v0[2], v0[3]); w.z = pk2(v1[0], v1[1]); w.w = pk2(v1[2], v1[3]);
                        *(u32x4*)(p.merged_bf() + ro + bj * 128) = w;
                    }
                }
            }
        }
        return !second;
    }
};
struct MergeOrder {
    static constexpr bool KSPLIT = false;
    pg8::StaticOrder base;
    __device__ bool next(int i, pg8::Unit& u) const {
        if (!base.next(i >> 1, u)) return false;
        if (i & 1) { u.pm += 32; u.pn += 8; }
        return true;
    }
    __device__ __forceinline__ void a_ready(const pg8::Unit&) const {}
    __device__ __forceinline__ void done(const pg8::Unit&) const {}
};
struct EpiWout {
    static constexpr bool PERM = true, AFTER_DRAIN = false, CHAIN = false;
    Params p;
    __device__ __forceinline__ void operator()(const pg8::f32x4 (&acc)[2][2][4][2], const pg8::Unit& u, int wr, int wc, int fr, int fq) const {
        const int row0 = u.pm * 256 + wr * 64 + fr, col0 = u.pn * 256 + wc * 32 + 8 * fq;
#pragma unroll
        for (int ai = 0; ai < 2; ++ai) {
            pg8::f32x4 xv[4][2][2];
#pragma unroll
            for (int m = 0; m < 4; ++m) {
                const size_t ro = (size_t)(row0 + ai * 128 + m * 16) * kD + col0;
#pragma unroll
                for (int bj = 0; bj < 2; ++bj) { const float* xs = p.x + ro + bj * 128; xv[m][bj][0] = *(const pg8::f32x4*)xs; xv[m][bj][1] = *(const pg8::f32x4*)(xs + 4); }
            }
#pragma unroll
            for (int m = 0; m < 4; ++m) {
                const size_t ro = (size_t)(row0 + ai * 128 + m * 16) * kD + col0;
#pragma unroll
                for (int bj = 0; bj < 2; ++bj) {
                    float* xd = p.x2() + ro + bj * 128;
                    *(pg8::f32x4*)xd = xv[m][bj][0] + acc[ai][bj][m][0];
                    *(pg8::f32x4*)(xd + 4) = xv[m][bj][1] + acc[ai][bj][m][1];
                }
            }
        }
    }
};

enum { PH_INDEX = 0, PH_ATTN, PH_RNNA, PH_SCAN, PH_CARRY, PH_FIX, PH_ROUTE, PH_LISTS, PH_FINAL, PH_COUNT };

__device__ __forceinline__ int phase_units(int ph) {
    switch (ph) {
        case PH_INDEX: return kT;
        case PH_ATTN: return kT;
        case PH_RNNA: return kT;
        case PH_SCAN: return 2 * kNChunk * 2;
        case PH_CARRY: return 4;
        case PH_FIX: return kT;
        case PH_ROUTE: return kT;
        case PH_LISTS: return kNE;
        case PH_FINAL: return kT;
    }
    return 0;
}

__device__ __forceinline__ unsigned fkey(float f) { unsigned b = __float_as_uint(f); return (b & 0x80000000u) ? ~b : (b | 0x80000000u); }


typedef short bf16x8_t __attribute__((ext_vector_type(8)));
typedef float f32x16_t __attribute__((ext_vector_type(16)));

constexpr int kIdxChunk = 256;

__device__ __forceinline__ void idx_stage_chunk(const Params& p, int b, int ci, unsigned char* buf, int wave, int lane) {
#pragma unroll
    for (int i = 0; i < 4; ++i) {
        const int q = wave * 4 + i;
        const int key = 8 * q + (lane >> 3), cpos = lane & 7;
        const bf16_t* src = p.ki_bf() + (size_t)(b * kS + ci * kIdxChunk + key) * 64 + ((cpos ^ ((key >> 1) & 7)) * 8);
        __builtin_amdgcn_global_load_lds((const unsigned*)src, (LAS unsigned*)(buf + q * 1024), 16, 0, 0);
    }
}

__device__ __forceinline__ void index_select(const Params& p, int b, int tb) {
    const int tid_l = tidx();
    const int lane = tid_l & 63, wave = __builtin_amdgcn_readfirstlane(tid_l >> 6);
    const int pos0 = tb * 16;
    float vr[64];
#define IDX_REQ(pos_) do { const float* sr_ = p.sc() + ((size_t)b * kS + (pos_)) * kS; \
        _Pragma("unroll") for (int g = 0; g < 4; ++g) if (g == 0 || 1024 * g <= (pos_)) { \
            _Pragma("unroll") for (int jj = 0; jj < 16; ++jj) { const int s = 64 * (16 * g + jj) + lane; vr[16 * g + jj] = sr_[s <= (pos_) ? s : (pos_)]; } } } while (0)
#pragma unroll 1
    for (int tt = 0; tt < 2; ++tt) {
        const int pos = pos0 + 2 * wave + tt;
        const size_t trow = (size_t)b * kS + pos;
        IDX_REQ(pos);
        unsigned key[64];
#pragma unroll
        for (int g = 0; g < 4; ++g) {
            if (g == 0 || 1024 * g <= pos) {
#pragma unroll
                for (int jj = 0; jj < 16; ++jj) {
                    const int s = 64 * (16 * g + jj) + lane;
                    const unsigned bb = __float_as_uint(vr[16 * g + jj]);
                    key[16 * g + jj] = (s <= pos) ? ((bb & 0x80000000u) ? ~bb : (bb | 0x80000000u)) : 0u;
                }
            } else {
#pragma unroll
                for (int jj = 0; jj < 16; ++jj) key[16 * g + jj] = 0u;
            }
        }
        unsigned long long mine = 0ull;
        if (pos + 1 <= kTopK) {
#pragma unroll
            for (int j = 0; j < 4; ++j) { const unsigned long long wj = __ballot(64 * j + lane <= pos); if (lane == j) mine = wj; }
        } else {
            unsigned Kth = 0u; bool exact = false;
#pragma unroll 1
            for (int bit = 31; bit >= 0; --bit) {
                const unsigned cand = Kth | (1u << bit);
                int cl0 = 0, cl1 = 0;
#pragma unroll
                for (int g = 0; g < 4; ++g) {
                    if (g == 0 || 1024 * g <= pos) {
#pragma unroll
                        for (int j = 16 * g; j < 16 * g + 16; j += 2) {
                            asm volatile("v_cmp_ge_u32 vcc, %1, %2\n\tv_addc_co_u32 %0, vcc, 0, %0, vcc" : "+v"(cl0) : "v"(key[j]), "v"(cand) : "vcc");
                            asm volatile("v_cmp_ge_u32 vcc, %1, %2\n\tv_addc_co_u32 %0, vcc, 0, %0, vcc" : "+v"(cl1) : "v"(key[j + 1]), "v"(cand) : "vcc");
                        }
                    }
                }
                const int cnt = wave_sum_i_dpp(cl0 + cl1);
                if (cnt >= kTopK) { Kth = cand; if (cnt == kTopK) { exact = true; break; } }
            }
            if (exact) {
#pragma unroll
                for (int j = 0; j < 64; ++j) { const unsigned long long wj = __ballot(key[j] >= Kth); if (lane == j) mine = wj; }
            } else {
                int cgt = 0;
#pragma unroll
                for (int j = 0; j < 64; ++j) cgt += __popcll(__ballot(key[j] > Kth));
                const int need = kTopK - cgt;
                int running = 0;
                const unsigned long long lt = (1ull << lane) - 1ull;
#pragma unroll
                for (int j = 0; j < 64; ++j) {
                    const unsigned long long eq = __ballot(key[j] == Kth);
                    const int rank = running + __popcll(eq & lt);
                    const bool sel = key[j] > Kth || (key[j] == Kth && rank < need);
                    const unsigned long long wj = __ballot(sel);
                    if (lane == j) mine = wj;
                    running += __popcll(eq);
                }
            }
        }
        *(unsigned long long*)(p.mask() + trow * 512 + lane * 8) = mine;
    }
#undef IDX_REQ
}
__device__ __forceinline__ void index_item(const Params& p, int b, int tb, unsigned char* smem, int mode = 3) {
    const int tid_l = tidx();
    const int tid = tid_l, lane = tid & 63, wave = __builtin_amdgcn_readfirstlane(tid >> 6);
    const int tg = wave & 3, kp = wave >> 2, hi = lane >> 5, l31 = lane & 31;
    const int pos0 = tb * 16;
    const int wpos0 = pos0 + 4 * tg;
    const size_t trow0 = (size_t)b * kS + wpos0;
    bf16x8_t af[2][4]; float wv[2][16];
    {
        const int rho = l31, atok = (rho >> 2) & 1, ahead = (rho & 3) + 4 * (rho >> 3);
#pragma unroll
        for (int mt = 0; mt < 2; ++mt) {
            const bf16_t* qrow = p.qi_bf() + (trow0 + 2 * mt + atok) * 1024 + ahead * 64 + 8 * hi;
#pragma unroll
            for (int kk = 0; kk < 4; ++kk) af[mt][kk] = *(const bf16x8_t*)(qrow + 16 * kk);
            const float* wrow = p.wi() + (trow0 + 2 * mt + hi) * 16;
#pragma unroll
            for (int r = 0; r < 16; r += 4) { const f32x4 w4 = *(const f32x4*)(wrow + r); wv[mt][r] = w4.x * 0.03125f; wv[mt][r + 1] = w4.y * 0.03125f; wv[mt][r + 2] = w4.z * 0.03125f; wv[mt][r + 3] = w4.w * 0.03125f; }
        }
    }
    const int nchunk = (mode & 1) ? (pos0 + 15) / kIdxChunk + 1 : 0;
    __syncthreads();
    if (mode & 1) idx_stage_chunk(p, b, 0, smem, wave, lane);
    asm volatile("s_waitcnt vmcnt(0)" ::: "memory");
    __syncthreads();
    const int rdoff = l31 * 128, rdswz = (l31 >> 1) & 7;
    for (int ci = 0; ci < nchunk; ++ci) {
        if (ci + 1 < nchunk) idx_stage_chunk(p, b, ci + 1, smem + ((ci + 1) & 1) * 32768, wave, lane);
        const unsigned char* buf = smem + (ci & 1) * 32768;
        int nst = 0;
#pragma unroll 1
        for (int kt = kp; kt < 8; kt += 2) {
            const int key0 = ci * kIdxChunk + kt * 32;
            if (key0 > wpos0 + 3) break;
            bf16x8_t bfr[4];
#pragma unroll
            for (int kk = 0; kk < 4; ++kk) bfr[kk] = *(const bf16x8_t*)(buf + kt * 4096 + rdoff + (((2 * kk + hi) ^ rdswz) * 16));
#pragma unroll
            for (int mt = 0; mt < 2; ++mt) {
                f32x16_t acc;
#pragma unroll
                for (int r = 0; r < 16; ++r) acc[r] = 0.f;
#pragma unroll
                for (int kk = 0; kk < 4; ++kk) acc = __builtin_amdgcn_mfma_f32_32x32x16_bf16(af[mt][kk], bfr[kk], acc, 0, 0, 0);
                pg8::f32x2 s2 = {0.f, 0.f};
#pragma unroll
                for (int r = 0; r < 16; r += 2) {
                    const int a0 = (int)__float_as_uint(acc[r]), a1 = (int)__float_as_uint(acc[r + 1]);
                    pg8::f32x2 rl, w2; rl.x = __uint_as_float((unsigned)(a0 > 0 ? a0 : 0)); rl.y = __uint_as_float((unsigned)(a1 > 0 ? a1 : 0)); w2.x = wv[mt][r]; w2.y = wv[mt][r + 1];
                    s2 = __builtin_elementwise_fma(rl, w2, s2);
                }
                const float sc = s2.x + s2.y;
                p.sc()[(trow0 + 2 * mt + hi) * kS + key0 + l31] = sc;
            }
            nst += 2;
        }
        if (nst >= 8) asm volatile("s_waitcnt vmcnt(8)" ::: "memory");
        else if (nst == 6) asm volatile("s_waitcnt vmcnt(6)" ::: "memory");
        else if (nst == 4) asm volatile("s_waitcnt vmcnt(4)" ::: "memory");
        else if (nst == 2) asm volatile("s_waitcnt vmcnt(2)" ::: "memory");
        else asm volatile("s_waitcnt vmcnt(0)" ::: "memory");
        __builtin_amdgcn_s_barrier();
    }
    asm volatile("s_waitcnt vmcnt(0)" ::: "memory");
    __syncthreads();
    if (mode & 2) index_select(p, b, tb);
}

__device__ __forceinline__ void ph_index_mfma(const Params& p, unsigned char* smem, int mode = 3) {
    for (int i = blockIdx.x; i < 256; i += gridDim.x) {
        const int b = i & 1;
#pragma unroll 1
        for (int k = 0; k < 2; ++k) index_item(p, b, k ? (i >> 1) : 255 - (i >> 1), smem, mode);
    }
    __syncthreads();
}

__device__ __forceinline__ int rel_bucket(int n) {
    if (n < 16) return n;
    const float v = logf((float)n / 16.0f) / 2.0794415416798357f * 16.0f;
    int l = 16 + (int)v;
    return l < 31 ? l : 31;
}

__device__ __forceinline__ void att_stage_pair(const Params& p, int b, int g, int i, unsigned char* buf, int wave, int lane) {
    const int kind = wave >> 2, par = (wave >> 1) & 1, j = 2 * i + par;
#pragma unroll
    for (int ii = 0; ii < 8; ++ii) {
        const int pc = (wave & 1) * 8 + ii;
        const bf16_t* src;
        if (kind == 0) { const int key = 4 * pc + (lane >> 4), cpos = lane & 15; src = p.k_bf() + (size_t)(b * kS + 64 * j + key) * 256 + g * 128 + ((cpos ^ (key & 15)) * 8); }
        else           { const int d = 8 * pc + (lane >> 3), cpos = lane & 7; src = p.vT() + (size_t)((b * 2 + g) * 128 + d) * kS + 64 * j + ((cpos ^ ((d >> 1) & 7)) * 8); }
        __builtin_amdgcn_global_load_lds((const unsigned*)src, (LAS unsigned*)(buf + kind * 32768 + par * 16384 + pc * 1024), 16, 0, 0);
    }
}
__device__ __forceinline__ float half_max(float x) { auto rr = __builtin_amdgcn_permlane32_swap(__float_as_uint(x), __float_as_uint(x), false, false); return fmaxf(__uint_as_float(rr[0]), __uint_as_float(rr[1])); }
__device__ __forceinline__ float half_sum(float x) { auto rr = __builtin_amdgcn_permlane32_swap(__float_as_uint(x), __float_as_uint(x), false, false); return __uint_as_float(rr[0]) + __uint_as_float(rr[1]); }

__device__ __forceinline__ void attn_item(const Params& p, int b, int h, int qb, unsigned char* smem) {
    const int tid_l = tidx();
    const int tid = tid_l, lane = tid & 63, wave = __builtin_amdgcn_readfirstlane(tid >> 6);
    const int rw = wave & 3, kp = wave >> 2, hi = lane >> 5, l31 = lane & 31;
    const int g = h >> 2, r0 = 128 * qb + 32 * rw, row = r0 + l31;
    const size_t trow = (size_t)b * kS + row;
    float* tbl = (float*)(smem + kStageBytes + 64);
    constexpr float LOG2E = 1.4426950408889634f, C2 = 1.4426950408889634f * 0.08838834764831845f;
    __syncthreads();
    const float tb0 = p.rel_bias[rel_bucket(tid & 127) * 8 + h], tb1 = p.rel_bias[31 * 8 + h];
    bf16x8_t qf[8];
    {
        const bf16_t* qrow = p.q_bf() + trow * 1024 + h * 128 + 8 * hi;
#pragma unroll
        for (int kk = 0; kk < 8; ++kk) qf[kk] = *(const bf16x8_t*)(qrow + 16 * kk);
    }
    f32x16_t o[4];
#pragma unroll
    for (int a = 0; a < 4; ++a)
#pragma unroll
        for (int r = 0; r < 16; ++r) o[a][r] = 0.f;
    float m = -1e30f, l = 0.f;
    att_stage_pair(p, b, g, 0, smem, wave, lane);
    const unsigned long long* mrow = (const unsigned long long*)(p.mask() + trow * 512);
    unsigned long long mw_next;
    asm volatile("global_load_dwordx2 %0, %1, off" : "=v"(mw_next) : "v"(mrow + kp) : "memory");
    if (tid < 256) tbl[tid] = tid < 128 ? (tb0 - tb1) * LOG2E : 0.f;
    asm volatile("s_waitcnt vmcnt(0)" : "+v"(mw_next) :: "memory");
    __syncthreads();
    const int kswz = l31 & 15;
    for (int i = 0; i <= qb; ++i) {
        if (i < qb) att_stage_pair(p, b, g, i + 1, smem + ((i + 1) & 1) * 65536, wave, lane);
        const int j = 2 * i + kp;
        const unsigned long long mw = mw_next;
        asm volatile("global_load_dwordx2 %0, %1, off" : "=v"(mw_next) : "v"(mrow + ((j + 2) < 64 ? (j + 2) : 63)) : "memory");
        if (64 * j <= r0 + 31) {
            const unsigned char* kb = smem + (i & 1) * 65536 + kp * 16384;
            const unsigned char* vb = kb + 32768;
            int kofs = l31 * 256, ksw = kswz * 16 ^ hi * 16; asm volatile("" : "+v"(kofs), "+v"(ksw));
            f32x16_t s0, s1;
#pragma unroll
            for (int r = 0; r < 16; ++r) { s0[r] = 0.f; s1[r] = 0.f; }
            {
                bf16x8_t ka[2][2];
                { const int co = kofs + ksw; ka[0][0] = *(const bf16x8_t*)(kb + co); ka[0][1] = *(const bf16x8_t*)(kb + 8192 + co); }
#pragma unroll
                for (int kk = 0; kk < 8; ++kk) {
                    if (kk < 7) { const int co = kofs + ((32 * (kk + 1)) ^ ksw); ka[(kk + 1) & 1][0] = *(const bf16x8_t*)(kb + co); ka[(kk + 1) & 1][1] = *(const bf16x8_t*)(kb + 8192 + co); }
                    s0 = __builtin_amdgcn_mfma_f32_32x32x16_bf16(ka[kk & 1][0], qf[kk], s0, 0, 0, 0);
                    s1 = __builtin_amdgcn_mfma_f32_32x32x16_bf16(ka[kk & 1][1], qf[kk], s1, 0, 0, 0);
                }
            }
            const bool needb = (64 * j + 191 > r0);
            const unsigned mlo = (unsigned)(mw) >> (4 * hi), mhi = (unsigned)(mw >> 32) >> (4 * hi);
            const unsigned NEGB = 0xFF800000u;
#define ATT_MASK(x, w, c) __uint_as_float((__float_as_uint(x) & (unsigned)__builtin_amdgcn_sbfe((int)(w), (c), 1)) | (NEGB & ~(unsigned)__builtin_amdgcn_sbfe((int)(w), (c), 1)))
            float mn, ps = 0.f, alpha;
            if (needb) {
                const int dq = row - 64 * j - 4 * hi;
#pragma unroll
                for (int r = 0; r < 16; ++r) {
                    const int c = (r & 3) + 8 * (r >> 2);
                    int d0 = dq - c, d1 = dq - c - 32;
                    d0 = d0 < 0 ? 0 : (d0 > 255 ? 255 : d0); d1 = d1 < 0 ? 0 : (d1 > 255 ? 255 : d1);
                    const float x0 = fmaf(s0[r], C2, tbl[d0]), x1 = fmaf(s1[r], C2, tbl[d1]);
                    s0[r] = ATT_MASK(x0, mlo, c); s1[r] = ATT_MASK(x1, mhi, c);
                }
                float mx = s0[0];
#pragma unroll
                for (int r = 1; r < 16; ++r) mx = fmaxf(mx, s0[r]);
#pragma unroll
                for (int r = 0; r < 16; ++r) mx = fmaxf(mx, s1[r]);
                mx = half_max(mx);
                mn = (mx > m + 8.0f) ? mx : m;
                alpha = __builtin_amdgcn_exp2f(m - mn);
#pragma unroll
                for (int r = 0; r < 16; ++r) { s0[r] = __builtin_amdgcn_exp2f(s0[r] - mn); s1[r] = __builtin_amdgcn_exp2f(s1[r] - mn); ps += s0[r] + s1[r]; }
            } else {
#pragma unroll
                for (int r = 0; r < 16; ++r) {
                    const int c = (r & 3) + 8 * (r >> 2);
                    s0[r] = ATT_MASK(s0[r], mlo, c); s1[r] = ATT_MASK(s1[r], mhi, c);
                }
                float mx = s0[0];
#pragma unroll
                for (int r = 1; r < 16; ++r) mx = fmaxf(mx, s0[r]);
#pragma unroll
                for (int r = 0; r < 16; ++r) mx = fmaxf(mx, s1[r]);
                mx = half_max(mx);
                { const float mxs = mx * C2; mn = (mxs > m + 8.0f) ? mxs : m; }
                alpha = __builtin_amdgcn_exp2f(m - mn);
                const float nmn = -mn;
#pragma unroll
                for (int r = 0; r < 16; ++r) { s0[r] = __builtin_amdgcn_exp2f(fmaf(s0[r], C2, nmn)); s1[r] = __builtin_amdgcn_exp2f(fmaf(s1[r], C2, nmn)); ps += s0[r] + s1[r]; }
            }
#undef ATT_MASK
            m = mn;
            ps = half_sum(ps);
            l = l * alpha + ps;
            if (__any(alpha != 1.f)) {
#pragma unroll
                for (int a = 0; a < 4; ++a)
#pragma unroll
                    for (int r = 0; r < 16; ++r) o[a][r] *= alpha;
            }
            bf16x8_t pf[4];
#pragma unroll
            for (int s = 0; s < 2; ++s) {
                u32x4 w0, w1;
                w0.x = pk2(s0[8 * s + 0], s0[8 * s + 1]); w0.y = pk2(s0[8 * s + 2], s0[8 * s + 3]); w0.z = pk2(s0[8 * s + 4], s0[8 * s + 5]); w0.w = pk2(s0[8 * s + 6], s0[8 * s + 7]);
                w1.x = pk2(s1[8 * s + 0], s1[8 * s + 1]); w1.y = pk2(s1[8 * s + 2], s1[8 * s + 3]); w1.z = pk2(s1[8 * s + 4], s1[8 * s + 5]); w1.w = pk2(s1[8 * s + 6], s1[8 * s + 7]);
                pf[s] = *reinterpret_cast<bf16x8_t*>(&w0); pf[2 + s] = *reinterpret_cast<bf16x8_t*>(&w1);
            }
            int vofs = l31 * 128, vsw = (((l31 >> 1) & 7) * 16) ^ (hi * 16); asm volatile("" : "+v"(vofs), "+v"(vsw));
            {
                bf16x8_t va[2][4];
#pragma unroll
                for (int ks = 0; ks < 4; ++ks) va[0][ks] = *(const bf16x8_t*)(vb + vofs + ((32 * ks) ^ vsw));
#pragma unroll
                for (int a = 0; a < 4; ++a) {
                    if (a < 3) {
#pragma unroll
                        for (int ks = 0; ks < 4; ++ks) va[(a + 1) & 1][ks] = *(const bf16x8_t*)(vb + (a + 1) * 4096 + vofs + ((32 * ks) ^ vsw));
                    }
#pragma unroll
                    for (int ks = 0; ks < 4; ++ks) o[a] = __builtin_amdgcn_mfma_f32_32x32x16_bf16(va[a & 1][ks], pf[ks], o[a], 0, 0, 0);
                    __builtin_amdgcn_sched_barrier(0);
                }
            }
        }
        asm volatile("s_waitcnt vmcnt(0)" : "+v"(mw_next) :: "memory");
        __syncthreads();
    }
    float* xch = (float*)smem + rw * (66 * 64);
    if (kp == 1) {
#pragma unroll
        for (int a = 0; a < 4; ++a)
#pragma unroll
            for (int r = 0; r < 16; ++r) xch[(a * 16 + r) * 64 + lane] = o[a][r];
        xch[64 * 64 + lane] = m; xch[65 * 64 + lane] = l;
    }
    __syncthreads();
    if (kp == 0) {
        const float m1 = xch[64 * 64 + lane], l1 = xch[65 * 64 + lane];
        const float mn = fmaxf(m, m1), a0 = __builtin_amdgcn_exp2f(m - mn), a1 = __builtin_amdgcn_exp2f(m1 - mn);
        const float inv = 1.0f / (l * a0 + l1 * a1);
        int rowb = r0 + (lane & 31); asm volatile("" : "+v"(rowb));
        bf16_t* orow = p.ab_bf() + ((size_t)b * kS + rowb) * 1024 + h * 128 + 4 * hi;
#pragma unroll
        for (int a = 0; a < 4; ++a)
#pragma unroll
            for (int k4 = 0; k4 < 4; ++k4) {
                float v[4];
#pragma unroll
                for (int e = 0; e < 4; ++e) { const int r = 4 * k4 + e; v[e] = (o[a][r] * a0 + xch[(a * 16 + r) * 64 + lane] * a1) * inv; }
                u32x2 w; w.x = pk2(v[0], v[1]); w.y = pk2(v[2], v[3]);
                *(u32x2*)(orow + 32 * a + 8 * k4) = w;
            }
    }
}
__device__ __forceinline__ void ph_attn_mfma(const Params& p, unsigned char* smem) {
    for (int i = blockIdx.x; i < 256; i += gridDim.x) {
        const int bh = i & 15;
#pragma unroll 1
        for (int k = 0; k < 2; ++k) attn_item(p, bh >> 3, bh & 7, k ? (i >> 4) : 31 - (i >> 4), smem);
    }
    __syncthreads();
}

__device__ __forceinline__ float neg_expm1(float x) {
    if (x > -0.1f) return -x * (1.0f + x * (0.5f + x * (0.16666667f + x * (0.041666668f + x * 0.0083333338f))));
    return 1.0f - __expf(x);
}
template <int mt>
__device__ __forceinline__ void rnn1_mt(const Params& p, const float (&xc)[8][8], const bf16x8_t (&bfr)[8], int n, int token, int b, int chunk, int hi, int l31) {
        f32x16_t accr, acci;
#pragma unroll
        for (int r = 0; r < 16; ++r) { accr[r] = 0.f; acci[r] = 0.f; }
        const bf16_t* wa = p.WgT() + (size_t)((n * 128 + 32 * mt + l31) * 128) + 8 * hi;
        const bf16_t* wx = wa + 8 * 128 * 128;
        f32x4 bav[4], bxv[4], spv[4];
#pragma unroll
        for (int k4 = 0; k4 < 4; ++k4) {
            const int c0 = n * 128 + 32 * mt + 8 * k4 + 4 * hi;
            bav[k4] = *(const f32x4*)(p.lru_ba + c0); bxv[k4] = *(const f32x4*)(p.lru_bx + c0); spv[k4] = *(const f32x4*)(p.spl() + c0);
        }
#pragma unroll
        for (int ks = 0; ks < 8; ++ks) {
            const bf16x8_t fa = *(const bf16x8_t*)(wa + 16 * ks), fx = *(const bf16x8_t*)(wx + 16 * ks);
            accr = __builtin_amdgcn_mfma_f32_32x32x16_bf16(fa, bfr[ks], accr, 0, 0, 0);
            acci = __builtin_amdgcn_mfma_f32_32x32x16_bf16(fx, bfr[ks], acci, 0, 0, 0);
            if ((ks & 3) == 3) __builtin_amdgcn_sched_barrier(0);
        }
        float av[16], bv[16];
#pragma unroll
        for (int k4 = 0; k4 < 4; ++k4) {
            const int c0 = n * 128 + 32 * mt + 8 * k4 + 4 * hi;
            const f32x4 ba = bav[k4], bx = bxv[k4], sp = spv[k4];
#pragma unroll
            for (int e = 0; e < 4; ++e) {
                const int r = 4 * k4 + e;
                const float x = xc[2 * mt + (r >> 3)][(r & 3) + 4 * ((r >> 2) & 1)];
                const float rg = __builtin_amdgcn_rcpf(1.0f + __expf(-(accr[r] + ba[e]))), ig = __builtin_amdgcn_rcpf(1.0f + __expf(-(acci[r] + bx[e])));
                const float la = -8.0f * rg * sp[e];
                av[r] = __expf(la);
                bv[r] = __builtin_amdgcn_sqrtf(neg_expm1(2.0f * la)) * (ig * x);
            }
        }
#define RNN_DPP_STEP(CTRL, RMASK) do { _Pragma("unroll") for (int r = 0; r < 16; ++r) { \
            const float ap = __uint_as_float((unsigned)__builtin_amdgcn_update_dpp((int)0x3F800000, (int)__float_as_uint(av[r]), CTRL, RMASK, 0xF, false)); \
            const float bp = __uint_as_float((unsigned)__builtin_amdgcn_update_dpp(0, (int)__float_as_uint(bv[r]), CTRL, RMASK, 0xF, false)); \
            bv[r] = fmaf(av[r], bp, bv[r]); av[r] *= ap; } } while (0)
        RNN_DPP_STEP(0x111, 0xF); RNN_DPP_STEP(0x112, 0xF); RNN_DPP_STEP(0x114, 0xF); RNN_DPP_STEP(0x118, 0xF); RNN_DPP_STEP(0x142, 0xA);
#undef RNN_DPP_STEP
#pragma unroll
        for (int k4 = 0; k4 < 4; ++k4) {
            const int c0 = n * 128 + 32 * mt + 8 * k4 + 4 * hi;
            const f32x4 va = (f32x4){av[4 * k4], av[4 * k4 + 1], av[4 * k4 + 2], av[4 * k4 + 3]}, vb = (f32x4){bv[4 * k4], bv[4 * k4 + 1], bv[4 * k4 + 2], bv[4 * k4 + 3]};
            *(f32x4*)(p.bufA() + (size_t)token * 1024 + c0) = va;
            *(f32x4*)(p.bufB() + (size_t)token * 1024 + c0) = vb;
            if (l31 == 31) {
                *(f32x4*)(p.chA() + (size_t)(b * kNChunk + chunk) * 1024 + c0) = va;
                *(f32x4*)(p.chH() + (size_t)(b * kNChunk + chunk) * 1024 + c0) = vb;
            }
        }

}
__device__ __forceinline__ void rnn1_item(const Params& p, int tg, int n) {
    asm volatile("" : "+s"(n));
    const int tid = tidx(), lane = tid & 63, hi = lane >> 5, l31 = lane & 31;
    const int token = tg * 32 + l31, pos = token & (kS - 1);
    float xc[8][8];
#pragma unroll
    for (int ks = 0; ks < 8; ++ks)
#pragma unroll
        for (int hf = 0; hf < 2; ++hf) {
            const int c0 = n * 128 + 16 * ks + 4 * hi + 8 * hf;
            f32x4 a = *(const f32x4*)(p.conv_b + c0);
#pragma unroll
            for (int j = 0; j < 4; ++j) {
                const f32x4 w = *(const f32x4*)(p.conv_w + j * 1024 + c0);
                const bool inside = pos - 3 + j >= 0;
                f32x4 x = *(const f32x4*)(p.xr() + (size_t)(inside ? token - 3 + j : token) * 1024 + c0);
                const float keep = inside ? 1.0f : 0.0f;
                a = a + (x * keep) * w;
            }
            xc[ks][4 * hf + 0] = a.x; xc[ks][4 * hf + 1] = a.y; xc[ks][4 * hf + 2] = a.z; xc[ks][4 * hf + 3] = a.w;
            if (hf == 1 && (ks & 1)) __builtin_amdgcn_sched_barrier(0);
        }
    bf16x8_t bfr[8];
#pragma unroll
    for (int ks = 0; ks < 8; ++ks) {
        u32x4 w; w.x = pk2(xc[ks][0], xc[ks][1]); w.y = pk2(xc[ks][2], xc[ks][3]); w.z = pk2(xc[ks][4], xc[ks][5]); w.w = pk2(xc[ks][6], xc[ks][7]);
        bfr[ks] = *reinterpret_cast<bf16x8_t*>(&w);
    }
    const int b = token >> 12, chunk = pos >> 5;
    __builtin_amdgcn_sched_barrier(0);
    rnn1_mt<0>(p, xc, bfr, n, token, b, chunk, hi, l31);
    __builtin_amdgcn_sched_barrier(0);
    rnn1_mt<1>(p, xc, bfr, n, token, b, chunk, hi, l31);
    __builtin_amdgcn_sched_barrier(0);
    rnn1_mt<2>(p, xc, bfr, n, token, b, chunk, hi, l31);
    __builtin_amdgcn_sched_barrier(0);
    rnn1_mt<3>(p, xc, bfr, n, token, b, chunk, hi, l31);
}
__device__ __forceinline__ void ph_rnn1(const Params& p) {
    const int wave = __builtin_amdgcn_readfirstlane(tidx() >> 6);
    for (int tg = blockIdx.x; tg < kT / 32; tg += gridDim.x) rnn1_item(p, tg, wave);
}
__device__ __forceinline__ void ph_rnn2(const Params& p, float* lds) {
    const int tid = tidx(), lane = tid & 63, wave = tid >> 6;
    for (int u = blockIdx.x; u < 256; u += gridDim.x) {
        const int b = u >> 7, c = (u & 127) * 8 + wave;
        const size_t g0 = (size_t)(b * kNChunk + 2 * lane) * 1024 + c;
        const float a0 = p.chA()[g0], h0 = p.chH()[g0], a1 = p.chA()[g0 + 1024], h1 = p.chH()[g0 + 1024];
        float av = a1 * a0, hv = fmaf(a1, h0, h1);
#define R2_STEP(CTRL, RMASK) do { \
            const float ap = __uint_as_float((unsigned)__builtin_amdgcn_update_dpp((int)0x3F800000, (int)__float_as_uint(av), CTRL, RMASK, 0xF, false)); \
            const float hp = __uint_as_float((unsigned)__builtin_amdgcn_update_dpp(0, (int)__float_as_uint(hv), CTRL, RMASK, 0xF, false)); \
            hv = fmaf(av, hp, hv); av *= ap; } while (0)
        R2_STEP(0x111, 0xF); R2_STEP(0x112, 0xF); R2_STEP(0x114, 0xF); R2_STEP(0x118, 0xF); R2_STEP(0x142, 0xA); R2_STEP(0x143, 0xC);
#undef R2_STEP
        const float cin = __uint_as_float((unsigned)__builtin_amdgcn_update_dpp(0, (int)__float_as_uint(hv), 0x138, 0xF, 0xF, false));
        p.carry()[g0] = cin;
        p.carry()[g0 + 1024] = fmaf(a0, cin, h0);
    }
    asm volatile("s_waitcnt vmcnt(0)" ::: "memory");
    __syncthreads();
    if (tid == 0) {
        __builtin_amdgcn_fence(__ATOMIC_RELEASE, "agent");
        asm volatile("s_waitcnt vmcnt(0)" ::: "memory");
        (void)xb_add((unsigned*)(p.ws + O_ecnt + 512 + 64 * 128) + 100, 1u);
    }
}
__device__ __forceinline__ void rnn2_wait(const Params& p) {
    if (tidx() == 0) {
        unsigned* cnt = (unsigned*)(p.ws + O_ecnt + 512 + 64 * 128) + 100;
        XB_SPIN(xb_ld(cnt) < gridDim.x, p.bar());
        __builtin_amdgcn_fence(__ATOMIC_ACQUIRE, "agent");
        asm volatile("s_waitcnt vmcnt(0)" ::: "memory");
    }
    __syncthreads();
}
__device__ __forceinline__ void ph_rnn3(const Params& p) {
    const int tid = tidx(), c4 = (tid & 255) * 4, tsub = tid >> 8;
    for (int cu = blockIdx.x; cu < kT / 32; cu += gridDim.x) {
        const f32x4 cin = *(const f32x4*)(p.carry() + (size_t)cu * 1024 + c4);
#pragma unroll 1
        for (int s0 = 0; s0 < 16; s0 += 8) {
            f32x4 ca[8], hl[8]; u32x2 gg[8];
#pragma unroll
            for (int k = 0; k < 8; ++k) {
                const size_t i = (size_t)(cu * 32 + 2 * (s0 + k) + tsub) * 1024 + c4;
                ca[k] = *(const f32x4*)(p.bufA() + i); hl[k] = *(const f32x4*)(p.bufB() + i); gg[k] = *(const u32x2*)(p.gg_bf() + i);
            }
#pragma unroll
            for (int k = 0; k < 8; ++k) {
                const size_t i = (size_t)(cu * 32 + 2 * (s0 + k) + tsub) * 1024 + c4;
                const f32x4 h = hl[k] + ca[k] * cin;
                u32x2 o;
                o.x = pk2(h.x * __uint_as_float(gg[k].x << 16), h.y * __uint_as_float(gg[k].x & 0xFFFF0000u));
                o.y = pk2(h.z * __uint_as_float(gg[k].y << 16), h.w * __uint_as_float(gg[k].y & 0xFFFF0000u));
                *(u32x2*)(p.ab_bf() + (size_t)kT * 1024 + i) = o;
            }
        }
    }
}

__device__ __forceinline__ void route_item(const Params& p, int item, unsigned char* smem, bool commit = true) {
    const int tid = tidx(), lane = tid & 63, wave = __builtin_amdgcn_readfirstlane(tid >> 6), hi = lane >> 5, l31 = lane & 31;
    const int t0 = item * 32;
    float* part = (float*)smem;
    float* ssp = (float*)(smem + 131072);
    float* lg = ssp + 32;
    float* rs = lg + 32 * 96;
    float* gl = rs + 32;
    float* bias = gl + 2048;
    const f32x4 gpre = *(const f32x4*)(p.norm2_g + 4 * tid);
    const float bpre = tid < 8 ? p.b_group[tid] : (tid < 72 ? p.b_er[tid - 8] : 0.f);
    f32x16_t acc[3];
#pragma unroll
    for (int a = 0; a < 3; ++a)
#pragma unroll
        for (int r = 0; r < 16; ++r) acc[a][r] = 0.f;
    float ss[4] = {0.f, 0.f, 0.f, 0.f};
    const float* xbase = p.x2() + (size_t)(t0 + 4 * wave) * kD + 4 * lane;
    bf16_t* obase = p.u2_bf() + (size_t)(t0 + 4 * wave) * kD + 4 * lane;
    const bf16_t* wfr = p.WrT() + (size_t)lane * 8;
    const int wks = lane >> 2, whi = (lane >> 1) & 1;
    f32x4 xv[4][4];
#pragma unroll
    for (int j = 0; j < 4; ++j)
#pragma unroll
        for (int i = 0; i < 4; ++i) xv[j][i] = *(const f32x4*)(xbase + (size_t)j * kD + 256 * i);
    __syncthreads();
    *(f32x4*)(gl + 4 * tid) = gpre;
    if (tid < 72) bias[tid] = bpre;
    __syncthreads();
#pragma unroll
    for (int kc = 0; kc < 2; ++kc) {
        f32x4 g4[4];
#pragma unroll
        for (int i = 0; i < 4; ++i) g4[i] = *(const f32x4*)(gl + 1024 * kc + 256 * i + 4 * lane);
        int wbase = wks * 2048 + whi * 512 + (lane & 1) * 8, wrot = 4 * wave + 2 * wks + whi;
        asm volatile("" : "+v"(wbase), "+v"(wrot));
#pragma unroll
        for (int j = 0; j < 4; ++j) {
#pragma unroll
            for (int i = 0; i < 4; ++i) {
                const f32x4 x = xv[j][i];
                ss[j] += (x.x * x.x + x.y * x.y) + (x.z * x.z + x.w * x.w);
                const f32x4 a = x * g4[i];
                u32x2 h; h.x = pk2(a.x, a.y); h.y = pk2(a.z, a.w);
                *(u32x2*)(obase + (size_t)j * kD + 1024 * kc + 256 * i) = h;
                u32x2 lo;
                lo.x = pk2(a.x - __uint_as_float(h.x << 16), a.y - __uint_as_float(h.x & 0xFFFF0000u));
                lo.y = pk2(a.z - __uint_as_float(h.y << 16), a.w - __uint_as_float(h.y & 0xFFFF0000u));
                unsigned char* d = smem + i * 32768 + wbase + ((wrot + j) & 31) * 16;
                *(u32x2*)d = h; *(u32x2*)(d + 1024) = lo;
            }
        }
        if (kc == 0) {
#pragma unroll
            for (int j = 0; j < 4; ++j)
#pragma unroll
                for (int i = 0; i < 4; ++i) xv[j][i] = *(const f32x4*)(xbase + (size_t)j * kD + 1024 + 256 * i);
        }
        if (kc == 1) {
#pragma unroll
            for (int j = 0; j < 4; ++j) { const float s = wave_sum_dpp(ss[j]); if (lane == 0) ssp[4 * wave + j] = s; }
        }
        __syncthreads();
        bf16x8_t wq[2][6];
#pragma unroll
        for (int f = 0; f < 6; ++f) wq[0][f] = *(const bf16x8_t*)(wfr + (size_t)(((64 * kc + 8 * wave) * 6 + f) * 64) * 8);
#pragma unroll
        for (int i = 0; i < 8; ++i) {
            const int ks = 8 * wave + i;
            if (i + 1 < 8) {
#pragma unroll
                for (int f = 0; f < 6; ++f) wq[(i + 1) & 1][f] = *(const bf16x8_t*)(wfr + (size_t)(((64 * kc + ks + 1) * 6 + f) * 64) * 8);
            }
            const unsigned char* s = smem + ((ks * 2) * 2 + hi) * 512 + ((l31 + 2 * ks + hi) & 31) * 16;
            const bf16x8_t ah = *(const bf16x8_t*)s, alo = *(const bf16x8_t*)(s + 1024);
            __builtin_amdgcn_sched_barrier(0);
#pragma unroll
            for (int nt = 0; nt < 3; ++nt) {
                const bf16x8_t bh = wq[i & 1][2 * nt], bl = wq[i & 1][2 * nt + 1];
                acc[nt] = __builtin_amdgcn_mfma_f32_32x32x16_bf16(ah, bh, acc[nt], 0, 0, 0);
                acc[nt] = __builtin_amdgcn_mfma_f32_32x32x16_bf16(ah, bl, acc[nt], 0, 0, 0);
                acc[nt] = __builtin_amdgcn_mfma_f32_32x32x16_bf16(alo, bh, acc[nt], 0, 0, 0);
            }
            __builtin_amdgcn_sched_barrier(0);
        }
        __syncthreads();
    }
#pragma unroll
    for (int nt = 0; nt < 3; ++nt)
#pragma unroll
        for (int r = 0; r < 16; ++r) part[wave * 3072 + (nt * 16 + r) * 64 + lane] = acc[nt][r];
    __syncthreads();
    for (int o = tid; o < 3072; o += kNT) {
        float s = 0.f;
#pragma unroll
        for (int w = 0; w < 8; ++w) s += part[w * 3072 + o];
        const int nt = o >> 10, r = (o >> 6) & 15, ln = o & 63;
        const int trow = (r & 3) + 8 * (r >> 2) + 4 * (ln >> 5), col = 32 * nt + (ln & 31);
        lg[trow * 96 + col] = s;
    }
    if (tid < 32) {
        const float s = ssp[tid];
        const float r = rsqrtf(s * (1.0f / kD) + 1e-6f);
        rs[tid] = r; p.rstd()[t0 + tid] = r;
    }
    __syncthreads();
    if (tid < 32 && commit) {
        const int t = t0 + tid;
        const float r = rs[tid];
        const float* lgt = lg + tid * 96;
        float glg[8];
#pragma unroll
        for (int i = 0; i < 8; ++i) glg[i] = lgt[i] * r + bias[i];
        int g = 0; float m = glg[0];
#pragma unroll
        for (int i = 1; i < 8; ++i) if (glg[i] > m) { m = glg[i]; g = i; }
        float den = 0.f;
#pragma unroll
        for (int i = 0; i < 8; ++i) den += expf(glg[i] - m);
        const float psel = 1.0f / den;
        float el[8];
#pragma unroll
        for (int i = 0; i < 8; ++i) el[i] = lgt[8 + g * 8 + i] * r + bias[8 + g * 8 + i];
        int e0 = 0; float v0 = el[0];
#pragma unroll
        for (int i = 1; i < 8; ++i) if (el[i] > v0) { v0 = el[i]; e0 = i; }
        int e1 = -1; float v1 = -INFINITY;
#pragma unroll
        for (int i = 0; i < 8; ++i) if (i != e0 && el[i] > v1) { v1 = el[i]; e1 = i; }
        const float ex = expf(v1 - v0);
        const float w0 = 1.0f / (1.0f + ex), w1 = ex / (1.0f + ex);
        const int ea = g * 8 + e0, eb = g * 8 + e1;
        const int ra = atomicAdd(p.ecnt() + 128 + 32 * ea, 1), rb = atomicAdd(p.ecnt() + 128 + 32 * eb, 1);
        p.eid()[t * 2 + 0] = ea; p.eid()[t * 2 + 1] = eb;
        p.srank()[t * 2 + 0] = ra; p.srank()[t * 2 + 1] = rb;
        p.tokr()[ea * 16384 + ra] = t; p.tokr()[eb * 16384 + rb] = t;
        p.wrk()[ea * 16384 + ra] = psel * w0; p.wrk()[eb * 16384 + rb] = psel * w1;
    }
}
__device__ __forceinline__ void ph_route_mfma(const Params& p, unsigned char* smem, bool commit = true) {
    for (int i = blockIdx.x; i < kT / 32; i += gridDim.x) route_item(p, i, smem, commit);
    __syncthreads();
}

__device__ __forceinline__ void build_expert_tab(const Params& p, int* tab) {
    const int tid = tidx();
    __syncthreads();
    if (tid < 64) {
        const int c = p.ecnt()[128 + 32 * tid], tiles = (c + moe::MT - 1) / moe::MT;
        int inc = tiles, cin = c;
#pragma unroll
        for (int o = 1; o < 64; o <<= 1) { const int n = __shfl_up(inc, o), n2 = __shfl_up(cin, o); if (tid >= o) { inc += n; cin += n2; } }
        tab[tid] = inc - tiles; tab[65 + tid] = c; tab[129 + tid] = cin - c;
        if (tid == 63) { tab[64] = inc; tab[193] = cin; }
    }
    __syncthreads();
}

__device__ __forceinline__ int find_expert(const int* __restrict__ mtp, int mg) {
    int l; asm volatile("v_mbcnt_lo_u32_b32 %0, -1, 0\n\tv_mbcnt_hi_u32_b32 %0, -1, %0" : "=v"(l));
    const int v = mtp[l < 63 ? l + 1 : 63];
    return __popcll(__ballot(l < 63 && v <= mg));
}
struct MoeCfg1 {
    static constexpr int K = kD, LDB = kFF;
    Params p; const int* tab; int G, c;
    __device__ __forceinline__ bool next(int i, moe::Unit& u) const {
        const int cc = (G == 256) ? (((c & 7) * 4 + (c >> 6)) * 8 + ((c >> 3) & 7)) : c;
        const int L = i * G + cc, total = tab[kNE] * 8;
        if (L >= total) return false;
        u.pm = L >> 3; u.pn = L & 7; u.ex = find_expert(tab, u.pm);
        return true;
    }
    __device__ __forceinline__ void a_voffs(const moe::Unit& u, int wid, int lane, unsigned (&v)[moe::MG]) const {
        const int rb = (u.pm - tab[u.ex]) * moe::MT, cnt = tab[65 + u.ex];
        const int* lst = p.tokr() + u.ex * 16384;
#pragma unroll
        for (int i = 0; i < moe::MG; ++i) {
            int R, Cc; pg8::stage_rc((wid + 4 * i) * 1024 + lane * 16, R, Cc);
            const int r = rb + R;
            const int t = lst[r < cnt ? r : cnt - 1];
            v[i] = (unsigned)(t * kD + Cc) * 2u;
        }
    }
    __device__ __forceinline__ const void* abase() const { return p.u2_bf(); }
    __device__ __forceinline__ const float* bsrc(const moe::Unit& u, int nq) const {
        const int col = 64 * u.pn + 32 * (nq >> 4) + 16 * ((nq >> 3) & 1) + 4 * (nq & 3);
        return (((nq >> 2) & 1) ? p.w_up : p.w_gate) + (size_t)u.ex * kD * kFF + col;
    }
    __device__ __forceinline__ void epilogue(const pg8::f32x4 (&acc)[moe::MG][4], const moe::Unit& u, int wr, int wc, int fr, int fq) const {
        const int cnt = tab[65 + u.ex], rk0 = (u.pm - tab[u.ex]) * moe::MT + wr * (16 * moe::MG) + fr, row0 = tab[129 + u.ex];
        const int col = 64 * u.pn + 32 * wc + 4 * fq;
#pragma unroll
        for (int mh = 0; mh < moe::MG; mh += 6) {
        float wv[6], rsv[6]; int tk[6];
#pragma unroll
        for (int m = 0; m < 6; ++m) if (mh + m < moe::MG) {
            const int rank = rk0 + 16 * (mh + m), rc = rank < cnt ? rank : cnt - 1;
            wv[m] = p.wrk()[u.ex * 16384 + rc]; tk[m] = p.tokr()[u.ex * 16384 + rc];
        }
#pragma unroll
        for (int m = 0; m < 6; ++m) if (mh + m < moe::MG) rsv[m] = p.rstd()[tk[m]];
#pragma unroll
        for (int mm = 0; mm < 6; ++mm) if (mh + mm < moe::MG) {
            const int m = mh + mm, rank = rk0 + 16 * m;
            const float w = wv[mm], rs = rsv[mm];
            bf16_t* rowp = p.h_bf() + (size_t)(row0 + rank) * kFF + col;
#pragma unroll
            for (int q = 0; q < 2; ++q) {
                float h[4];
#pragma unroll
                for (int j = 0; j < 4; ++j) { const float g = acc[m][2 * q][j] * rs, uu = acc[m][2 * q + 1][j] * rs; h[j] = g * __builtin_amdgcn_rcpf(1.0f + __expf(-g)) * uu * w; }
                u32x2 o; o.x = pk2(h[0], h[1]); o.y = pk2(h[2], h[3]);
                if (rank < cnt) *(u32x2*)(rowp + 16 * q) = o;
            }
        }
        }
    }
};
struct MoeCfg2 {
    static constexpr int K = kFF, LDB = kD;
    Params p; const int* tab; int G, c;
    __device__ __forceinline__ bool next(int i, moe::Unit& u) const {
        const int cc = (G == 256) ? (((c & 7) * 2 + (c >> 7)) * 16 + ((c >> 3) & 15)) : c;
        const int L = i * G + cc, total = tab[kNE] * 16;
        if (L >= total) return false;
        u.pm = L >> 4; u.pn = L & 15; u.ex = find_expert(tab, u.pm);
        return true;
    }
    __device__ __forceinline__ void a_voffs(const moe::Unit& u, int wid, int lane, unsigned (&v)[moe::MG]) const {
        const int row0 = tab[129 + u.ex] + (u.pm - tab[u.ex]) * moe::MT;
#pragma unroll
        for (int i = 0; i < moe::MG; ++i) { int R, Cc; pg8::stage_rc((wid + 4 * i) * 1024 + lane * 16, R, Cc); v[i] = (unsigned)((row0 + R) * kFF + Cc) * 2u; }
    }
    __device__ __forceinline__ const void* abase() const { return p.h_bf(); }
    __device__ __forceinline__ const float* bsrc(const moe::Unit& u, int nq) const { return p.w_down + (size_t)u.ex * kFF * kD + 128 * u.pn + 4 * nq; }
    __device__ __forceinline__ void epilogue(const pg8::f32x4 (&acc)[moe::MG][4], const moe::Unit& u, int wr, int wc, int fr, int fq) const {
        const int cnt = tab[65 + u.ex], rk0 = (u.pm - tab[u.ex]) * moe::MT + wr * (16 * moe::MG) + fr, row0 = tab[129 + u.ex];
        const int col = 128 * u.pn + 64 * wc + 4 * fq;
#pragma unroll
        for (int m = 0; m < moe::MG; ++m) {
            const int rank = rk0 + 16 * m;
            bf16_t* rowp = p.y_bf() + (size_t)(row0 + rank) * kD + col;
#pragma unroll
            for (int n = 0; n < 4; ++n) {
                const pg8::f32x4 v = acc[m][n];
                u32x2 o; o.x = pk2(v[0], v[1]); o.y = pk2(v[2], v[3]);
                if (rank < cnt) *(u32x2*)(rowp + 16 * n) = o;
            }
        }
    }
};

__device__ __forceinline__ void final_row(const Params& p, int t, int pa, int pb, int tn, int (&nx)[4], int lane) {
    const int tc = tn < kT ? tn : t;
    nx[0] = p.eid()[2 * tc]; nx[1] = p.srank()[2 * tc]; nx[2] = p.eid()[2 * tc + 1]; nx[3] = p.srank()[2 * tc + 1];
    const f32x4* xr = (const f32x4*)(p.x2() + (size_t)t * kD) + lane;
    const u32x2* ya = (const u32x2*)(p.y_bf() + (size_t)pa * kD) + lane;
    const u32x2* yb = (const u32x2*)(p.y_bf() + (size_t)pb * kD) + lane;
    f32x4 v[8]; u32x2 a[8], c[8];
#pragma unroll
    for (int j = 0; j < 8; ++j) { v[j] = xr[64 * j]; a[j] = ya[64 * j]; c[j] = yb[64 * j]; }
    float ss = 0.f;
#pragma unroll
    for (int j = 0; j < 8; ++j) {
        v[j].x += __uint_as_float(a[j].x << 16) + __uint_as_float(c[j].x << 16);
        v[j].y += __uint_as_float(a[j].x & 0xFFFF0000u) + __uint_as_float(c[j].x & 0xFFFF0000u);
        v[j].z += __uint_as_float(a[j].y << 16) + __uint_as_float(c[j].y << 16);
        v[j].w += __uint_as_float(a[j].y & 0xFFFF0000u) + __uint_as_float(c[j].y & 0xFFFF0000u);
        ss += (v[j].x * v[j].x + v[j].y * v[j].y) + (v[j].z * v[j].z + v[j].w * v[j].w);
    }
    const float sc = rsqrtf(wave_sum(ss) * (1.0f / kD) + 1e-6f);
    const f32x4* gr = (const f32x4*)p.norm_f_g + lane;
    f32x4* orow = (f32x4*)(p.out + (size_t)t * kD) + lane;
    f32x4 gv[8];
#pragma unroll
    for (int j = 0; j < 8; ++j) gv[j] = gr[64 * j];
#pragma unroll
    for (int j = 0; j < 8; ++j) { const f32x4 g = gv[j]; orow[64 * j] = (f32x4){v[j].x * sc * g.x, v[j].y * sc * g.y, v[j].z * sc * g.z, v[j].w * sc * g.w}; }
}
__device__ __forceinline__ void ph_final2(const Params& p, const int* tab) {
    const int tid = tidx(), lane = tid & 63;
    const int stride = gridDim.x * 8;
    int t = blockIdx.x * 8 + p.wave;
    if (t >= kT) return;
    int pa = tab[129 + p.eid()[2 * t]] + p.srank()[2 * t], pb = tab[129 + p.eid()[2 * t + 1]] + p.srank()[2 * t + 1];
    for (; t < kT; t += stride) {
        int nx[4];
        final_row(p, t, pa, pb, t + stride, nx, lane);
        pa = tab[129 + nx[0]] + nx[1]; pb = tab[129 + nx[2]] + nx[3];
    }
}

__device__ __forceinline__ void ph_rnn1_index(const Params& p, unsigned char* smem) {
    if (gridDim.x != 256) { ph_rnn1(p); ph_index_mfma(p, smem); return; }
    const int wave = __builtin_amdgcn_readfirstlane(tidx() >> 6);
    const int i = blockIdx.x, b = i & 1, t1 = 255 - (i >> 1), t2 = i >> 1;
    index_item(p, b, t1, smem, 1);
    index_item(p, b, t2, smem, 1);
#pragma unroll 1
    for (int s = 0; s < 3; ++s) {
        const int job = wave < 4 ? s : (s == 2 ? 0 : s + 1);
        if (job == 0) rnn1_item(p, (int)blockIdx.x, wave);
        else index_select(p, b, job == 1 ? t1 : t2);
    }
    __syncthreads();
}

#define GRID_BARRIER() xcd_barrier(bar)
__global__ void __launch_bounds__(512, 2) k_mega(Params p_in) {
    Params p = p_in;
    p.wave = __builtin_amdgcn_readfirstlane(threadIdx.x >> 6);
    extern __shared__ __attribute__((aligned(16))) unsigned char smem[];
    float* lds = (float*)smem;
    PG8_LAS unsigned char* ldsl = (PG8_LAS unsigned char*)smem;
    volatile LAS unsigned* xbw = (volatile LAS unsigned*)(smem + kStageBytes);
    if (tidx() < 4) xbw[tidx()] = 0u;
    __syncthreads();
    XcdBarrier bar = xcd_barrier_post(p.bar(), xbw, (unsigned)p.wave);
    const int G = gridDim.x, c = blockIdx.x;

    ph_prologue(p, lds);
    GRID_BARRIER();
    {
        pg8::Gemm g{p.u_bf(), p.WinT(), kT, kNP, kD};
        ProjOrder S; S.base.init(kT, kNP, G, c);
        EpiProj E{p};
        pg8::gemm_phase<EpiProj, ProjOrder, false>(ldsl, g, S, E, nullptr, p.wave);
    }
    ph_convert_late(p);
    ph_tables(p);
    GRID_BARRIER();
    ph_rnn1_index(p, smem);
    GRID_BARRIER();
    ph_rnn2(p, lds);
    ph_attn_mfma(p, smem);
    rnn2_wait(p);
    ph_rnn3(p);
    GRID_BARRIER();
    {
        pg8::Gemm g{p.ab_bf(), p.WpT(), 2 * kT, 2 * kD, 1024};
        MergeOrder S; S.base.init(kT, kD, G, c);
        EpiMerge E{p};
        pg8::gemm_phase<EpiMerge, MergeOrder, false>(ldsl, g, S, E, nullptr, p.wave);
    }
    GRID_BARRIER();
    {
        pg8::Gemm g{p.merged_bf(), p.WoutT(), kT, kD, kD};
        pg8::StaticOrder S; S.init(kT, kD, G, c);
        EpiWout E{p};
        pg8::gemm_phase<EpiWout, pg8::StaticOrder, false>(ldsl, g, S, E, nullptr, p.wave);
    }
    GRID_BARRIER();
    ph_route_mfma(p, smem);
    GRID_BARRIER();
    int* etab = (int*)(smem + kStageBytes + 64 + 1024);
    build_expert_tab(p, etab);
    {
        MoeCfg1 C1{p, etab, G, c};
        moe::gemm<MoeCfg1>(ldsl, C1, p.wave);
    }
    GRID_BARRIER();
    {
        MoeCfg2 C2{p, etab, G, c};
        moe::gemm<MoeCfg2>(ldsl, C2, p.wave);
    }
    GRID_BARRIER();
    ph_final2(p, etab);
}
}

extern "C" void kernel_launch(void* const* d_in, const int* in_sizes, int n_in, void* d_out, int out_size, void* d_ws, size_t ws_size,
                              hipStream_t stream) {
    Params p{};
    const float* const* in = (const float* const*)d_in;
    p.x = in[0]; p.norm1_g = in[1]; p.w_in = in[2]; p.conv_w = in[3]; p.conv_b = in[4]; p.lru_wa = in[5]; p.lru_ba = in[6];
    p.lru_wx = in[7]; p.lru_bx = in[8]; p.lru_lambda = in[9]; p.w_proj_attn = in[10]; p.w_proj_rnn = in[11]; p.w_out = in[12];
    p.rel_bias = in[13]; p.norm2_g = in[14]; p.w_group = in[15]; p.b_group = in[16]; p.w_er = in[17]; p.b_er = in[18];
    p.w_gate = in[19]; p.w_up = in[20]; p.w_down = in[21]; p.norm_f_g = in[22];
    p.out = (float*)d_out;
    p.ws = (unsigned char*)d_ws;
    if (kWsBytes > ws_size) fprintf(stderr, "workspace too small: need %zu, have %zu\n", (size_t)kWsBytes, ws_size);
    static int grid = 0;
    if (!grid) {
        int dev = 0, cus = 0, per_cu = 0;
        (void)hipGetDevice(&dev);
        (void)hipDeviceGetAttribute(&cus, hipDeviceAttributeMultiprocessorCount, dev);
        if (hipFuncSetAttribute((const void*)k_mega, hipFuncAttributeMaxDynamicSharedMemorySize, kLdsBytes) != hipSuccess) fprintf(stderr, "hipFuncSetAttribute failed\n");
        (void)hipOccupancyMaxActiveBlocksPerMultiprocessor(&per_cu, (const void*)k_mega, kNT, kLdsBytes);
        if (per_cu < 1) fprintf(stderr, "occupancy query says %d blocks/CU\n", per_cu);
        (void)hipGetLastError();
        grid = cus;
    }
    (void)hipMemsetAsync(p.ws + O_bar, 0, O_WguT - O_bar, stream);
    hipLaunchKernelGGL(k_mega, dim3(grid), dim3(kNT), kLdsBytes, stream, p);
}
```
